# Optimizing an MI355X kernel written in HIP

```python
import math
import jax, jax.numpy as jnp
from jax import lax
import numpy as np

D_MODEL = 1024
BATCH = 8
SEQ = 4096
DEPTH = 4

CHUNK = 64
Q_BLOCK = 128
TOKEN_BLOCK = 128
EPS = 1e-6
H_A = 4
DH_A = 64
DV_A = 2 * DH_A
H_B = 4
DK_B = 64
DV_B = 128
GATE_RANK = 16
GATE_TAU = 16.0
H_C = 16
DH_C = 64
N_BUCKETS = 32
MAX_DISTANCE = 128
N_GROUPS = 4
EXPERTS_PER_GROUP = 8
N_EXPERTS = N_GROUPS * EXPERTS_PER_GROUP
TOP_K = 2
D_EXPERT = 512

N_EVEN = (DEPTH + 1) // 2
N_ODD = DEPTH // 2
EVEN_SIZES = (H_A * 2 * DH_A, H_A * 2 * DH_A, H_A * DV_A,
              H_B * DK_B, H_B * DK_B, H_B * DV_B, H_B * DV_B, GATE_RANK)
EVEN_COLS = sum(EVEN_SIZES)
MIX_EVEN = H_A * DV_A + H_B * DV_B
MIX_ODD = H_C * DH_C

kernel_name = "hybrid_diff_gla_stickbreak_hmoe"


def rmsnorm(x, g):
    xf = x.astype(jnp.float32)
    y = xf * lax.rsqrt(jnp.mean(xf * xf, axis=-1, keepdims=True) + EPS)
    return (y * g.astype(jnp.float32)).astype(x.dtype)


def t5_bucket(rel):
    nb = N_BUCKETS // 2
    max_exact = nb // 2
    ret = jnp.where(rel > 0, nb, 0)
    n = jnp.abs(rel)
    nf = jnp.maximum(n, 1).astype(jnp.float32)
    large = max_exact + (jnp.log(nf / max_exact) / math.log(MAX_DISTANCE / max_exact)
                         * (nb - max_exact)).astype(jnp.int32)
    large = jnp.minimum(large, nb - 1)
    return ret + jnp.where(n < max_exact, n, large)


def diff_attention(q, k, v, lam, rel_bias):
    B, S = q.shape[0], q.shape[1]
    nq = S // Q_BLOCK
    kpos = jnp.arange(S)
    q_blocks = jnp.moveaxis(q.reshape(B, nq, Q_BLOCK, H_A, 2, DH_A), 1, 0)
    starts = jnp.arange(nq) * Q_BLOCK

    def one(args):
        qb, start = args
        qpos = start + jnp.arange(Q_BLOCK)
        logits = jnp.einsum('bqhmd,bkhmd->bhmqk', qb, k).astype(jnp.float32) * (DH_A ** -0.5)
        bias = jnp.transpose(rel_bias[t5_bucket(kpos[None, :] - qpos[:, None])], (2, 0, 1))
        logits = logits + bias[None, :, None].astype(jnp.float32)
        mask = (kpos[None, :] // CHUNK) <= (qpos[:, None] // CHUNK)
        p = jax.nn.softmax(jnp.where(mask, logits, -jnp.inf), axis=-1)
        w = p[:, :, 0] - lam * p[:, :, 1]
        return jnp.einsum('bhqk,bkhe->bqhe', w.astype(v.dtype), v)

    o = lax.map(one, (q_blocks, starts))
    return jnp.moveaxis(o, 0, 1).reshape(B, S, H_A, DV_A)


def gla(q, k, v, log_alpha):
    B, S = q.shape[0], q.shape[1]
    nc = S // CHUNK
    f32 = jnp.float32
    q = q.astype(f32).reshape(B, nc, CHUNK, H_B, DK_B) * (DK_B ** -0.5)
    k = k.astype(f32).reshape(B, nc, CHUNK, H_B, DK_B)
    v = v.astype(f32).reshape(B, nc, CHUNK, H_B, DV_B)
    b = jnp.cumsum(log_alpha.reshape(B, nc, CHUNK, H_B, DK_B), axis=2)
    b_last = b[:, :, -1]
    q_dec = q * jnp.exp(b)
    k_inv = k * jnp.exp(-b)
    k_dec = k * jnp.exp(b_last[:, :, None] - b)
    causal = jnp.tril(jnp.ones((CHUNK, CHUNK), dtype=bool))
    scores = jnp.einsum('bnthd,bnshd->bnhts', q_dec, k_inv)
    intra = jnp.einsum('bnhts,bnshe->bnthe', jnp.where(causal, scores, 0.0), v)

    def step(state, xs):
        q_c, k_c, v_c, bl = xs
        o = jnp.einsum('bthd,bhde->bthe', q_c, state)
        state = jnp.exp(bl)[..., None] * state + jnp.einsum('bshd,bshe->bhde', k_c, v_c)
        return state, o

    xs = (jnp.moveaxis(q_dec, 1, 0), jnp.moveaxis(k_dec, 1, 0), jnp.moveaxis(v, 1, 0),
          jnp.moveaxis(b_last, 1, 0))
    _, inter = lax.scan(step, jnp.zeros((B, H_B, DK_B, DV_B), f32), xs)
    return (intra + jnp.moveaxis(inter, 0, 1)).reshape(B, S, H_B, DV_B)


def stick_breaking(q, k, v):
    B, S = q.shape[0], q.shape[1]
    nq = S // Q_BLOCK
    kpos = jnp.arange(S)
    q_blocks = jnp.moveaxis(q.reshape(B, nq, Q_BLOCK, H_C, DH_C), 1, 0)
    starts = jnp.arange(nq) * Q_BLOCK

    def one(args):
        qb, start = args
        qpos = start + jnp.arange(Q_BLOCK)
        z = jnp.einsum('bqhd,bkhd->bhqk', qb, k).astype(jnp.float32) * (DH_C ** -0.5)
        mask = kpos[None, :] < qpos[:, None]
        log_1m = jnp.where(mask, jax.nn.log_sigmoid(-z), 0.0)
        suffix = lax.cumsum(log_1m, axis=3, reverse=True) - log_1m
        a = jnp.where(mask, jnp.exp(jax.nn.log_sigmoid(z) + suffix), 0.0)
        return jnp.einsum('bhqk,bkhd->bqhd', a.astype(v.dtype), v)

    o = lax.map(one, (q_blocks, starts))
    return jnp.moveaxis(o, 0, 1).reshape(B, S, H_C, DH_C)


def even_mixer(h, w_in, lam_p, subln_g, w_gk2, b_gk, gla_g, w_out, rel_bias, layer_idx):
    B, S, _ = h.shape
    idx = np.cumsum(EVEN_SIZES)[:-1].tolist()
    aq, ak, av, bq, bk, bv, br, bg = jnp.split(h @ w_in, idx, axis=-1)
    lambda_init = 0.8 - 0.6 * math.exp(-0.3 * layer_idx)
    lp = lam_p.astype(jnp.float32)
    lam = jnp.exp(jnp.sum(lp[0] * lp[1])) - jnp.exp(jnp.sum(lp[2] * lp[3])) + lambda_init
    oa = diff_attention(aq.reshape(B, S, H_A, 2, DH_A), ak.reshape(B, S, H_A, 2, DH_A),
                        av.reshape(B, S, H_A, DV_A), lam, rel_bias)
    oa = rmsnorm(oa, subln_g) * (1.0 - lambda_init)
    log_alpha = jax.nn.log_sigmoid((bg @ w_gk2 + b_gk).astype(jnp.float32)) / GATE_TAU
    ob = gla(bq.reshape(B, S, H_B, DK_B), bk.reshape(B, S, H_B, DK_B),
             bv.reshape(B, S, H_B, DV_B), log_alpha.reshape(B, S, H_B, DK_B)).astype(h.dtype)
    ob = rmsnorm(ob, gla_g) * jax.nn.silu(br.reshape(B, S, H_B, DV_B))
    o = jnp.concatenate([oa.reshape(B, S, H_A * DV_A), ob.reshape(B, S, H_B * DV_B)], axis=-1)
    return o @ w_out


def odd_mixer(h, w_in, w_out):
    B, S, _ = h.shape
    q, k, v = jnp.split(h @ w_in, 3, axis=-1)
    o = stick_breaking(q.reshape(B, S, H_C, DH_C), k.reshape(B, S, H_C, DH_C),
                       v.reshape(B, S, H_C, DH_C))
    return o.reshape(B, S, MIX_ODD) @ w_out


def hier_moe(h, w_rg, b_rg, w_re, b_re, w_gate, w_up, w_down):
    B, S, D = h.shape
    hf = h.reshape(B * S, D)
    n_tok = B * S
    p_g = jax.nn.softmax((hf @ w_rg + b_rg).astype(jnp.float32), axis=-1)
    g_val, g_idx = lax.top_k(p_g, 1)
    g_sel = g_idx[:, 0]
    e_logits = (hf @ w_re + b_re).astype(jnp.float32).reshape(n_tok, N_GROUPS, EXPERTS_PER_GROUP)
    e_in_group = jnp.take_along_axis(e_logits, g_sel[:, None, None], axis=1)[:, 0]
    top_v, top_i = lax.top_k(jax.nn.softmax(e_in_group, axis=-1), TOP_K)
    top_v = top_v / jnp.sum(top_v, axis=-1, keepdims=True)
    weights = g_val * top_v
    expert_idx = g_sel[:, None] * EXPERTS_PER_GROUP + top_i
    combine = jnp.sum(jax.nn.one_hot(expert_idx, N_EXPERTS, dtype=jnp.float32)
                      * weights[..., None], axis=1).astype(h.dtype)
    nb = n_tok // TOKEN_BLOCK

    def run(args):
        xb, cb = args
        g = jnp.einsum('td,edf->tef', xb, w_gate)
        u = jnp.einsum('td,edf->tef', xb, w_up)
        act = jax.nn.silu(g) * u * cb[:, :, None]
        return jnp.einsum('tef,efd->td', act, w_down)

    y = lax.map(run, (hf.reshape(nb, TOKEN_BLOCK, D), combine.reshape(nb, TOKEN_BLOCK, N_EXPERTS)))
    return y.reshape(B, S, D)


def setup_inputs(seed: int = 0) -> dict:
    key = jax.random.key(seed)
    ks = jax.random.split(key, 26)
    f32 = jnp.float32

    def nrm(k, shape, scale):
        return jax.random.normal(k, shape, f32) * scale

    D = D_MODEL
    return {
        "x": nrm(ks[0], (BATCH, SEQ, D), 1.0),
        "c": nrm(ks[1], (BATCH, D), 1.0),
        "w_ada": nrm(ks[2], (DEPTH, D, 6 * D), 0.5 * D ** -0.5),
        "b_ada": nrm(ks[3], (DEPTH, 6 * D), 0.02),
        "norm_mix": 1.0 + nrm(ks[4], (DEPTH, D), 0.05),
        "norm_ffn": 1.0 + nrm(ks[5], (DEPTH, D), 0.05),
        "norm_final": 1.0 + nrm(ks[6], (D,), 0.05),
        "rel_bias": nrm(ks[7], (N_BUCKETS, H_A), 0.5),
        "even_w_in": nrm(ks[8], (N_EVEN, D, EVEN_COLS), D ** -0.5),
        "even_lambda": nrm(ks[9], (N_EVEN, 4, DH_A), 0.1),
        "even_subln": 1.0 + nrm(ks[10], (N_EVEN, DV_A), 0.05),
        "even_w_gk2": nrm(ks[11], (N_EVEN, GATE_RANK, H_B * DK_B), GATE_RANK ** -0.5),
        "even_b_gk": nrm(ks[12], (N_EVEN, H_B * DK_B), 0.1),
        "even_gla_norm": 1.0 + nrm(ks[13], (N_EVEN, DV_B), 0.05),
        "even_w_out": nrm(ks[14], (N_EVEN, MIX_EVEN, D), MIX_EVEN ** -0.5),
        "odd_w_in": nrm(ks[15], (N_ODD, D, 3 * MIX_ODD), D ** -0.5),
        "odd_w_out": nrm(ks[16], (N_ODD, MIX_ODD, D), MIX_ODD ** -0.5),
        "router_group_w": nrm(ks[17], (DEPTH, D, N_GROUPS), D ** -0.5),
        "router_group_b": nrm(ks[18], (DEPTH, N_GROUPS), 0.01),
        "router_expert_w": nrm(ks[19], (DEPTH, D, N_EXPERTS), D ** -0.5),
        "router_expert_b": nrm(ks[20], (DEPTH, N_EXPERTS), 0.01),
        "expert_w_gate": nrm(ks[21], (DEPTH, N_EXPERTS, D, D_EXPERT), D ** -0.5),
        "expert_w_up": nrm(ks[22], (DEPTH, N_EXPERTS, D, D_EXPERT), D ** -0.5),
        "expert_w_down": nrm(ks[23], (DEPTH, N_EXPERTS, D_EXPERT, D), D_EXPERT ** -0.5),
    }


def reference(x, c, w_ada, b_ada, norm_mix, norm_ffn, norm_final, rel_bias,
              even_w_in, even_lambda, even_subln, even_w_gk2, even_b_gk, even_gla_norm,
              even_w_out, odd_w_in, odd_w_out, router_group_w, router_group_b,
              router_expert_w, router_expert_b, expert_w_gate, expert_w_up, expert_w_down):
    mod_all = jnp.einsum('bd,lde->lbe', jax.nn.silu(c), w_ada) + b_ada[:, None, :]
    for l in range(DEPTH):
        shift1, scale1, gate1, shift2, scale2, gate2 = jnp.split(mod_all[l][:, None, :], 6, axis=-1)
        h = rmsnorm(x, norm_mix[l]) * (1.0 + scale1) + shift1
        i = l // 2
        if l % 2 == 0:
            m = even_mixer(h, even_w_in[i], even_lambda[i], even_subln[i], even_w_gk2[i],
                           even_b_gk[i], even_gla_norm[i], even_w_out[i], rel_bias, l)
        else:
            m = odd_mixer(h, odd_w_in[i], odd_w_out[i])
        x = x + gate1 * m
        h = rmsnorm(x, norm_ffn[l]) * (1.0 + scale2) + shift2
        x = x + gate2 * hier_moe(h, router_group_w[l], router_group_b[l], router_expert_w[l],
                                 router_expert_b[l], expert_w_gate[l], expert_w_up[l],
                                 expert_w_down[l])
    return rmsnorm(x, norm_final)
```

```cpp
#include <hip/hip_runtime.h>
#include <cstdio>
#include <cstdint>

#define GAS __attribute__((address_space(1)))
#define LAS __attribute__((address_space(3)))
typedef unsigned short bf16;
typedef short bf16x8 __attribute__((ext_vector_type(8)));
typedef short s16x4 __attribute__((ext_vector_type(4)));
typedef float f32x4 __attribute__((ext_vector_type(4)));
typedef float f32x2 __attribute__((ext_vector_type(2)));
typedef float f32x16 __attribute__((ext_vector_type(16)));
typedef unsigned u32x4 __attribute__((ext_vector_type(4)));
typedef unsigned u32x2 __attribute__((ext_vector_type(2)));

constexpr int NTOK = 32768, DM = 1024, SEQ = 4096, NBATCH = 8, DEPTH = 4;
constexpr int QKVW = 3072;
constexpr int NEXP = 32;
constexpr float EPS = 1e-6f;
constexpr float LOG2E = 1.4426950408889634f;
constexpr float C2 = 0.125f * 1.4426950408889634f;
constexpr int E_AQ = 0, E_AK = 512, E_AV = 1024, E_BQ = 1536, E_BK = 1792, E_BV = 2048, E_BR = 2560;
constexpr int O_Q = 0, O_K = 1024, O_V = 2048;

constexpr size_t MiB = 1u << 20;
constexpr size_t WS_CTL = 0, CTL_ZERO_BYTES = 1 * MiB;
constexpr size_t WS_MOD = 2 * MiB;
constexpr size_t WS_WR = 3 * MiB;
constexpr size_t WS_WBG = 3 * MiB + 512 * 1024;
constexpr size_t WS_PLIST = 4 * MiB;
constexpr size_t WS_WLIST = 8 * MiB;
constexpr size_t WS_BG = 12 * MiB;
constexpr size_t WS_WIN = 16 * MiB;
constexpr size_t WS_WOUT = 40 * MiB;
constexpr size_t WS_WGU = 48 * MiB;
constexpr size_t WS_WD = 304 * MiB;
constexpr size_t WS_H = 432 * MiB;
constexpr size_t WS_QKV = 498 * MiB;
constexpr size_t WS_O = 690 * MiB;
constexpr size_t WS_GQD = 768 * MiB;
constexpr size_t WS_GIN = 784 * MiB;
constexpr size_t WS_GKV = 816 * MiB;
constexpr size_t WS_GAD = 880 * MiB;
constexpr size_t WS_GKA = 880 * MiB + 512 * 1024;
constexpr size_t WS_XB = 889 * MiB;
constexpr size_t WS_H8 = 953 * MiB;
constexpr size_t WS_END = 987 * MiB;
constexpr int CW_BAR = 4096;
constexpr int CW_CNT = 16384;
constexpr int CW_DBG = 24576;
constexpr int CW_QUEUE = 20480;
constexpr int RING_BYTES = 147456;
constexpr int LCTL_OFF = RING_BYTES;
constexpr int LDS_BYTES = RING_BYTES + 4096;

__device__ __forceinline__ unsigned f2bf(float f) { unsigned u = __builtin_bit_cast(unsigned, f); return (u + 0x7fffu + ((u >> 16) & 1u)) >> 16; }
__device__ __forceinline__ unsigned pk2(float lo, float hi) { return f2bf(lo) | (f2bf(hi) << 16); }
typedef __bf16 bf16x2_t __attribute__((ext_vector_type(2)));
__device__ __forceinline__ unsigned cvt_pk_bf16(float lo, float hi) { f32x2 v = {lo, hi}; bf16x2_t b = __builtin_convertvector(v, bf16x2_t); return __builtin_bit_cast(unsigned, b); }
__device__ __forceinline__ unsigned cvt1_bf16(float x) { return cvt_pk_bf16(x, 0.f); }
typedef int v4i32 __attribute__((ext_vector_type(4)));
typedef int v8i32 __attribute__((ext_vector_type(8)));
__device__ __forceinline__ unsigned pk4_fp8(float a, float b, float c, float d) {
    a = __builtin_fminf(__builtin_fmaxf(a, -448.f), 448.f); b = __builtin_fminf(__builtin_fmaxf(b, -448.f), 448.f); c = __builtin_fminf(__builtin_fmaxf(c, -448.f), 448.f); d = __builtin_fminf(__builtin_fmaxf(d, -448.f), 448.f);
    int pk = 0; pk = __builtin_amdgcn_cvt_pk_fp8_f32(a, b, pk, false); pk = __builtin_amdgcn_cvt_pk_fp8_f32(c, d, pk, true); return (unsigned)pk; }
constexpr float F8_ACT_SCALE = 16.f, F8_W_SCALE = 64.f;
constexpr int F8_SC_ACT = 0x7b7b7b7b, F8_SC_W = 0x79797979;
__device__ __forceinline__ float bf2f(unsigned short x) { return __builtin_bit_cast(float, (unsigned)x << 16); }
__device__ __forceinline__ float bflo(unsigned x) { return __builtin_bit_cast(float, x << 16); }
__device__ __forceinline__ float bfhi(unsigned x) { return __builtin_bit_cast(float, x & 0xffff0000u); }
__device__ __forceinline__ int crow(int r, int hi) { return (r & 3) + 8 * (r >> 2) + 4 * hi; }
__device__ __forceinline__ float ex2(float x) { return __builtin_amdgcn_exp2f(x); }
__device__ __forceinline__ float lg2(float x) { return __builtin_amdgcn_logf(x); }
__device__ __forceinline__ void swap32(float& a, float& b) { asm volatile("s_nop 1\n\tv_permlane32_swap_b32 %0, %1\n\ts_nop 1" : "+v"(a), "+v"(b)); }
__device__ __forceinline__ void swap16(float& a, float& b) { asm volatile("s_nop 1\n\tv_permlane16_swap_b32 %0, %1\n\ts_nop 1" : "+v"(a), "+v"(b)); }
#define LDS_WAIT() asm volatile("s_waitcnt lgkmcnt(0)" ::: "memory")
#define LBAR() do { asm volatile("s_waitcnt lgkmcnt(0)" ::: "memory"); __builtin_amdgcn_s_barrier(); asm volatile("" ::: "memory"); } while (0)

namespace pg8 {
typedef unsigned short bf16_t;
constexpr int BM = 256, BK = 64, HALF = 128, HTB = HALF * BK * 2, STAGE_BYTES = 8 * HTB, NXCD = 8, WGM = 8;
__host__ __device__ __forceinline__ int lds_byte(int r, int c) { const int st = (r >> 4) * 2 + (c >> 5), rr = r & 15, cc = c & 31, ob = rr * 64 + cc * 2; return st * 1024 + (ob ^ (((ob >> 9) & 1) << 5)); }
__host__ __device__ __forceinline__ void stage_rc(int b, int& R, int& C) { const int st = b / 1024, sb = b % 1024, swz = sb ^ (((sb >> 9) & 1) << 5); R = (st >> 1) * 16 + swz / 64; C = (st & 1) * 32 + (swz % 64) / 2; }
__host__ __device__ __forceinline__ int perm32(int rho) { const int n = rho >> 4, i = rho & 15; return 8 * (i >> 2) + 4 * n + (i & 3); }

struct Unit { int pm, pn, e, t0, ne; };
struct Gemm { const bf16_t* A; const bf16_t* Bt; int K; };

struct StaticOrder {
    int nM, nN, nwg, G, c;
    __device__ void init(int M, int N, int G_, int c_) { nM = M / BM; nN = N / BM; nwg = nM * nN; G = G_; c = c_; }
    __device__ bool next(int i, Unit& u) const {
        const long L = (long)i * G + c; if (L >= nwg) return false;
        int wgid = (int)L; { const int q = nwg / NXCD, r = nwg % NXCD, xcd = wgid % NXCD, off = wgid / NXCD; wgid = (xcd < r ? xcd * (q + 1) : r * (q + 1) + (xcd - r) * q) + off; }
        const int nig = WGM * nN, gid = wgid / nig, fm = gid * WGM, gsz = (nM - fm) < WGM ? (nM - fm) : WGM;
        u.pm = fm + ((wgid % nig) % gsz); u.pn = (wgid % nig) / gsz; u.e = 0; u.t0 = 0; u.ne = 0; return true;
    }
    __device__ __forceinline__ int arow(const Unit&, int) const { return 0; }
};

struct GroupedOrder {
    const LAS int* tb; int T, G, c; const int* plist; const LAS int* cl;
    __device__ __forceinline__ bool next(int i, Unit& u) const {
        const int nun = T * 4; const long L = (long)i * G + c; if (L >= nun) return false;
        int w = (int)L; { const int q = nun / NXCD, r = nun % NXCD, xcd = w % NXCD, off = w / NXCD; w = (xcd < r ? xcd * (q + 1) : r * (q + 1) + (xcd - r) * q) + off; }
        const int ti = w >> 2, pnl = w & 3;
        int e = 0;
#pragma unroll
        for (int step = 16; step >= 1; step >>= 1) { const int v = __builtin_amdgcn_readfirstlane(tb[e + step]); if (v <= ti) e += step; }
        u.pm = ti; u.pn = e * 4 + pnl; u.e = e; u.t0 = ti - __builtin_amdgcn_readfirstlane(tb[e]); u.ne = __builtin_amdgcn_readfirstlane(cl[e]); return true;
    }
    __device__ __forceinline__ int arow(const Unit& u, int r) const {
        const int pos = u.t0 * 256 + r; const int pr = plist[(size_t)u.e * NTOK + pos];
        return pos < u.ne ? (pr >> 1) : NTOK;
    }
};

struct EpiQKV {
    static constexpr bool PERM = true;
    bf16_t* O; int ldc; float s_lo; int n_lo; float s_one; int i_one;
    __device__ __forceinline__ void operator()(const f32x4 (&acc)[2][2][4][2], const Unit& u, int wr, int wc, int fr, int fq) const {
        const int row0 = u.pm * BM + wr * 64 + fr; const int col0 = u.pn * BM + wc * 32 + 8 * fq;
        const float sc = (u.pn < n_lo) ? s_lo : ((u.pn == i_one) ? s_one : 1.f);
#pragma unroll
        for (int ai = 0; ai < 2; ++ai)
#pragma unroll
            for (int m = 0; m < 4; ++m) { bf16_t* rowp = O + (size_t)(row0 + ai * HALF + m * 16) * ldc + col0;
#pragma unroll
                for (int bj = 0; bj < 2; ++bj) { f32x4 v0 = acc[ai][bj][m][0] * sc, v1 = acc[ai][bj][m][1] * sc;
                    u32x4 w; w.x = cvt_pk_bf16(v0[0], v0[1]); w.y = cvt_pk_bf16(v0[2], v0[3]); w.z = cvt_pk_bf16(v1[0], v1[1]); w.w = cvt_pk_bf16(v1[2], v1[3]);
                    *(u32x4*)(rowp + bj * HALF) = w; } }
    }
};
template <bool BASE_F32> struct EpiResid {
    static constexpr bool PERM = true;
    const float* base32; bf16_t* xb; const float* gate;
    __device__ __forceinline__ void operator()(const f32x4 (&acc)[2][2][4][2], const Unit& u, int wr, int wc, int fr_, int fq_) const {
        int fr = fr_, fq = fq_; asm volatile("" : "+v"(fr), "+v"(fq));
        const int b = (u.pm * BM) >> 12; const float* gp = gate + (size_t)b * 6144;
        const int col0 = u.pn * BM + wc * 32 + 8 * fq;
        if constexpr (!BASE_F32) {
            const unsigned ob0 = (unsigned)(((u.pm * BM + wr * 64 + fr) * DM + col0) * 2);
#pragma unroll
            for (int bj = 0; bj < 2; ++bj) { const f32x4 g0 = *(const f32x4*)(gp + col0 + bj * HALF), g1 = *(const f32x4*)(gp + col0 + bj * HALF + 4);
                u32x4 xr[2][4];
#pragma unroll
                for (int ai = 0; ai < 2; ++ai)
#pragma unroll
                    for (int m = 0; m < 4; ++m) { const unsigned ob = ob0 + (unsigned)(((ai * HALF + m * 16) * DM + bj * HALF) * 2); xr[ai][m] = *(const u32x4*)((const char*)xb + ob); }
#pragma unroll
                for (int ai = 0; ai < 2; ++ai)
#pragma unroll
                    for (int m = 0; m < 4; ++m) { const unsigned ob = ob0 + (unsigned)(((ai * HALF + m * 16) * DM + bj * HALF) * 2); const u32x4 r = xr[ai][m];
                        const f32x4 x0 = (f32x4){bflo(r.x), bfhi(r.x), bflo(r.y), bfhi(r.y)}, x1 = (f32x4){bflo(r.z), bfhi(r.z), bflo(r.w), bfhi(r.w)};
                        const f32x4 y0 = x0 + g0 * acc[ai][bj][m][0], y1 = x1 + g1 * acc[ai][bj][m][1];
                        u32x4 w; w.x = cvt_pk_bf16(y0[0], y0[1]); w.y = cvt_pk_bf16(y0[2], y0[3]); w.z = cvt_pk_bf16(y1[0], y1[1]); w.w = cvt_pk_bf16(y1[2], y1[3]);
                        *(u32x4*)((char*)xb + ob) = w; } }
            return;
        }
#pragma unroll
        for (int bj = 0; bj < 2; ++bj) { const f32x4 g0 = *(const f32x4*)(gp + col0 + bj * HALF), g1 = *(const f32x4*)(gp + col0 + bj * HALF + 4);
#pragma unroll
            for (int ai = 0; ai < 2; ++ai) {
                f32x4 x0[4], x1[4];
#pragma unroll
                for (int m = 0; m < 4; ++m) { const size_t off = (size_t)(u.pm * BM + ai * HALF + wr * 64 + m * 16 + fr) * DM + col0 + bj * HALF;
                    if (BASE_F32) { x0[m] = *(const f32x4*)(base32 + off); x1[m] = *(const f32x4*)(base32 + off + 4); }
                    else { const u32x4 xr = *(const u32x4*)(xb + off); x0[m] = (f32x4){bflo(xr.x), bfhi(xr.x), bflo(xr.y), bfhi(xr.y)}; x1[m] = (f32x4){bflo(xr.z), bfhi(xr.z), bflo(xr.w), bfhi(xr.w)}; } }
#pragma unroll
                for (int m = 0; m < 4; ++m) { const size_t off = (size_t)(u.pm * BM + ai * HALF + wr * 64 + m * 16 + fr) * DM + col0 + bj * HALF;
                    const f32x4 y0 = x0[m] + g0 * acc[ai][bj][m][0], y1 = x1[m] + g1 * acc[ai][bj][m][1];
                    u32x4 w; w.x = cvt_pk_bf16(y0[0], y0[1]); w.y = cvt_pk_bf16(y0[2], y0[3]); w.z = cvt_pk_bf16(y1[0], y1[1]); w.w = cvt_pk_bf16(y1[2], y1[3]);
                    *(u32x4*)(xb + off) = w; } } }
    }
};
struct EpiSwiGLU {
    static constexpr bool PERM = true;
    bf16_t* ACT; const float* wlist; const int* cnt;
    __device__ __forceinline__ void operator()(const f32x4 (&acc)[2][2][4][2], const Unit& u, int wr, int wc, int fr, int fq) const {
        const int n_e = cnt[u.e]; const int col0 = (u.pn & 3) * 128 + wc * 32 + 8 * fq;
#pragma unroll
        for (int ai = 0; ai < 2; ++ai)
#pragma unroll
            for (int m = 0; m < 4; ++m) { const int rloc = ai * HALF + wr * 64 + m * 16 + fr; const int pos = u.t0 * 256 + rloc;
                const float w = pos < n_e ? wlist[(size_t)u.e * NTOK + pos] : 0.f;
                float r[8];
#pragma unroll
                for (int n = 0; n < 2; ++n)
#pragma unroll
                    for (int i = 0; i < 4; ++i) { const float g = acc[ai][0][m][n][i], uu = acc[ai][1][m][n][i];
                        r[n * 4 + i] = g * __builtin_amdgcn_rcpf(1.f + __expf(-g)) * uu * w; }
                u32x4 o; o.x = cvt_pk_bf16(r[0], r[1]); o.y = cvt_pk_bf16(r[2], r[3]); o.z = cvt_pk_bf16(r[4], r[5]); o.w = cvt_pk_bf16(r[6], r[7]);
                *(u32x4*)(ACT + (size_t)(u.pm * BM + rloc) * 512 + col0) = o; }
    }
};
struct EpiSwiGLU8 {
    static constexpr bool PERM = true;
    unsigned char* ACT8; const float* wlist;
    __device__ __forceinline__ void operator()(const f32x4 (&acc)[2][2][4][2], const Unit& u, int wr, int wc, int fr_, int fq_) const {
        int fr = fr_, fq = fq_; asm volatile("" : "+v"(fr), "+v"(fq));
        const int n_e = u.ne; const int col0 = (u.pn & 3) * 128 + wc * 32 + 8 * fq;
        float w8[8];
#pragma unroll
        for (int q = 0; q < 8; ++q) { const int pos = u.t0 * 256 + (q >> 2) * HALF + wr * 64 + (q & 3) * 16 + fr; w8[q] = wlist[(size_t)u.e * NTOK + pos]; }
#pragma unroll
        for (int ai = 0; ai < 2; ++ai)
#pragma unroll
            for (int m = 0; m < 4; ++m) { const int rloc = ai * HALF + wr * 64 + m * 16 + fr; const int pos = u.t0 * 256 + rloc;
                const float w = pos < n_e ? w8[ai * 4 + m] * F8_ACT_SCALE : 0.f;
                float r[8];
#pragma unroll
                for (int n = 0; n < 2; ++n)
#pragma unroll
                    for (int i = 0; i < 4; ++i) { const float g = acc[ai][0][m][n][i], uu = acc[ai][1][m][n][i];
                        r[n * 4 + i] = g * __builtin_amdgcn_rcpf(1.f + __expf(-g)) * uu * w; }
                u32x2 o; o.x = pk4_fp8(r[0], r[1], r[2], r[3]); o.y = pk4_fp8(r[4], r[5], r[6], r[7]);
                *(u32x2*)(ACT8 + (size_t)(u.pm * BM + rloc) * 512 + col0) = o; }
    }
};
struct EpiScatterY {
    static constexpr bool PERM = true;
    bf16_t* Y; const int* plist;
    __device__ __forceinline__ void operator()(const f32x4 (&acc)[2][2][4][2], const Unit& u, int wr, int wc, int fr_, int fq_) const {
        int fr = fr_, fq = fq_; asm volatile("" : "+v"(fr), "+v"(fq));
        const int n_e = u.ne; const int col0 = (u.pn & 3) * 256 + wc * 32 + 8 * fq;
        int yr[8];
#pragma unroll
        for (int q = 0; q < 8; ++q) { const int pos = u.t0 * 256 + (q >> 2) * HALF + wr * 64 + (q & 3) * 16 + fr; yr[q] = plist[(size_t)u.e * NTOK + pos]; }
#pragma unroll
        for (int ai = 0; ai < 2; ++ai)
#pragma unroll
            for (int m = 0; m < 4; ++m) { const int rloc = ai * HALF + wr * 64 + m * 16 + fr; const int pos = u.t0 * 256 + rloc;
                const int yrow = pos < n_e ? yr[ai * 4 + m] : 2 * NTOK;
                unsigned char* rowp = (unsigned char*)Y + (size_t)yrow * DM + col0;
#pragma unroll
                for (int bj = 0; bj < 2; ++bj) { const f32x4 v0 = acc[ai][bj][m][0] * 32.f, v1 = acc[ai][bj][m][1] * 32.f;
                    u32x2 w; w.x = pk4_fp8(v0[0], v0[1], v0[2], v0[3]); w.y = pk4_fp8(v1[0], v1[1], v1[2], v1[3]);
                    *(u32x2*)(rowp + bj * HALF) = w; } }
    }
};

__device__ __forceinline__ void glds_s(const char* sbase_, unsigned voff, unsigned lds_dst) {
    const unsigned long long pb_ = (unsigned long long)sbase_;
    const char* sbase = (const char*)(((unsigned long long)(unsigned)__builtin_amdgcn_readfirstlane((int)(pb_ >> 32)) << 32) | (unsigned long long)(unsigned)__builtin_amdgcn_readfirstlane((int)(unsigned)pb_));
    unsigned keep;
    asm volatile("s_mov_b32 %0, m0\n\ts_mov_b32 m0, %3\n\ts_nop 0\n\tglobal_load_lds_dwordx4 %1, %2\n\ts_mov_b32 m0, %0"
                 : "=&s"(keep) : "v"(voff), "s"(sbase), "s"(lds_dst) : "memory");
}
template <class Epi, class Sched, bool GATHER, bool ALIGN_EPI, bool F8 = false>
__device__ __forceinline__ void gemm_phase(LAS unsigned char* lds, const int tid, const Gemm g, const Sched& S, const Epi& E) {
    const int wid = __builtin_amdgcn_readfirstlane(tid >> 6), lane = tid & 63, wr = wid >> 2, wc = wid & 3, fr = lane & 15, fq = lane >> 4;
    int K_ = g.K; asm volatile("" : "+s"(K_));
    const int K = K_, nt = K / BK;
    unsigned voffB[2]; int sR[2], sC[2];
#pragma unroll
    for (int i = 0; i < 2; ++i) { int R, C; stage_rc(tid * 16 + i * 8192, R, C); const int Rb = Epi::PERM ? ((R & ~31) + perm32(R & 31)) : R;
        voffB[i] = (unsigned)(Rb * K + C) * 2u; sR[i] = R; sC[i] = C; }
    const size_t kstep = (size_t)(BK * 2);
    const size_t hstep = (size_t)HALF * K * 2;
    const size_t tstep = 2 * hstep;
    const unsigned ldsw = (unsigned)wid * 1024u;
    const unsigned ldsbase = (unsigned)__builtin_amdgcn_readfirstlane((int)(unsigned)(uintptr_t)lds);
    const int aoff = lds_byte(wr * 64 + fr, fq * 8), boff = lds_byte(wc * 32 + fr, fq * 8);
    constexpr int KOFF = 1024;
#define PG8_SA(b, h) (((b) * 2 + (h)) * HTB)
#define PG8_SB(b, h) ((4 + (b) * 2 + (h)) * HTB)
#define PG8_STAGE_B(bufoff, gbase) do { _Pragma("unroll") for (int _i = 0; _i < 2; ++_i) glds_s((const char*)(gbase), voffB[_i], ldsbase + (unsigned)(bufoff) + ldsw + (unsigned)(_i * 8192)); } while (0)
#define PG8_STAGE_A(bufoff, gbase, o) do { _Pragma("unroll") for (int _i = 0; _i < 2; ++_i) glds_s((const char*)(gbase), (o)[_i], ldsbase + (unsigned)(bufoff) + ldsw + (unsigned)(_i * 8192)); } while (0)
#define PG8_LD8(p) __builtin_shufflevector(*(const LAS v4i32*)(p), *(const LAS v4i32*)((p) + KOFF), 0, 1, 2, 3, 4, 5, 6, 7)
#define PG8_LDA8(dst, b, h) do { _Pragma("unroll") for (int m = 0; m < 4; ++m) dst[m] = PG8_LD8(lds + PG8_SA(b, h) + aoff + m * 2048); } while (0)
#define PG8_LDB8(dst, b, h) do { _Pragma("unroll") for (int n = 0; n < 2; ++n) dst[n] = PG8_LD8(lds + PG8_SB(b, h) + boff + n * 2048); } while (0)
#define PG8_MMA8(ai, bj, A8, B8) do { __builtin_amdgcn_s_setprio(1); _Pragma("unroll") for (int m = 0; m < 4; ++m) _Pragma("unroll") for (int n = 0; n < 2; ++n) \
        asm volatile("v_mfma_scale_f32_16x16x128_f8f6f4 %0, %1, %2, %0, %3, %4 op_sel_hi:[0,0,0]" : "+v"(acc[ai][bj][m][n]) : "v"(B8[n]), "v"(A8[m]), "v"(sc_w), "v"(sc_a)); \
        __builtin_amdgcn_s_setprio(0); } while (0)
#define PG8_LDA(dst, b, h) do { _Pragma("unroll") for (int m = 0; m < 4; ++m) _Pragma("unroll") for (int k = 0; k < 2; ++k) dst[m][k] = *(const LAS bf16x8*)(lds + PG8_SA(b, h) + aoff + m * 2048 + k * KOFF); } while (0)
#define PG8_LDB(dst, b, h) do { _Pragma("unroll") for (int n = 0; n < 2; ++n) _Pragma("unroll") for (int k = 0; k < 2; ++k) dst[n][k] = *(const LAS bf16x8*)(lds + PG8_SB(b, h) + boff + n * 2048 + k * KOFF); } while (0)
#define PG8_MMA(ai, bj, At, Bt) do { __builtin_amdgcn_s_setprio(1); _Pragma("unroll") for (int m = 0; m < 4; ++m) _Pragma("unroll") for (int n = 0; n < 2; ++n) _Pragma("unroll") for (int k = 0; k < 2; ++k) \
        acc[ai][bj][m][n] = __builtin_amdgcn_mfma_f32_16x16x32_bf16(Bt[n][k], At[m][k], acc[ai][bj][m][n], 0, 0, 0); __builtin_amdgcn_s_setprio(0); } while (0)
#define PG8_WAIT_V(n) asm volatile("s_waitcnt vmcnt(" #n ")" ::: "memory")
#define PG8_WAIT_L(n) asm volatile("s_waitcnt lgkmcnt(" #n ")" ::: "memory")
#define PG8_BAR __builtin_amdgcn_s_barrier()
#define PG8_SCHED __builtin_amdgcn_sched_barrier(0)
#define PG8_SETOFF(o, u) do { _Pragma("unroll") for (int _h = 0; _h < 2; ++_h) _Pragma("unroll") for (int _i = 0; _i < 2; ++_i) \
        (o)[_h][_i] = GATHER ? ((unsigned)S.arow(u, _h * HALF + sR[_i]) * (unsigned)(K * 2) + (unsigned)(sC[_i] * 2)) : (unsigned)(((_h * HALF + sR[_i]) * K + sC[_i]) * 2); } while (0)
    Unit cur, nxt; int ui = 0;
    if (!S.next(0, cur)) return;
    unsigned offA[2][2], noffA[2][2];
    PG8_SETOFF(offA, cur);
    f32x4 acc[2][2][4][2];
#pragma unroll
    for (int a = 0; a < 2; ++a)
#pragma unroll
        for (int b = 0; b < 2; ++b)
#pragma unroll
            for (int m = 0; m < 4; ++m)
#pragma unroll
                for (int n = 0; n < 2; ++n) acc[a][b][m][n] = (f32x4){0.f, 0.f, 0.f, 0.f};
    bf16x8 At[4][2], B0[2][2], B1[2][2];
    v8i32 At8[4], B08[2], B18[2];
    int sc_w = F8_SC_W, sc_a = F8_SC_ACT; asm volatile("" : "+v"(sc_w), "+v"(sc_a));
    const char* cA = GATHER ? (const char*)g.A : (const char*)g.A + (size_t)cur.pm * tstep; const char* cB = (const char*)g.Bt + (size_t)cur.pn * tstep;
    PG8_STAGE_B(PG8_SB(0, 0), cB); PG8_STAGE_B(PG8_SB(0, 1), cB + hstep); PG8_STAGE_A(PG8_SA(0, 0), cA, offA[0]); PG8_STAGE_A(PG8_SA(0, 1), cA, offA[1]);
    if (wr == 1) PG8_BAR;
    PG8_WAIT_V(2); PG8_BAR;
    PG8_STAGE_B(PG8_SB(1, 0), cB + kstep); PG8_STAGE_A(PG8_SA(1, 0), cA + kstep, offA[0]); PG8_STAGE_B(PG8_SB(1, 1), cB + hstep + kstep);
    PG8_WAIT_V(6); PG8_BAR;
    for (;;) {
        const bool has_next = S.next(ui + 1, nxt);
        if (GATHER) { if (has_next) { PG8_SETOFF(noffA, nxt); } else {
#pragma unroll
            for (int h = 0; h < 2; ++h)
#pragma unroll
                for (int i = 0; i < 2; ++i) noffA[h][i] = offA[h][i]; } }
        const char* nA = GATHER ? cA : (has_next ? (const char*)g.A + (size_t)nxt.pm * tstep : cA); const char* nB = has_next ? (const char*)g.Bt + (size_t)nxt.pn * tstep : cB;
        for (int t = 0; t < nt; t += 2) {
            const bool last = (t == nt - 2);
            const char* a1 = cA + (size_t)(t + 1) * kstep;
            const char* a2 = last ? nA : cA + (size_t)(t + 2) * kstep; const char* b2 = last ? nB : cB + (size_t)(t + 2) * kstep;
            const char* a3 = a2 + kstep; const char* b3 = b2 + kstep;
            unsigned o2[2][2];
#pragma unroll
            for (int h = 0; h < 2; ++h)
#pragma unroll
                for (int i = 0; i < 2; ++i) o2[h][i] = (GATHER && last) ? noffA[h][i] : offA[h][i];
            if constexpr (F8) {
            PG8_LDB8(B08, 0, 0); PG8_LDB8(B18, 0, 1); PG8_SCHED; PG8_LDA8(At8, 0, 0); PG8_STAGE_A(PG8_SA(1, 1), a1, offA[1]);
            PG8_WAIT_V(8); PG8_WAIT_L(0); PG8_BAR; PG8_MMA8(0, 0, At8, B08); PG8_MMA8(0, 1, At8, B18); PG8_BAR; PG8_SCHED;
            PG8_LDA8(At8, 0, 1); PG8_STAGE_B(PG8_SB(0, 0), b2); PG8_STAGE_B(PG8_SB(0, 1), b2 + hstep); PG8_STAGE_A(PG8_SA(0, 0), a2, o2[0]);
            PG8_WAIT_V(8); PG8_WAIT_L(0); PG8_BAR; PG8_MMA8(1, 0, At8, B08); PG8_MMA8(1, 1, At8, B18); PG8_BAR; PG8_SCHED;
            PG8_LDB8(B08, 1, 0); PG8_LDB8(B18, 1, 1); PG8_SCHED; PG8_LDA8(At8, 1, 0); PG8_STAGE_A(PG8_SA(0, 1), a2, o2[1]);
            PG8_WAIT_V(8); PG8_WAIT_L(0); PG8_BAR; PG8_MMA8(0, 0, At8, B08); PG8_MMA8(0, 1, At8, B18); PG8_BAR; PG8_SCHED;
            PG8_LDA8(At8, 1, 1); PG8_STAGE_B(PG8_SB(1, 0), b3); PG8_STAGE_B(PG8_SB(1, 1), b3 + hstep); PG8_STAGE_A(PG8_SA(1, 0), a3, o2[0]);
            PG8_WAIT_V(8); PG8_WAIT_L(0); PG8_BAR; PG8_MMA8(1, 0, At8, B08); PG8_MMA8(1, 1, At8, B18); PG8_BAR; PG8_SCHED;
            } else {
            PG8_LDB(B0, 0, 0); PG8_LDB(B1, 0, 1); PG8_SCHED; PG8_LDA(At, 0, 0); PG8_STAGE_A(PG8_SA(1, 1), a1, offA[1]);
            PG8_WAIT_V(8); PG8_WAIT_L(0); PG8_BAR; PG8_MMA(0, 0, At, B0); PG8_MMA(0, 1, At, B1); PG8_BAR; PG8_SCHED;
            PG8_LDA(At, 0, 1); PG8_STAGE_B(PG8_SB(0, 0), b2); PG8_STAGE_B(PG8_SB(0, 1), b2 + hstep); PG8_STAGE_A(PG8_SA(0, 0), a2, o2[0]);
            PG8_WAIT_V(8); PG8_WAIT_L(0); PG8_BAR; PG8_MMA(1, 0, At, B0); PG8_MMA(1, 1, At, B1); PG8_BAR; PG8_SCHED;
            PG8_LDB(B0, 1, 0); PG8_LDB(B1, 1, 1); PG8_SCHED; PG8_LDA(At, 1, 0); PG8_STAGE_A(PG8_SA(0, 1), a2, o2[1]);
            PG8_WAIT_V(8); PG8_WAIT_L(0); PG8_BAR; PG8_MMA(0, 0, At, B0); PG8_MMA(0, 1, At, B1); PG8_BAR; PG8_SCHED;
            PG8_LDA(At, 1, 1); PG8_STAGE_B(PG8_SB(1, 0), b3); PG8_STAGE_B(PG8_SB(1, 1), b3 + hstep); PG8_STAGE_A(PG8_SA(1, 0), a3, o2[0]);
            PG8_WAIT_V(8); PG8_WAIT_L(0); PG8_BAR; PG8_MMA(1, 0, At, B0); PG8_MMA(1, 1, At, B1); PG8_BAR; PG8_SCHED;
            }
        }
        if constexpr (ALIGN_EPI) { if (wr == 0) PG8_BAR; }
        if constexpr (F8) asm volatile("s_nop 15\n\ts_nop 15" ::: "memory");
        E(acc, cur, wr, wc, fr, fq);
        if (!has_next) break;
#pragma unroll
        for (int a = 0; a < 2; ++a)
#pragma unroll
            for (int b = 0; b < 2; ++b)
#pragma unroll
                for (int m = 0; m < 4; ++m)
#pragma unroll
                    for (int n = 0; n < 2; ++n) acc[a][b][m][n] = (f32x4){0.f, 0.f, 0.f, 0.f};
        cur = nxt; cA = nA; cB = nB; ++ui;
#pragma unroll
        for (int h = 0; h < 2; ++h)
#pragma unroll
            for (int i = 0; i < 2; ++i) offA[h][i] = noffA[h][i];
        if constexpr (ALIGN_EPI) { if (wr == 1) PG8_BAR; }
    }
    PG8_WAIT_V(0);
    if constexpr (!ALIGN_EPI) { if (wr == 0) PG8_BAR; }
    PG8_BAR;
#undef PG8_SA
#undef PG8_SB
#undef PG8_STAGE_A
#undef PG8_STAGE_B
#undef PG8_LDA
#undef PG8_LDA8
#undef PG8_LD8
#undef PG8_LDB8
#undef PG8_MMA8
#undef PG8_LDB
#undef PG8_MMA
#undef PG8_WAIT_V
#undef PG8_WAIT_L
#undef PG8_BAR
#undef PG8_SCHED
#undef PG8_SETOFF
}
}

#define XB_TMO      128
#define XB_XCNT(j)  (256  + 64 * (j))
#define XB_XSUB(j)  (1280 + 64 * (j))
#define XB_XGEN(j)  (2304 + 64 * (j))
#define XB_TOP      3328
#define XB_TOPGEN   3392
#define XCD_BAR_WORDS 3456
#define XB_SPIN_CAP (1u << 18)
__device__ __forceinline__ unsigned xb_ld(unsigned* p)              { return __hip_atomic_load(p, __ATOMIC_RELAXED, __HIP_MEMORY_SCOPE_AGENT); }
__device__ __forceinline__ unsigned xb_add(unsigned* p, unsigned v) { return __hip_atomic_fetch_add(p, v, __ATOMIC_RELAXED, __HIP_MEMORY_SCOPE_AGENT); }
__device__ __forceinline__ unsigned xb_xcc_id() { return (unsigned)__builtin_amdgcn_s_getreg((3 << 11) | 20) & 0xFu; }
#define XB_SPIN(cond, bar) do { unsigned _sp = 0; while (cond) { __builtin_amdgcn_s_sleep(1); \
    if ((++_sp & 255u) == 0u) { if (xb_ld(&(bar)[XB_TMO])) break; if (_sp > XB_SPIN_CAP) { atomicAdd(&(bar)[XB_TMO], 1u); break; } } } } while (0)
struct XcdBarrier { unsigned* bar; unsigned x; volatile LAS unsigned* st; };
__device__ __forceinline__ XcdBarrier xcd_barrier_post(unsigned* bar, volatile LAS unsigned* st) {
    XcdBarrier b; b.bar = bar; b.x = xb_xcc_id(); b.st = st;
    if (threadIdx.x == 0) (void)xb_add(&bar[XB_XCNT(b.x)], 1u);
    return b;
}
__device__ __forceinline__ void xcd_barrier_complete(unsigned* bar, unsigned x, unsigned& nloc, unsigned& nx) {
    const unsigned G = gridDim.x * gridDim.y * gridDim.z;
    unsigned sum, cnt, mine, sp = 0u;
    for (;;) {
        sum = 0u; cnt = 0u; mine = 0u;
#pragma unroll 1
        for (unsigned j = 0; j < 16; ++j) { const unsigned c = xb_ld(&bar[XB_XCNT(j)]); sum += c; cnt += (c > 0u) ? 1u : 0u; mine = (j == x) ? c : mine; }
        if (sum == G) break;
        __builtin_amdgcn_s_sleep(1);
        if ((++sp & 255u) == 0u) { if (xb_ld(&bar[XB_TMO])) break; if (sp > XB_SPIN_CAP) { atomicAdd(&bar[XB_TMO], 1u); break; } }
    }
    nloc = mine > 0u ? mine : 1u; nx = cnt > 0u ? cnt : 1u;
}
__device__ __forceinline__ void xcd_barrier(const XcdBarrier& b) {
    asm volatile("s_waitcnt vmcnt(0)" ::: "memory");
    __syncthreads();
    if (threadIdx.x == 0) {
        unsigned* bar = b.bar;
        __builtin_amdgcn_s_waitcnt(0);
        unsigned nloc = b.st[0], nx = b.st[1];
        if (nloc == 0u) { xcd_barrier_complete(bar, b.x, nloc, nx); b.st[0] = nloc; b.st[1] = nx; }
        const unsigned old = xb_add(&bar[XB_XSUB(b.x)], 1u);
        const unsigned gen = old / nloc;
        if (old + 1u == (gen + 1u) * nloc) {
            __builtin_amdgcn_fence(__ATOMIC_RELEASE, "agent");
            asm volatile("s_waitcnt vmcnt(0)" ::: "memory");
            const unsigned og = xb_add(&bar[XB_TOP], 1u);
            const unsigned tg = og / nx;
            if (og + 1u == (tg + 1u) * nx) xb_add(&bar[XB_TOPGEN], 1u);
            else XB_SPIN(xb_ld(&bar[XB_TOPGEN]) == tg, bar);
            __builtin_amdgcn_fence(__ATOMIC_ACQUIRE, "agent");
            xb_add(&bar[XB_XGEN(b.x)], 1u);
            asm volatile("s_waitcnt vmcnt(0)" ::: "memory");
        } else {
            XB_SPIN(xb_ld(&bar[XB_XGEN(b.x)]) == gen, bar);
            __builtin_amdgcn_fence(__ATOMIC_ACQUIRE, "agent");
            asm volatile("s_waitcnt vmcnt(0)" ::: "memory");
        }
    }
    __syncthreads();
}

struct Args {
    const float* in[24]; float* out; unsigned char* ws; int ph_lo, ph_hi;
};
struct Ctx {
    LAS unsigned char* lds;
    int tid, lane, wave, vcu, G;
    const Args* a;
};
__device__ __forceinline__ Ctx launder(const Ctx& C) {
    Ctx P = C; int t = C.tid; asm volatile("" : "+v"(t)); P.tid = t; P.lane = t & 63; P.wave = __builtin_amdgcn_readfirstlane(t >> 6);
    int v = C.vcu, g = C.G; asm volatile("" : "+s"(v), "+s"(g)); P.vcu = v; P.G = g;
    unsigned lo = (unsigned)(uintptr_t)C.lds; asm volatile("" : "+s"(lo)); P.lds = (LAS unsigned char*)(uintptr_t)lo;
    return P;
}
enum { I_X = 0, I_C, I_WADA, I_BADA, I_NMIX, I_NFFN, I_NFIN, I_RELB, I_EWIN, I_ELAM, I_ESUBLN, I_EGK2, I_EBGK, I_EGLAN, I_EWOUT, I_OWIN, I_OWOUT,
       I_RGW, I_RGB, I_REW, I_REB, I_WG, I_WU, I_WDN };

__device__ __forceinline__ float wave_sum(float v) {
#pragma unroll
    for (int o = 1; o < 64; o <<= 1) v += __shfl_xor(v, o);
    return v;
}
template <int CTRL> __device__ __forceinline__ float dpp_mov(float v) { return __builtin_bit_cast(float, __builtin_amdgcn_update_dpp(0, __builtin_bit_cast(int, v), CTRL, 0xf, 0xf, true)); }
__device__ __forceinline__ float sum8_dpp(float v) { v += dpp_mov<0xB1>(v); v += dpp_mov<0x4E>(v); v += dpp_mov<0x141>(v); return v; }
__device__ __forceinline__ float sum16_dpp(float v) { v = sum8_dpp(v); v += dpp_mov<0x140>(v); return v; }

__device__ __forceinline__ float reduce4(const float (&v)[4], int) {
    float a0 = v[0], a2 = v[2], a1 = v[1], a3 = v[3];
    swap32(a0, a2); swap32(a1, a3);
    float A0 = a0 + a2, A1 = a1 + a3;
    swap16(A0, A1);
    const float c = A0 + A1;
    return sum16_dpp(c);
}

__device__ __forceinline__ void transpose_item(const float* W, int ldw, int K, bf16* WT, size_t drow0, LAS float* scr, int k0, int n0, int lane) {
#pragma unroll 8
    for (int i = 0; i < 32; ++i) { const int kk = 2 * i + (lane >> 5); scr[kk * 33 + (lane & 31)] = W[(size_t)(k0 + kk) * ldw + n0 + (lane & 31)]; }
    LDS_WAIT(); asm volatile("" ::: "memory");
    const int c = lane & 7;
#pragma unroll
    for (int j = 0; j < 4; ++j) { const int n = (lane >> 3) + 8 * j; const LAS float* s = scr + (8 * c) * 33 + n;
        u32x4 o; o.x = pk2(s[0 * 33], s[1 * 33]); o.y = pk2(s[2 * 33], s[3 * 33]); o.z = pk2(s[4 * 33], s[5 * 33]); o.w = pk2(s[6 * 33], s[7 * 33]);
        *(u32x4*)(WT + (drow0 + n) * K + k0 + 8 * c) = o; }
    LDS_WAIT(); asm volatile("" ::: "memory");
}
__device__ __forceinline__ void transpose_item8w(const float* W, int ldw, int K, unsigned char* WT8, size_t drow0, LAS float* scr, int k0, int n0, int lane) {
#pragma unroll 16
    for (int i = 0; i < 64; ++i) { const int kk = 2 * i + (lane >> 5); scr[kk * 33 + (lane & 31)] = __builtin_nontemporal_load(W + (size_t)(k0 + kk) * ldw + n0 + (lane & 31)); }
    LDS_WAIT(); asm volatile("" ::: "memory");
    const int n = lane & 31, kh = lane >> 5;
    unsigned char* op = WT8 + (drow0 + n) * K + k0 + 64 * kh;
#pragma unroll
    for (int q = 0; q < 4; ++q) { u32x4 o;
#pragma unroll
        for (int w = 0; w < 4; ++w) { const LAS float* p = scr + (64 * kh + 16 * q + 4 * w) * 33 + n; o[w] = pk4_fp8(p[0] * F8_W_SCALE, p[33] * F8_W_SCALE, p[66] * F8_W_SCALE, p[99] * F8_W_SCALE); }
        *(u32x4*)(op + 16 * q) = o; }
    LDS_WAIT(); asm volatile("" ::: "memory");
}
__device__ __forceinline__ void transpose_item8(const float* W, int ldw, int K, unsigned char* WT8, size_t drow0, LAS float* scr, int k0, int n0, int lane) {
#pragma unroll 8
    for (int i = 0; i < 32; ++i) { const int kk = 2 * i + (lane >> 5); scr[kk * 33 + (lane & 31)] = W[(size_t)(k0 + kk) * ldw + n0 + (lane & 31)]; }
    LDS_WAIT(); asm volatile("" ::: "memory");
    const int c = lane & 7;
#pragma unroll
    for (int j = 0; j < 4; ++j) { const int n = (lane >> 3) + 8 * j; const LAS float* s = scr + (8 * c) * 33 + n;
        u32x2 o; o.x = pk4_fp8(s[0 * 33] * F8_W_SCALE, s[1 * 33] * F8_W_SCALE, s[2 * 33] * F8_W_SCALE, s[3 * 33] * F8_W_SCALE); o.y = pk4_fp8(s[4 * 33] * F8_W_SCALE, s[5 * 33] * F8_W_SCALE, s[6 * 33] * F8_W_SCALE, s[7 * 33] * F8_W_SCALE);
        *(u32x2*)(WT8 + (drow0 + n) * K + k0 + 8 * c) = o; }
    LDS_WAIT(); asm volatile("" ::: "memory");
}
__device__ __forceinline__ void p0_prologue(const Ctx& C) {
    LAS float* sc = (LAS float*)(C.lds);
    LAS float* part = (LAS float*)(C.lds + 32768);
    for (int i = C.tid; i < 8192; i += 512) { const float cv = C.a->in[I_C][i]; sc[i] = cv / (1.f + __expf(-cv)); }
    __syncthreads();
    for (int it = blockIdx.x; it < 384; it += C.G) {
        const int l = it / 96, e0 = (it % 96) * 64;
        float acc[8];
#pragma unroll
        for (int b = 0; b < 8; ++b) acc[b] = 0.f;
        const float* wp = C.a->in[I_WADA] + ((size_t)l * 1024 + C.wave * 128) * 6144 + e0 + C.lane;
#pragma unroll 16
        for (int dd = 0; dd < 128; ++dd) { const float w = __builtin_nontemporal_load(wp + (size_t)dd * 6144);
#pragma unroll
            for (int b = 0; b < 8; ++b) acc[b] += sc[b * 1024 + C.wave * 128 + dd] * w; }
#pragma unroll
        for (int b = 0; b < 8; ++b) part[(C.wave * 8 + b) * 64 + C.lane] = acc[b];
        __syncthreads();
        { const int b = C.tid >> 6, col = C.tid & 63; float s = C.a->in[I_BADA][l * 6144 + e0 + col];
#pragma unroll
          for (int w = 0; w < 8; ++w) s += part[(w * 8 + b) * 64 + col];
          ((float*)(C.a->ws + WS_MOD))[((size_t)l * 8 + b) * 6144 + e0 + col] = s; }
        __syncthreads();
    }
    const int gt = blockIdx.x * 512 + C.tid, NGT = C.G * 512;
    for (int i = gt; i < 4 * 36 * 1024; i += NGT) { const int l = i / (36 * 1024), jj = (i >> 10) % 36, d = i & 1023;
        const float v = jj < 4 ? C.a->in[I_RGW][((size_t)l * 1024 + d) * 4 + jj] : C.a->in[I_REW][((size_t)l * 1024 + d) * 32 + (jj - 4)];
        ((bf16*)(C.a->ws + WS_WR))[i] = (bf16)f2bf(v); }
    for (int i = gt; i < 2 * 16 * 1024; i += NGT) { const int ii = i >> 14, r = (i >> 10) & 15, d = i & 1023;
        ((bf16*)(C.a->ws + WS_WBG))[i] = (bf16)f2bf(C.a->in[I_EWIN][((size_t)ii * 1024 + d) * 3088 + 3072 + r]); }
    for (int i = gt; i < 256; i += NGT) ((unsigned*)(C.a->ws + WS_H8 + (size_t)NTOK * DM))[i] = 0u;
    LAS float* scr = (LAS float*)(C.lds + C.wave * 16896);
    const int gw = C.vcu * 8 + C.wave, NGW = C.G * 8;
    constexpr int I_IN = 16 * 96, I_OUT = 16 * 16, I_E = 128;
    constexpr int NITEMS = 4 * I_IN + 4 * I_OUT + 3 * 128 * I_E;
    for (int it = gw; it < NITEMS; it += NGW) {
        int r = it;
        if (r < 4 * I_IN) { const int l = r / I_IN, q = r % I_IN, kb = q / 96, nb = q % 96; const int i = l >> 1;
            const float* W = (l & 1) ? C.a->in[I_OWIN] + (size_t)i * 1024 * 3072 : C.a->in[I_EWIN] + (size_t)i * 1024 * 3088;
            transpose_item(W, (l & 1) ? 3072 : 3088, 1024, ((bf16*)(C.a->ws + WS_WIN)) + (size_t)l * 3072 * 1024, (size_t)nb * 32, scr, kb * 64, nb * 32, C.lane); continue; }
        r -= 4 * I_IN;
        if (r < 4 * I_OUT) { const int l = r / I_OUT, q = r % I_OUT, kb = q / 32, nb = q % 32; const int i = l >> 1;
            const float* W = ((l & 1) ? C.a->in[I_OWOUT] : C.a->in[I_EWOUT]) + (size_t)i * 1024 * 1024;
            transpose_item8w(W, 1024, 1024, (unsigned char*)(C.a->ws + WS_WOUT) + (size_t)l * 1024 * 1024, (size_t)nb * 32, scr, kb * 128, nb * 32, C.lane); continue; }
        r -= 4 * I_OUT;
        const int job = r / I_E, q = r % I_E, typ = job / 128, le = job % 128;
        if (typ < 2) { const int kb = q / 16, nb = q % 16, n0 = nb * 32;
            const float* W = C.a->in[typ == 0 ? I_WG : I_WU] + (size_t)le * 1024 * 512;
            const size_t drow0 = (size_t)(n0 >> 7) * 256 + (n0 & 127) + (typ ? 128 : 0);
            transpose_item8w(W, 512, 1024, ((unsigned char*)(C.a->ws + WS_WGU)) + (size_t)le * 1024 * 1024, drow0, scr, kb * 128, n0, C.lane);
        } else { const int kb = q / 32, nb = q % 32;
            const float* W = C.a->in[I_WDN] + (size_t)le * 512 * 1024;
            transpose_item8w(W, 1024, 512, ((unsigned char*)(C.a->ws + WS_WD)) + (size_t)le * 1024 * 512, (size_t)nb * 32, scr, kb * 128, nb * 32, C.lane); }
    }
}

template <bool COMBINE, int EXTRA, bool FINAL, bool XIN_F32>
__device__ __forceinline__ void norm_phase(const Ctx& C, int l, const float* xin, const float* normw, int shift_chunk, const bf16* WX) {
    constexpr int NX = EXTRA == 1 ? 16 : (EXTRA == 2 ? 36 : 0);
    constexpr int NR = 4;
    constexpr int NCB = (NX + 15) / 16;
    constexpr int WPITCH = 2064;
    LAS unsigned char* wl = C.lds;
    LAS unsigned char* atile = C.lds + 99072 + C.wave * 4160;
    LAS float* lgbase = (LAS float*)(C.lds + 99072 + 8 * 4160);
    LAS int* ent_p = (LAS int*)(C.lds + 99072 + 8 * 4160 + 8 * 768);
    LAS int* ent_e = ent_p + 256;
    LAS float* ent_w = (LAS float*)(ent_e + 256);
    LAS int* lcnt = (LAS int*)(ent_w + 256);
    LAS int* lbase = lcnt + 32;
    LAS int* erank = lbase + 32;
    if (EXTRA) { for (int i = C.tid; i < NCB * 16 * 128; i += 512) { const int row = i >> 7, c16 = i & 127;
            *(LAS u32x4*)(wl + row * WPITCH + c16 * 16) = row < NX ? ((const u32x4*)WX)[i] : (u32x4){0u, 0u, 0u, 0u}; }
        if (EXTRA == 2) { if (C.tid < 32) lcnt[C.tid] = 0; }
        __syncthreads(); }
    const int gw = C.vcu * 8 + C.wave, NGW = C.G * 8, lane = C.lane;
    float* X = C.a->out; bf16* XBp = (bf16*)(C.a->ws + WS_XB); bf16* Hb = (bf16*)(C.a->ws + WS_H); const bf16* Yb = (const bf16*)(C.a->ws + WS_QKV); const float* MOD = (const float*)(C.a->ws + WS_MOD);
    int pass = 0;
    for (int rg = gw; rg < NTOK / NR; rg += NGW, ++pass) {
        const int t0 = rg * NR, b = t0 >> 12;
        f32x4 v[NR][4];
#pragma unroll
        for (int r = 0; r < NR; ++r)
#pragma unroll
            for (int j = 0; j < 4; ++j) {
                if (XIN_F32) v[r][j] = *(const f32x4*)(xin + (size_t)(t0 + r) * DM + 4 * lane + 256 * j);
                else { const u32x2 xr = *(const u32x2*)(XBp + (size_t)(t0 + r) * DM + 4 * lane + 256 * j); v[r][j] = (f32x4){bflo(xr.x), bfhi(xr.x), bflo(xr.y), bfhi(xr.y)}; } }
        if (COMBINE) {
            const float* g2p = MOD + ((size_t)((FINAL ? 3 : l - 1) * 8 + b)) * 6144 + 5 * 1024;
            int y0[NR][4], y1[NR][4]; f32x4 g2[4];
#pragma unroll
            for (int j = 0; j < 4; ++j) { g2[j] = *(const f32x4*)(g2p + 4 * lane + 256 * j);
#pragma unroll
                for (int r = 0; r < NR; ++r) { y0[r][j] = *(const int*)((const unsigned char*)Yb + (size_t)(2 * (t0 + r)) * DM + 4 * lane + 256 * j);
                    y1[r][j] = *(const int*)((const unsigned char*)Yb + (size_t)(2 * (t0 + r) + 1) * DM + 4 * lane + 256 * j); } }
#pragma unroll
            for (int j = 0; j < 4; ++j)
#pragma unroll
                for (int r = 0; r < NR; ++r) {
                    const f32x2 a0 = __builtin_amdgcn_cvt_pk_f32_fp8(y0[r][j], false), a1 = __builtin_amdgcn_cvt_pk_f32_fp8(y0[r][j], true), b0 = __builtin_amdgcn_cvt_pk_f32_fp8(y1[r][j], false), b1 = __builtin_amdgcn_cvt_pk_f32_fp8(y1[r][j], true);
                    f32x4 ys; ys[0] = (a0[0] + b0[0]) * (1.f / 32.f); ys[1] = (a0[1] + b0[1]) * (1.f / 32.f); ys[2] = (a1[0] + b1[0]) * (1.f / 32.f); ys[3] = (a1[1] + b1[1]) * (1.f / 32.f);
                    v[r][j] = v[r][j] + g2[j] * ys; }
            if (!FINAL) {
#pragma unroll
                for (int j = 0; j < 4; ++j)
#pragma unroll
                    for (int r = 0; r < NR; ++r) { u32x2 xo; xo.x = cvt_pk_bf16(v[r][j][0], v[r][j][1]); xo.y = cvt_pk_bf16(v[r][j][2], v[r][j][3]); *(u32x2*)(XBp + (size_t)(t0 + r) * DM + 4 * lane + 256 * j) = xo; } }
        }
        float ss[NR];
#pragma unroll
        for (int r = 0; r < NR; ++r) { float s_ = 0.f;
#pragma unroll
            for (int j = 0; j < 4; ++j) s_ += (v[r][j][0] * v[r][j][0] + v[r][j][1] * v[r][j][1]) + (v[r][j][2] * v[r][j][2] + v[r][j][3] * v[r][j][3]);
            ss[r] = s_; }
        const float red = reduce4(ss, lane);
        const float rstd_l = 1.0f / sqrtf(red * (1.f / DM) + EPS);
        float rs[NR];
#pragma unroll
        for (int r = 0; r < NR; ++r) rs[r] = __builtin_bit_cast(float, __builtin_amdgcn_readlane(__builtin_bit_cast(int, rstd_l), 16 * r));
        if (FINAL) {
#pragma unroll
            for (int j = 0; j < 4; ++j) { const f32x4 gn = *(const f32x4*)(normw + 4 * lane + 256 * j);
#pragma unroll
                for (int r = 0; r < NR; ++r) v[r][j] = v[r][j] * rs[r] * gn; }
#pragma unroll
            for (int j = 0; j < 4; ++j)
#pragma unroll
                for (int r = 0; r < NR; ++r) *(f32x4*)(X + (size_t)(t0 + r) * DM + 4 * lane + 256 * j) = v[r][j];
            continue;
        }
        u32x2 hp[NR][4];
        const float* mp = MOD + ((size_t)(l * 8 + b)) * 6144 + (size_t)shift_chunk * 1024;
#pragma unroll
        for (int j = 0; j < 4; ++j) { const f32x4 sh = *(const f32x4*)(mp + 4 * lane + 256 * j), scl = *(const f32x4*)(mp + 1024 + 4 * lane + 256 * j);
            const f32x4 gn = *(const f32x4*)(normw + (size_t)l * DM + 4 * lane + 256 * j); const f32x4 cmb = gn * (scl + 1.0f);
#pragma unroll
            for (int r = 0; r < NR; ++r) v[r][j] = v[r][j] * rs[r] * cmb + sh; }
#pragma unroll
        for (int j = 0; j < 4; ++j) {
#pragma unroll
            for (int r = 0; r < NR; ++r) {
                u32x2 o; o.x = cvt_pk_bf16(v[r][j][0], v[r][j][1]); o.y = cvt_pk_bf16(v[r][j][2], v[r][j][3]); hp[r][j] = o;
                if (EXTRA == 2) *(unsigned*)(C.a->ws + WS_H8 + (size_t)(t0 + r) * DM + 4 * lane + 256 * j) = pk4_fp8(v[r][j][0] * F8_ACT_SCALE, v[r][j][1] * F8_ACT_SCALE, v[r][j][2] * F8_ACT_SCALE, v[r][j][3] * F8_ACT_SCALE);
                else *(u32x2*)(Hb + (size_t)(t0 + r) * DM + 4 * lane + 256 * j) = o; } }
        if (EXTRA) {
            LAS float* lgb = lgbase + C.wave * (NR * 48);
            const int l15 = lane & 15, quad = lane >> 4;
            f32x4 lacc[NCB > 0 ? NCB : 1];
#pragma unroll
            for (int cb = 0; cb < NCB; ++cb) lacc[cb] = (f32x4){0.f, 0.f, 0.f, 0.f};
#pragma unroll
            for (int half = 0; half < 2; ++half) {
#pragma unroll
                for (int r = 0; r < NR; ++r)
#pragma unroll
                    for (int jl = 0; jl < 2; ++jl) *(LAS u32x2*)(atile + r * 1040 + (4 * lane + 256 * jl) * 2) = hp[r][2 * half + jl];
                LDS_WAIT();
#pragma unroll 4
                for (int ks = 0; ks < 16; ++ks) { const bf16x8 af = *(const LAS bf16x8*)(atile + (l15 & 3) * 1040 + (8 * quad + 32 * ks) * 2);
#pragma unroll
                    for (int cb = 0; cb < NCB; ++cb) { const bf16x8 bfv = *(const LAS bf16x8*)(wl + (16 * cb + l15) * WPITCH + (512 * half + 8 * quad + 32 * ks) * 2);
                        lacc[cb] = __builtin_amdgcn_mfma_f32_16x16x32_bf16(af, bfv, lacc[cb], 0, 0, 0); } }
                LDS_WAIT();
            }
            if (quad == 0) {
#pragma unroll
                for (int cb = 0; cb < NCB; ++cb)
#pragma unroll
                    for (int jj = 0; jj < 4; ++jj) lgb[jj * 48 + 16 * cb + l15] = lacc[cb][jj]; }
            LDS_WAIT();
            float lg[NX > 0 ? NX : 1];
#pragma unroll
            for (int jj = 0; jj < NX; ++jj) lg[jj] = lgb[(lane >> 4) * 48 + jj];
            const int row = lane >> 4, tok = t0 + row;
            if (EXTRA == 1) {
                if ((lane & 15) == 0) { float* BGp = (float*)(C.a->ws + WS_BG);
#pragma unroll
                    for (int q = 0; q < 4; ++q) *(f32x4*)(BGp + (size_t)tok * 16 + 4 * q) = (f32x4){lg[4 * q], lg[4 * q + 1], lg[4 * q + 2], lg[4 * q + 3]}; }
            } else {
                float gl[4];
#pragma unroll
                for (int q = 0; q < 4; ++q) gl[q] = lg[q] + C.a->in[I_RGB][l * 4 + q];
                int gs = 0; float gm = gl[0];
#pragma unroll
                for (int q = 1; q < 4; ++q) if (gl[q] > gm) { gm = gl[q]; gs = q; }
                float gsum = 0.f;
#pragma unroll
                for (int q = 0; q < 4; ++q) gsum += __expf(gl[q] - gm);
                const float gval = 1.0f / gsum;
                float el[8];
#pragma unroll
                for (int q = 0; q < 8; ++q) { const float e0 = lg[4 + q], e1 = lg[12 + q], e2 = lg[20 + q], e3 = lg[28 + q];
                    el[q] = (gs == 0 ? e0 : (gs == 1 ? e1 : (gs == 2 ? e2 : e3))) + C.a->in[I_REB][l * 32 + gs * 8 + q]; }
                int i0 = 0; float m0 = el[0];
#pragma unroll
                for (int q = 1; q < 8; ++q) if (el[q] > m0) { m0 = el[q]; i0 = q; }
                int i1 = -1; float m1 = -3.0e38f;
#pragma unroll
                for (int q = 0; q < 8; ++q) if (q != i0 && el[q] > m1) { m1 = el[q]; i1 = q; }
                const float w0 = gval / (1.0f + __expf(m1 - m0)), w1 = gval - w0;
                if ((lane & 15) == 0) { const int ei = (pass * 8 + C.wave) * 8 + row * 2;
                    ent_p[ei] = tok * 2; ent_e[ei] = gs * 8 + i0; ent_w[ei] = w0;
                    ent_p[ei + 1] = tok * 2 + 1; ent_e[ei + 1] = gs * 8 + i1; ent_w[ei + 1] = w1; }
            }
        }
    }
    if (EXTRA == 2) {
        __syncthreads();
        const int npass_blk = (NTOK / NR - C.vcu * 8 + NGW - 1) / NGW;
        const int nent = npass_blk * 64;
        int* gcnt = (int*)(C.a->ws + WS_CTL) + CW_CNT + 64 * l;
        int* PL = (int*)(C.a->ws + WS_PLIST); float* WL = (float*)(C.a->ws + WS_WLIST);
        for (int i = C.tid; i < nent; i += 512) { const int p_ = i >> 6, w_ = (i >> 3) & 7; const bool valid = (C.vcu * 8 + w_ + p_ * NGW) < NTOK / NR;
            if (valid) erank[i] = atomicAdd((int*)&lcnt[ent_e[i]], 1); else erank[i] = -1; }
        __syncthreads();
        if (C.tid < 32) lbase[C.tid] = __hip_atomic_fetch_add(gcnt + C.tid, lcnt[C.tid], __ATOMIC_RELAXED, __HIP_MEMORY_SCOPE_AGENT);
        __syncthreads();
        for (int i = C.tid; i < nent; i += 512) { const int rk = erank[i]; if (rk >= 0) { const int e = ent_e[i]; const int pos = lbase[e] + rk;
            PL[(size_t)e * NTOK + pos] = ent_p[i]; WL[(size_t)e * NTOK + pos] = ent_w[i]; } }
    }
    __syncthreads();
}

typedef short v4i16_t __attribute__((ext_vector_type(4)));
__device__ __forceinline__ s16x4 vtr(const LAS unsigned char* p) { return __builtin_bit_cast(s16x4, __builtin_amdgcn_ds_read_tr16_b64_v4i16((LAS v4i16_t*)p)); }
__device__ __forceinline__ float pl32_other(float m, int hi) { float a = m, b = m; swap32(a, b); return hi ? a : b; }
__device__ __forceinline__ float pl32_max(float m) { float a = m, b = m; swap32(a, b); return fmaxf(a, b); }
__device__ __forceinline__ float pl32_sum(float m) { float a = m, b = m; swap32(a, b); return a + b; }
__device__ __forceinline__ int t5_bucket(int rel) { const int n = rel < 0 ? -rel : rel;
    const int bk = n < 8 ? n : (n < 12 ? 8 : (n < 16 ? 9 : (n < 23 ? 10 : (n < 32 ? 11 : (n < 46 ? 12 : (n < 64 ? 13 : (n < 91 ? 14 : 15)))))));
    return bk + (rel > 0 ? 16 : 0); }

__device__ __forceinline__ int kswz(int row, int c) { return row * 128 + ((c ^ ((row >> 1) & 7)) << 4); }

__device__ __forceinline__ void diffattn_unit(const Ctx& C, int l, int b, int h, int qb, float lam, float lam_init) {
    LAS unsigned char* lds = C.lds;
    const int tid = C.tid, lane = C.lane, wave = C.wave, r32 = lane & 31, hi = lane >> 5, qt = wave & 3, m = wave >> 2;
    const int i16 = lane & 15, q4 = i16 >> 2, p4 = i16 & 3, half16 = (lane >> 4) & 1;
    const size_t tokbase = (size_t)b * SEQ; const int q0 = qb * 128, c0 = q0 >> 6, ntile = c0 + 2, cw = c0 + (qt >> 1);
    LAS float* lut = (LAS float*)(lds + 131072);
    const float rb15 = C.a->in[I_RELB][15 * 4 + h], rbt = C.a->in[I_RELB][t5_bucket((tid < 255 ? tid : 254) - 191) * 4 + h];
    const float b15 = rb15 * LOG2E;
    if (tid < 255) lut[tid] = rbt * LOG2E - b15;
    const bf16* qp = ((bf16*)(C.a->ws + WS_QKV)) + (tokbase + q0 + 32 * qt + r32) * QKVW + E_AQ + h * 128 + m * 64 + 8 * hi;
    bf16x8 qr[4];
#pragma unroll
    for (int d0 = 0; d0 < 4; ++d0) qr[d0] = *(const bf16x8*)(qp + 16 * d0);
    unsigned koff[2], voff[2];
#pragma unroll
    for (int i = 0; i < 2; ++i) { const int p = wave * 128 + i * 64 + lane;
        { const int mm = p >> 9, pp = p & 511, row = pp >> 3, pc = pp & 7, c = pc ^ ((row >> 1) & 7); koff[i] = (unsigned)((row * QKVW + E_AK + h * 128 + mm * 64 + c * 8) * 2); }
        { const int blk = p >> 8, row = (p >> 2) & 63, c4 = p & 3; voff[i] = (unsigned)((row * QKVW + E_AV + h * 128 + blk * 32 + c4 * 8) * 2); } }
    const unsigned ldsb = (unsigned)__builtin_amdgcn_readfirstlane((int)(unsigned)(uintptr_t)lds) + (unsigned)wave * 2048u;
    const char* tilebase = (const char*)(C.a->ws + WS_QKV) + tokbase * (size_t)(QKVW * 2);
#define DA_DMA(j, bi) do { const char* tb_ = tilebase + (size_t)(j) * (64 * QKVW * 2); const unsigned db_ = ldsb + (unsigned)(bi) * 32768u; \
        pg8::glds_s(tb_, koff[0], db_); pg8::glds_s(tb_, koff[1], db_ + 1024u); pg8::glds_s(tb_, voff[0], db_ + 16384u); pg8::glds_s(tb_, voff[1], db_ + 16384u + 1024u); } while (0)
    f32x16 o[4];
#pragma unroll
    for (int k = 0; k < 4; ++k)
#pragma unroll
        for (int i = 0; i < 16; ++i) o[k][i] = 0.f;
    float lsum = 0.f;
    f32x16 negm;
#pragma unroll
    for (int i = 0; i < 16; ++i) negm[i] = b15;
    __syncthreads();
    DA_DMA(0, 0); DA_DMA(1, 1);
    asm volatile("s_waitcnt vmcnt(4)" ::: "memory");
    __builtin_amdgcn_s_barrier(); asm volatile("" ::: "memory");
#define DA_LDV(vb_, s) do { _Pragma("unroll") for (int k = 0; k < 4; ++k) { va[s][k][0] = vtr((vb_) + k * 4096 + (s) * 1024); va[s][k][1] = vtr((vb_) + k * 4096 + (s) * 1024 + 512); } } while (0)
#define DA_PVS(s) do { const bf16x8 pf = __builtin_bit_cast(bf16x8, pwh[s]); _Pragma("unroll") for (int k = 0; k < 4; ++k) { const s16x4 lo = va[s][k][0], hh = va[s][k][1]; \
                const bf16x8 vf = (bf16x8){lo[0], lo[1], lo[2], lo[3], hh[0], hh[1], hh[2], hh[3]}; o[k] = __builtin_amdgcn_mfma_f32_32x32x16_bf16(vf, pf, o[k], 0, 0, 0); } } while (0)
#define DA_PV(vb_) do { s16x4 va[4][4][2]; DA_LDV(vb_, 0); DA_LDV(vb_, 1); __builtin_amdgcn_sched_barrier(0); \
        DA_PVS(0); DA_LDV(vb_, 2); __builtin_amdgcn_sched_barrier(0); DA_PVS(1); DA_LDV(vb_, 3); __builtin_amdgcn_sched_barrier(0); DA_PVS(2); DA_PVS(3); } while (0)
    u32x4 pwh[4]; int pbi = -1;
#pragma unroll
    for (int s = 0; s < 4; ++s) pwh[s] = (u32x4){0u, 0u, 0u, 0u};
    for (int j = 0; j < ntile; ++j) {
        const int bi = j & 3;
        if (j + 2 < ntile) { DA_DMA(j + 2, (j + 2) & 3); }
        if (pbi >= 0) {
            const LAS unsigned char* vp = lds + pbi * 32768 + 16384 + half16 * 32 + p4 * 8 + (4 * hi + q4) * 64;
            DA_PV(vp); pbi = -1; }
        if (j <= cw) {
            const LAS unsigned char* kb = lds + bi * 32768 + m * 8192;
            bf16x8 ka[4][2];
#pragma unroll
            for (int d0 = 0; d0 < 4; ++d0) { const int c = 2 * d0 + hi; ka[d0][0] = *(const LAS bf16x8*)(kb + kswz(r32, c)); ka[d0][1] = *(const LAS bf16x8*)(kb + kswz(32 + r32, c)); }
            __builtin_amdgcn_sched_barrier(0);
            f32x16 s0 = negm, s1 = negm;
#pragma unroll
            for (int d0 = 0; d0 < 4; ++d0) {
                s0 = __builtin_amdgcn_mfma_f32_32x32x16_bf16(ka[d0][0], qr[d0], s0, 0, 0, 0); s1 = __builtin_amdgcn_mfma_f32_32x32x16_bf16(ka[d0][1], qr[d0], s1, 0, 0, 0); }
            if (j + 2 >= cw) { const int base = 64 * j - (q0 + 32 * qt + r32) + 191;
#pragma unroll
                for (int i = 0; i < 16; ++i) { const int kv = crow(i, hi); s0[i] += lut[base + kv]; s1[i] += lut[base + kv + 32]; } }
            float tm = fmaxf(fmaxf(s0[0], s0[1]), s1[0]);
#pragma unroll
            for (int i = 1; i < 16; ++i) tm = fmaxf(fmaxf(tm, s0[i]), s1[i]);
            tm = fmaxf(tm, s0[1]);
            tm = pl32_max(tm);
            if (__any(tm > 8.f) || j == 0) { const float dl = (j == 0) ? tm : fmaxf(tm, 0.f); const float f = ex2(-dl);
                lsum *= f;
#pragma unroll
                for (int k = 0; k < 4; ++k)
#pragma unroll
                    for (int i = 0; i < 16; ++i) o[k][i] *= f;
#pragma unroll
                for (int i = 0; i < 16; ++i) { s0[i] -= dl; s1[i] -= dl; negm[i] -= dl; } }
            float ps = 0.f;
#pragma unroll
            for (int i = 0; i < 16; ++i) { s0[i] = ex2(s0[i]); s1[i] = ex2(s1[i]); ps += s0[i] + s1[i]; }
            lsum += ps;
#pragma unroll
            for (int s = 0; s < 2; ++s) {
                pwh[s].x = cvt_pk_bf16(s0[8 * s + 0], s0[8 * s + 1]); pwh[s].y = cvt_pk_bf16(s0[8 * s + 2], s0[8 * s + 3]); pwh[s].z = cvt_pk_bf16(s0[8 * s + 4], s0[8 * s + 5]); pwh[s].w = cvt_pk_bf16(s0[8 * s + 6], s0[8 * s + 7]);
                pwh[2 + s].x = cvt_pk_bf16(s1[8 * s + 0], s1[8 * s + 1]); pwh[2 + s].y = cvt_pk_bf16(s1[8 * s + 2], s1[8 * s + 3]); pwh[2 + s].z = cvt_pk_bf16(s1[8 * s + 4], s1[8 * s + 5]); pwh[2 + s].w = cvt_pk_bf16(s1[8 * s + 6], s1[8 * s + 7]); }
            if (m == 0) { const LAS unsigned char* vb = lds + bi * 32768 + 16384 + half16 * 32 + p4 * 8 + (4 * hi + q4) * 64; DA_PV(vb); }
            else pbi = bi;
        }
        if (j + 2 < ntile) asm volatile("s_waitcnt vmcnt(4) lgkmcnt(0)" ::: "memory"); else asm volatile("s_waitcnt vmcnt(0) lgkmcnt(0)" ::: "memory");
        __builtin_amdgcn_s_barrier(); asm volatile("" ::: "memory");
    }
    if (pbi >= 0) { const LAS unsigned char* vp = lds + pbi * 32768 + 16384 + half16 * 32 + p4 * 8 + (4 * hi + q4) * 64; DA_PV(vp); }
    __syncthreads();
#undef DA_LDV
#undef DA_PVS
#undef DA_PV
#undef DA_DMA
    const float linv = 1.0f / pl32_sum(lsum);
    LAS float* ox = (LAS float*)lds + qt * 4096;
    if (m == 1) {
#pragma unroll
        for (int k = 0; k < 4; ++k)
#pragma unroll
            for (int i = 0; i < 16; ++i) ox[(k * 16 + i) * 64 + lane] = o[k][i] * linv;
    }
    __syncthreads();
    if (m == 0) {
        float ssq = 0.f;
#pragma unroll
        for (int k = 0; k < 4; ++k)
#pragma unroll
            for (int i = 0; i < 16; ++i) { const float v = o[k][i] * linv - lam * ox[(k * 16 + i) * 64 + lane]; o[k][i] = v; ssq += v * v; }
        ssq = pl32_sum(ssq);
        const float rstd = (1.0f / sqrtf(ssq * (1.f / 128.f) + EPS)) * (1.0f - lam_init) * F8_ACT_SCALE;
        unsigned char* op = (unsigned char*)(C.a->ws + WS_O) + (tokbase + q0 + 32 * qt + r32) * DM + h * 128;
        const float* sg = C.a->in[I_ESUBLN] + (l >> 1) * 128; unsigned pko[4][4];
#pragma unroll
        for (int k = 0; k < 4; ++k)
#pragma unroll
            for (int g = 0; g < 4; ++g) { const int dv = 32 * k + 8 * g + 4 * hi; const f32x4 gg = *(const f32x4*)(sg + dv);
                pko[k][g] = pk4_fp8(o[k][4 * g] * rstd * gg[0], o[k][4 * g + 1] * rstd * gg[1], o[k][4 * g + 2] * rstd * gg[2], o[k][4 * g + 3] * rstd * gg[3]); }
#pragma unroll
        for (int k = 0; k < 4; ++k)
#pragma unroll
            for (int g = 0; g < 4; ++g) { const int dv = 32 * k + 8 * g + 4 * hi; *(unsigned*)(op + dv) = pko[k][g]; }
    }
    __syncthreads();
}

__device__ __forceinline__ void gla_local_unit(const Ctx& C, int l, int b, int h, int oct) {
    LAS unsigned char* lds = C.lds;
    constexpr int PT = 144;
    constexpr int SET = 46080;
    LAS unsigned char* PP = lds + 2 * SET;
    LAS unsigned char* OUT = PP + 9216;
    LAS float* GT = (LAS float*)(OUT + 18432);
    LAS float* AD = GT + 512;
    LAS float* BGL = AD + 128 + 512;
    const int tid = C.tid, lane = C.lane, wave = C.wave, l15 = lane & 15, quad = lane >> 4;
    const int i = l >> 1; const size_t tokbase = (size_t)b * SEQ; const int cfirst = oct * 8;
    const int d = tid & 63; const int tg = wave;
    const bf16* QKV = (const bf16*)(C.a->ws + WS_QKV); const float* BGg = (const float*)(C.a->ws + WS_BG);
    const size_t item0 = ((size_t)(b * 4 + h)) * 64;
    float w2[16];
#pragma unroll
    for (int r = 0; r < 16; ++r) w2[r] = C.a->in[I_EGK2][((size_t)i * 16 + r) * 256 + h * 64 + d];
    const float bgk = C.a->in[I_EBGK][i * 256 + h * 64 + d];
    const int e0 = 16 * wave;
    const int ot = tid >> 3, oj = tid & 7;
    unsigned short qraw[8], kraw[8]; u32x4 vraw[2]; f32x4 bgreg = (f32x4){0.f, 0.f, 0.f, 0.f};
    float cs[8];
#define GLA_LOAD_QKV(c_) do { const size_t tk0_ = tokbase + 64 * (size_t)(c_); \
        _Pragma("unroll") for (int t = 0; t < 8; ++t) { const size_t tk = tk0_ + 8 * tg + t; qraw[t] = QKV[tk * QKVW + E_BQ + h * 64 + d]; kraw[t] = QKV[tk * QKVW + E_BK + h * 64 + d]; } \
        _Pragma("unroll") for (int ii = 0; ii < 2; ++ii) { const int id = tid + 512 * ii, s_ = id >> 4, c8 = id & 15; vraw[ii] = *(const u32x4*)(QKV + (tk0_ + s_) * QKVW + E_BV + h * 128 + 8 * c8); } } while (0)
#define GLA_LOAD_BG(c_) do { if (tid < 256) bgreg = *(const f32x4*)(BGg + (tokbase + 64 * (size_t)(c_) + (tid >> 2)) * 16 + (tid & 3) * 4); } while (0)
#define GLA_STORE_BG(slot) do { if (tid < 256) *(LAS f32x4*)(BGL + (slot) * 1024 + (tid >> 2) * 16 + (tid & 3) * 4) = bgreg; } while (0)
#define GLA_PREP1(slot) do { float run = 0.f; \
        _Pragma("unroll") for (int t = 0; t < 8; ++t) { const LAS float* bgp = BGL + (slot) * 1024 + (8 * tg + t) * 16; float z = bgk; \
            _Pragma("unroll") for (int q_ = 0; q_ < 4; ++q_) { const f32x4 bv = *(const LAS f32x4*)(bgp + 4 * q_); z += bv[0] * w2[4 * q_] + bv[1] * w2[4 * q_ + 1] + bv[2] * w2[4 * q_ + 2] + bv[3] * w2[4 * q_ + 3]; } \
            const float ls = fminf(z, 0.f) - __logf(1.f + __expf(-fabsf(z))); run += ls * (1.f / 16.f); cs[t] = run; } \
        GT[tg * 64 + d] = run; } while (0)
#define GLA_PREP2(setp, adslot) do { LAS unsigned char* QD_ = (setp); LAS unsigned char* KI_ = (setp) + 9216; LAS unsigned char* KDT_ = (setp) + 18432; LAS unsigned char* VT_ = (setp) + 27648; \
        float pre = 0.f, tot = 0.f; \
        _Pragma("unroll") for (int g = 0; g < 8; ++g) { const float x = GT[g * 64 + d]; tot += x; if (g < tg) pre += x; } \
        float kd[8]; const float etot = __expf(tot); \
        _Pragma("unroll") for (int t = 0; t < 8; ++t) { const float bb = pre + cs[t]; const float qv = bf2f(qraw[t]), kv = bf2f(kraw[t]); \
            const float eb = __expf(bb), ib = __builtin_amdgcn_rcpf(eb); \
            *(LAS unsigned short*)(QD_ + (8 * tg + t) * PT + d * 2) = (unsigned short)cvt1_bf16(qv * eb); \
            *(LAS unsigned short*)(KI_ + (8 * tg + t) * PT + d * 2) = (unsigned short)cvt1_bf16(kv * ib); \
            kd[t] = kv * (etot * ib); } \
        u32x4 kdw; kdw.x = cvt_pk_bf16(kd[0], kd[1]); kdw.y = cvt_pk_bf16(kd[2], kd[3]); kdw.z = cvt_pk_bf16(kd[4], kd[5]); kdw.w = cvt_pk_bf16(kd[6], kd[7]); \
        *(LAS u32x4*)(KDT_ + d * PT + 16 * tg) = kdw; \
        if (tg == 0) AD[(adslot) * 64 + d] = etot; \
        _Pragma("unroll") for (int ii = 0; ii < 2; ++ii) { const int id = tid + 512 * ii, s_ = id >> 4, c8 = id & 15; \
            _Pragma("unroll") for (int jj = 0; jj < 8; ++jj) *(LAS unsigned short*)(VT_ + (8 * c8 + jj) * PT + s_ * 2) = (unsigned short)((vraw[ii][jj >> 1] >> ((jj & 1) * 16)) & 0xffffu); } } while (0)
    f32x4 agg[4];
#pragma unroll
    for (int db = 0; db < 4; ++db) agg[db] = (f32x4){0.f, 0.f, 0.f, 0.f};
    float aprod = 1.f;
    const int clast = cfirst + 7;
    GLA_LOAD_BG(cfirst); GLA_STORE_BG(0); GLA_LOAD_BG(cfirst + 1); GLA_STORE_BG(1);
    GLA_LOAD_QKV(cfirst);
    __syncthreads();
    GLA_PREP1(0);
    __syncthreads();
    GLA_PREP2(lds, 0);
    GLA_LOAD_QKV(cfirst + 1); GLA_LOAD_BG(cfirst + 2);
    __syncthreads();
    for (int cc = 0; cc < 8; ++cc) {
        const int c = cfirst + cc; const size_t item = item0 + c;
        const int cb = cc & 1, nb = cb ^ 1;
        LAS unsigned char* QD = lds + cb * SET; LAS unsigned char* KI = QD + 9216; LAS unsigned char* KDT = QD + 18432; LAS unsigned char* VT = QD + 27648;
        GLA_STORE_BG(cb);
        if (cc + 1 < 8) GLA_PREP1(nb);
        { const int tb = wave >> 1;
#pragma unroll
          for (int sq = 0; sq < 2; ++sq) { const int sb = 2 * (wave & 1) + sq; f32x4 sc = (f32x4){0.f, 0.f, 0.f, 0.f};
              if (sb <= tb) {
#pragma unroll
                  for (int ks = 0; ks < 2; ++ks) { const bf16x8 a = *(const LAS bf16x8*)(QD + (16 * tb + l15) * PT + (8 * quad + 32 * ks) * 2), bb = *(const LAS bf16x8*)(KI + (16 * sb + l15) * PT + (8 * quad + 32 * ks) * 2);
                      sc = __builtin_amdgcn_mfma_f32_16x16x32_bf16(a, bb, sc, 0, 0, 0); } }
#pragma unroll
              for (int jj = 0; jj < 4; ++jj) { const int t = 16 * tb + 4 * quad + jj, s_ = 16 * sb + l15; const float v = (s_ <= t) ? sc[jj] : 0.f;
                  *(LAS unsigned short*)(PP + t * PT + s_ * 2) = (unsigned short)cvt1_bf16(v); } } }
        { const u32x4 qv = *(const LAS u32x4*)(QD + ot * PT + oj * 16); *(u32x4*)((bf16*)(C.a->ws + WS_GQD) + item * 4096 + ot * 64 + oj * 8) = qv;
          if (tid < 64) { const float ad_ = AD[cb * 64 + tid]; ((float*)(C.a->ws + WS_GAD))[item * 64 + tid] = ad_; aprod *= ad_; } }
        LBAR();
        if (cc + 1 < 8) GLA_PREP2(lds + nb * SET, nb);
        bf16x8 vfrag[2], pq_[4][2], kq_[4][2];
#pragma unroll
        for (int ks = 0; ks < 2; ++ks) { vfrag[ks] = *(const LAS bf16x8*)(VT + (e0 + l15) * PT + (8 * quad + 32 * ks) * 2);
#pragma unroll
            for (int tb = 0; tb < 4; ++tb) { pq_[tb][ks] = *(const LAS bf16x8*)(PP + (16 * tb + l15) * PT + (8 * quad + 32 * ks) * 2); kq_[tb][ks] = *(const LAS bf16x8*)(KDT + (16 * tb + l15) * PT + (8 * quad + 32 * ks) * 2); } }
        __builtin_amdgcn_sched_barrier(0);
#pragma unroll
        for (int tb = 0; tb < 4; ++tb) { f32x4 oa = (f32x4){0.f, 0.f, 0.f, 0.f};
#pragma unroll
            for (int ks = 0; ks < 2; ++ks) oa = __builtin_amdgcn_mfma_f32_16x16x32_bf16(pq_[tb][ks], vfrag[ks], oa, 0, 0, 0);
#pragma unroll
            for (int jj = 0; jj < 4; ++jj) *(LAS unsigned short*)(OUT + (16 * tb + 4 * quad + jj) * 272 + (e0 + l15) * 2) = (unsigned short)cvt1_bf16(oa[jj]); }
        { float* kvp = (float*)(C.a->ws + WS_GKV) + item * 8192;
#pragma unroll
          for (int db = 0; db < 4; ++db) { f32x4 sa = (f32x4){0.f, 0.f, 0.f, 0.f};
#pragma unroll
            for (int ks = 0; ks < 2; ++ks) sa = __builtin_amdgcn_mfma_f32_16x16x32_bf16(vfrag[ks], kq_[db][ks], sa, 0, 0, 0);
#pragma unroll
            for (int jj = 0; jj < 4; ++jj) kvp[(e0 + 4 * quad + jj) * 64 + 16 * db + l15] = sa[jj];
            agg[db] = agg[db] * AD[cb * 64 + 16 * db + l15] + sa; } }
        { const int c2 = c + 2 <= clast ? c + 2 : clast, c3 = c + 3 <= clast ? c + 3 : clast; GLA_LOAD_QKV(c2); GLA_LOAD_BG(c3); }
        LBAR();
        { const u32x4 o0 = *(const LAS u32x4*)(OUT + ot * 272 + oj * 32), o1 = *(const LAS u32x4*)(OUT + ot * 272 + oj * 32 + 16);
          bf16* gp = (bf16*)(C.a->ws + WS_GIN) + item * 8192 + ot * 128 + oj * 16; *(u32x4*)gp = o0; *(u32x4*)(gp + 8) = o1; }
    }
    { float* ga = (float*)(C.a->ws + WS_GKA) + ((size_t)(b * 4 + h) * 8 + oct) * 8256;
#pragma unroll
      for (int db = 0; db < 4; ++db)
#pragma unroll
          for (int jj = 0; jj < 4; ++jj) ga[(e0 + 4 * quad + jj) * 64 + 16 * db + l15] = agg[db][jj];
      if (tid < 64) ga[8192 + tid] = aprod; }
    __syncthreads();
#undef GLA_LOAD_QKV
#undef GLA_LOAD_BG
#undef GLA_STORE_BG
#undef GLA_PREP1
#undef GLA_PREP2
}

__device__ __forceinline__ void gla_scan_unit(const Ctx& C, int l, int b, int h, int oct) {
    LAS unsigned char* lds = C.lds;
    constexpr int PT = 144;
    LAS unsigned char* QD = lds;
    LAS unsigned char* ST = lds + 2 * 9216;
    LAS unsigned char* OUT = ST + 18432;
    const int tid = C.tid, lane = C.lane, wave = C.wave, l15 = lane & 15, quad = lane >> 4;
    const int i = l >> 1; const size_t tokbase = (size_t)b * SEQ; const int cfirst = oct * 8;
    const bf16* QKV = (const bf16*)(C.a->ws + WS_QKV); bf16* Og = (bf16*)(C.a->ws + WS_O);
    const float* GKV = (const float*)(C.a->ws + WS_GKV); const float* GAD = (const float*)(C.a->ws + WS_GAD); const bf16* GQD = (const bf16*)(C.a->ws + WS_GQD); const bf16* GIN = (const bf16*)(C.a->ws + WS_GIN);
    const size_t item0 = ((size_t)(b * 4 + h)) * 64;
    const int e0 = 16 * wave;
    const int ot = tid >> 3, oj = tid & 7;
    const int se = tid >> 2, sd = (tid & 3) * 16;
    float gg[16];
#pragma unroll
    for (int k = 0; k < 16; ++k) gg[k] = C.a->in[I_EGLAN][i * 128 + 16 * oj + k];
    f32x4 S[4];
#pragma unroll
    for (int k = 0; k < 4; ++k) S[k] = (f32x4){0.f, 0.f, 0.f, 0.f};
    for (int oo = 0; oo < oct; ++oo) { const float* ga = (const float*)(C.a->ws + WS_GKA) + ((size_t)(b * 4 + h) * 8 + oo) * 8256;
#pragma unroll
        for (int k = 0; k < 4; ++k) { const f32x4 kv = *(const f32x4*)(ga + se * 64 + sd + 4 * k), av = *(const f32x4*)(ga + 8192 + sd + 4 * k); S[k] = S[k] * av + kv; } }
    for (int cc = 0; cc < 8; ++cc) {
        const int c = cfirst + cc; const size_t item = item0 + c; const size_t tok0 = tokbase + 64 * c; const int cb = cc & 1;
        const u32x4 qv = *(const u32x4*)(GQD + item * 4096 + ot * 64 + oj * 8);
        f32x4 kv[4], av[4];
#pragma unroll
        for (int k = 0; k < 4; ++k) { kv[k] = *(const f32x4*)(GKV + item * 8192 + se * 64 + sd + 4 * k); av[k] = *(const f32x4*)(GAD + item * 64 + sd + 4 * k); }
        const u32x4 in0 = *(const u32x4*)(GIN + item * 8192 + ot * 128 + oj * 16), in1 = *(const u32x4*)(GIN + item * 8192 + ot * 128 + oj * 16 + 8);
        const u32x4 rg0 = *(const u32x4*)(QKV + (tok0 + ot) * QKVW + E_BR + h * 128 + 16 * oj), rg1 = *(const u32x4*)(QKV + (tok0 + ot) * QKVW + E_BR + h * 128 + 16 * oj + 8);
        { u32x4 w0, w1; w0.x = cvt_pk_bf16(S[0][0], S[0][1]); w0.y = cvt_pk_bf16(S[0][2], S[0][3]); w0.z = cvt_pk_bf16(S[1][0], S[1][1]); w0.w = cvt_pk_bf16(S[1][2], S[1][3]);
          w1.x = cvt_pk_bf16(S[2][0], S[2][1]); w1.y = cvt_pk_bf16(S[2][2], S[2][3]); w1.z = cvt_pk_bf16(S[3][0], S[3][1]); w1.w = cvt_pk_bf16(S[3][2], S[3][3]);
          *(LAS u32x4*)(ST + se * PT + sd * 2) = w0; *(LAS u32x4*)(ST + se * PT + sd * 2 + 16) = w1; }
        *(LAS u32x4*)(QD + cb * 9216 + ot * PT + oj * 16) = qv;
        LBAR();
        { bf16x8 sq_[2], aq_[4][2];
#pragma unroll
          for (int ks = 0; ks < 2; ++ks) { sq_[ks] = *(const LAS bf16x8*)(ST + (e0 + l15) * PT + (8 * quad + 32 * ks) * 2);
#pragma unroll
              for (int tb = 0; tb < 4; ++tb) aq_[tb][ks] = *(const LAS bf16x8*)(QD + cb * 9216 + (16 * tb + l15) * PT + (8 * quad + 32 * ks) * 2); }
          __builtin_amdgcn_sched_barrier(0);
#pragma unroll
          for (int tb = 0; tb < 4; ++tb) { f32x4 oa = (f32x4){0.f, 0.f, 0.f, 0.f};
#pragma unroll
            for (int ks = 0; ks < 2; ++ks) oa = __builtin_amdgcn_mfma_f32_16x16x32_bf16(aq_[tb][ks], sq_[ks], oa, 0, 0, 0);
#pragma unroll
            for (int jj = 0; jj < 4; ++jj) *(LAS unsigned short*)(OUT + (16 * tb + 4 * quad + jj) * 272 + (e0 + l15) * 2) = (unsigned short)cvt1_bf16(oa[jj]); } }
#pragma unroll
        for (int k = 0; k < 4; ++k) S[k] = S[k] * av[k] + kv[k];
        LBAR();
        { const u32x4 o0 = *(const LAS u32x4*)(OUT + ot * 272 + oj * 32), o1 = *(const LAS u32x4*)(OUT + ot * 272 + oj * 32 + 16);
          float ov[16];
#pragma unroll
          for (int k = 0; k < 4; ++k) { ov[2 * k] = bflo(o0[k]) + bflo(in0[k]); ov[2 * k + 1] = bfhi(o0[k]) + bfhi(in0[k]); ov[8 + 2 * k] = bflo(o1[k]) + bflo(in1[k]); ov[8 + 2 * k + 1] = bfhi(o1[k]) + bfhi(in1[k]); }
          float q = 0.f;
#pragma unroll
          for (int k = 0; k < 16; ++k) q += ov[k] * ov[k];
          q = sum8_dpp(q);
          const float rstd = 1.0f / sqrtf(q * (1.f / 128.f) + EPS);
          u32x4 w0, w1;
#pragma unroll
          for (int k = 0; k < 4; ++k) {
              { const float ra = bflo(rg0[k]), rb = bfhi(rg0[k]); const float sa = ra * __builtin_amdgcn_rcpf(1.f + __expf(-ra)), sb2 = rb * __builtin_amdgcn_rcpf(1.f + __expf(-rb));
                w0[k] = cvt_pk_bf16(ov[2 * k] * rstd * gg[2 * k] * sa, ov[2 * k + 1] * rstd * gg[2 * k + 1] * sb2); ov[2 * k] *= rstd * gg[2 * k] * sa * F8_ACT_SCALE; ov[2 * k + 1] *= rstd * gg[2 * k + 1] * sb2 * F8_ACT_SCALE; }
              { const float ra = bflo(rg1[k]), rb = bfhi(rg1[k]); const float sa = ra * __builtin_amdgcn_rcpf(1.f + __expf(-ra)), sb2 = rb * __builtin_amdgcn_rcpf(1.f + __expf(-rb));
                w1[k] = cvt_pk_bf16(ov[8 + 2 * k] * rstd * gg[8 + 2 * k] * sa, ov[8 + 2 * k + 1] * rstd * gg[8 + 2 * k + 1] * sb2); ov[8 + 2 * k] *= rstd * gg[8 + 2 * k] * sa * F8_ACT_SCALE; ov[8 + 2 * k + 1] *= rstd * gg[8 + 2 * k + 1] * sb2 * F8_ACT_SCALE; } }
          (void)w0; (void)w1;
          u32x4 w8; w8.x = pk4_fp8(ov[0], ov[1], ov[2], ov[3]); w8.y = pk4_fp8(ov[4], ov[5], ov[6], ov[7]); w8.z = pk4_fp8(ov[8], ov[9], ov[10], ov[11]); w8.w = pk4_fp8(ov[12], ov[13], ov[14], ov[15]);
          *(u32x4*)((unsigned char*)Og + (tok0 + ot) * DM + 512 + h * 128 + 16 * oj) = w8; }
    }
    __syncthreads();
}

__device__ __forceinline__ void stickbreak_wave_unit(const Ctx& C, int b, int h, int qt, int nb_, int nh_, int nqt_) {
    LAS unsigned char* kl = C.lds + 65536 + C.wave * 8192;
    LAS unsigned char* vl = C.lds + C.wave * 8192;
    const int lane = C.lane, r32 = lane & 31, hi = lane >> 5;
    const int i16 = lane & 15, q4 = i16 >> 2, p4 = i16 & 3, half16 = (lane >> 4) & 1;
    const size_t tokbase = (size_t)b * SEQ; const int q0 = qt * 32;
    const bf16* qp = ((bf16*)(C.a->ws + WS_QKV)) + (tokbase + q0 + r32) * QKVW + O_Q + h * 64 + 8 * hi;
    bf16x8 qr[4];
#pragma unroll
    for (int d0 = 0; d0 < 4; ++d0) qr[d0] = *(const bf16x8*)(qp + 16 * d0);
    f32x16 o[2];
#pragma unroll
    for (int k = 0; k < 2; ++k)
#pragma unroll
        for (int i = 0; i < 16; ++i) o[k][i] = 0.f;
    float R = 0.f;
    const int jd = q0 >> 6, qloc = (q0 & 63) + r32;
    u32x4 kr[8];
    const unsigned vdst = (unsigned)__builtin_amdgcn_readfirstlane((int)(unsigned)(uintptr_t)vl);
    const unsigned tdst = (unsigned)__builtin_amdgcn_readfirstlane((int)(unsigned)(uintptr_t)(C.lds + 131072 + C.wave * 1024));
    const char* qkvb = (const char*)(C.a->ws + WS_QKV);
    unsigned nt1 = 0u, nt2 = 0u, nt3 = 0u;
    if (nb_ >= 0) { const unsigned tb2 = (unsigned)nb_ * SEQ, q02 = (unsigned)nqt_ * 32u, k02 = tb2 + ((q02 >> 6) << 6), l31 = (unsigned)(lane & 31);
        const unsigned oq = ((tb2 + q02 + l31) * QKVW + O_Q + nh_ * 64) * 2u, ok0 = ((k02 + l31) * QKVW + O_K + nh_ * 64) * 2u, ok1 = ((k02 + 32u + l31) * QKVW + O_K + nh_ * 64) * 2u,
                       ov0 = ((k02 + l31) * QKVW + O_V + nh_ * 64) * 2u, ov1 = ((k02 + 32u + l31) * QKVW + O_V + nh_ * 64) * 2u;
        nt1 = hi ? ok0 : oq; nt2 = hi ? ov0 : ok1; nt3 = ov1; }
    const unsigned vtch = (unsigned)((((unsigned)tokbase + (unsigned)lane) * QKVW + O_V + h * 64) * 2);
#define SB_LOAD(jj) do { _Pragma("unroll") for (int i = 0; i < 8; ++i) { const int id = lane + 64 * i, row = id >> 3, c = id & 7; \
        kr[i] = *(const u32x4*)(((const bf16*)(C.a->ws + WS_QKV)) + (tokbase + 64 * (jj) + row) * QKVW + O_K + h * 64 + c * 8); } } while (0)
    SB_LOAD(jd);
    for (int j = jd; j >= 0; --j) {
        if (j < jd - 1) { SB_LOAD(j); }
#pragma unroll
        for (int i = 0; i < 8; ++i) { const int id = lane + 64 * i, row = id >> 3, c = id & 7; *(LAS u32x4*)(kl + kswz(row, c)) = kr[i]; }
        { const char* vbase = (const char*)(C.a->ws + WS_QKV) + (tokbase + 64 * (size_t)j) * (size_t)(QKVW * 2);
#pragma unroll
          for (int i = 0; i < 8; ++i) { const int row = i * 8 + (lane >> 3), c = (lane & 7) ^ (((lane >> 4) & 1) << 2); const unsigned vo = (unsigned)((row * QKVW + O_V + h * 64 + c * 8) * 2);
              pg8::glds_s(vbase, vo, vdst + (unsigned)(i * 1024)); } }
        if (j > 0 && j == jd) { SB_LOAD(j - 1); }
        if (j > 0 && j == jd) pg8::glds_s(qkvb, vtch + (unsigned)(j - 1) * (unsigned)(64 * QKVW * 2), tdst);
        if (j == jd && nb_ >= 0) { pg8::glds_s(qkvb, nt1, tdst); pg8::glds_s(qkvb, nt2, tdst); pg8::glds_s(qkvb, nt3, tdst); }
        LDS_WAIT();
        f32x16 s0, s1;
#pragma unroll
        for (int i = 0; i < 16; ++i) { s0[i] = 0.f; s1[i] = 0.f; }
#pragma unroll
        for (int d0 = 0; d0 < 4; ++d0) { const int c = 2 * d0 + hi;
            const bf16x8 a0 = *(const LAS bf16x8*)(kl + kswz(r32, c)), a1 = *(const LAS bf16x8*)(kl + kswz(32 + r32, c));
            s0 = __builtin_amdgcn_mfma_f32_32x32x16_bf16(a0, qr[d0], s0, 0, 0, 0); s1 = __builtin_amdgcn_mfma_f32_32x32x16_bf16(a1, qr[d0], s1, 0, 0, 0); }
        const bool diag = (j == jd);
        const float eR = ex2(R);
#pragma unroll
        for (int i = 0; i < 16; ++i) { const int kv = crow(i, hi);
            { const float r = __builtin_amdgcn_rcpf(1.f + ex2(fminf(s0[i], 100.f))); s0[i] = (!diag || (kv < qloc)) ? r : 1.f; }
            { const float r = __builtin_amdgcn_rcpf(1.f + ex2(fminf(s1[i], 100.f))); s1[i] = (!diag || (kv + 32 < qloc)) ? r : 1.f; } }
        float own[8], oth[8];
#pragma unroll
        for (int g = 0; g < 4; ++g) { own[g] = (s0[4 * g] * s0[4 * g + 1]) * (s0[4 * g + 2] * s0[4 * g + 3]); own[4 + g] = (s1[4 * g] * s1[4 * g + 1]) * (s1[4 * g + 2] * s1[4 * g + 3]); }
#pragma unroll
        for (int g = 0; g < 8; ++g) oth[g] = pl32_other(own[g], hi);
        float T[8]; { float so = 1.f, sp_ = 1.f;
#pragma unroll
            for (int g = 7; g >= 0; --g) { T[g] = so * sp_ * (hi ? 1.f : oth[g]); so *= own[g]; sp_ *= oth[g]; }
            const float tot = so * sp_;
#pragma unroll
            for (int g = 0; g < 4; ++g) {
                { const float p4 = eR * T[g], p3 = p4 * s0[4 * g + 3], p2 = p3 * s0[4 * g + 2], p1 = p2 * s0[4 * g + 1], p0 = p1 * s0[4 * g];
                  s0[4 * g + 3] = p4 - p3; s0[4 * g + 2] = p3 - p2; s0[4 * g + 1] = p2 - p1; s0[4 * g] = p1 - p0; }
                { const float p4 = eR * T[4 + g], p3 = p4 * s1[4 * g + 3], p2 = p3 * s1[4 * g + 2], p1 = p2 * s1[4 * g + 1], p0 = p1 * s1[4 * g];
                  s1[4 * g + 3] = p4 - p3; s1[4 * g + 2] = p3 - p2; s1[4 * g + 1] = p2 - p1; s1[4 * g] = p1 - p0; } }
            R += lg2(tot); }
        if (j == jd) { if (nb_ >= 0) { if (j > 0) asm volatile("s_waitcnt vmcnt(12)" ::: "memory"); else asm volatile("s_waitcnt vmcnt(3)" ::: "memory"); }
                       else { if (j > 0) asm volatile("s_waitcnt vmcnt(9)" ::: "memory"); else asm volatile("s_waitcnt vmcnt(0)" ::: "memory"); } }
        else asm volatile("s_waitcnt vmcnt(0)" ::: "memory");
        const LAS unsigned char* vb = vl + half16 * 32 + p4 * 8 + (4 * hi + q4) * 128; const int vko[2] = {((q4 >> 1) & 1) * 64, 64 - ((q4 >> 1) & 1) * 64};
#pragma unroll
        for (int s = 0; s < 4; ++s) {
            u32x4 pw;
            if (s < 2) { pw.x = cvt_pk_bf16(s0[8 * s + 0], s0[8 * s + 1]); pw.y = cvt_pk_bf16(s0[8 * s + 2], s0[8 * s + 3]); pw.z = cvt_pk_bf16(s0[8 * s + 4], s0[8 * s + 5]); pw.w = cvt_pk_bf16(s0[8 * s + 6], s0[8 * s + 7]); }
            else { const int t = s - 2; pw.x = cvt_pk_bf16(s1[8 * t + 0], s1[8 * t + 1]); pw.y = cvt_pk_bf16(s1[8 * t + 2], s1[8 * t + 3]); pw.z = cvt_pk_bf16(s1[8 * t + 4], s1[8 * t + 5]); pw.w = cvt_pk_bf16(s1[8 * t + 6], s1[8 * t + 7]); }
            const bf16x8 pf = __builtin_bit_cast(bf16x8, pw);
#pragma unroll
            for (int k = 0; k < 2; ++k) { const s16x4 lo = vtr(vb + vko[k] + s * 2048), hh = vtr(vb + vko[k] + s * 2048 + 1024);
                const bf16x8 vf = (bf16x8){lo[0], lo[1], lo[2], lo[3], hh[0], hh[1], hh[2], hh[3]};
                o[k] = __builtin_amdgcn_mfma_f32_32x32x16_bf16(vf, pf, o[k], 0, 0, 0); }
        }
        LDS_WAIT();
        if (__all(R < -40.f)) break;
    }
#undef SB_LOAD
#pragma unroll
    for (int k = 0; k < 2; ++k)
#pragma unroll
        for (int g = 0; g < 4; ++g) { const int dv = 32 * k + 8 * g + 4 * hi;
            *(LAS unsigned*)(kl + r32 * 64 + dv) = pk4_fp8(o[k][4 * g] * F8_ACT_SCALE, o[k][4 * g + 1] * F8_ACT_SCALE, o[k][4 * g + 2] * F8_ACT_SCALE, o[k][4 * g + 3] * F8_ACT_SCALE); }
    LDS_WAIT();
    { const int orow = lane >> 2, opc = lane & 3;
      const u32x4 w0 = *(const LAS u32x4*)(kl + orow * 64 + opc * 16), w1 = *(const LAS u32x4*)(kl + (16 + orow) * 64 + opc * 16);
      unsigned char* ob = (unsigned char*)(C.a->ws + WS_O) + (tokbase + q0 + orow) * DM + h * 64 + opc * 16;
      *(u32x4*)ob = w0; *(u32x4*)(ob + (size_t)16 * DM) = w1; }
    LDS_WAIT();
}


constexpr int PH_PER_LAYER = 8, N_PHASES = 1 + DEPTH * PH_PER_LAYER + 1;

__global__ void __launch_bounds__(512, 2) fwd(Args args) {
    extern __shared__ __attribute__((aligned(16))) unsigned char lds_raw[];
    Ctx C;
    C.lds = (LAS unsigned char*)lds_raw;
    C.tid = threadIdx.x; C.lane = C.tid & 63; C.wave = __builtin_amdgcn_readfirstlane(C.tid >> 6);
    C.G = gridDim.x; { const int bx = blockIdx.x; C.vcu = (C.G % 8 == 0) ? (bx % 8) * (C.G / 8) + bx / 8 : bx; }
    C.a = &args;
    LAS unsigned* lctl = (LAS unsigned*)(C.lds + LCTL_OFF);
    for (int u = C.tid; u < 1024; u += 512) lctl[u] = 0u;
    __syncthreads();
    const int lo = args.ph_lo, hi = args.ph_hi;
    XcdBarrier bar; bar.bar = ((unsigned*)(C.a->ws + WS_CTL)) + CW_BAR; bar.x = 0; bar.st = nullptr;
    if (hi - lo > 1) bar = xcd_barrier_post(((unsigned*)(C.a->ws + WS_CTL)) + CW_BAR, (volatile LAS unsigned*)lctl);
#ifndef PH_MASK
#define PH_MASK 0xffff
#endif
#define PHM(kind) ((PH_MASK >> (kind)) & 1)
#define IN(k) (lo <= (k) && (k) < hi)
#define INL(p) (PHM((p) + 1) && IN(pb + (p)))
#define SEAM(k) do { if (IN(k) && IN((k) + 1)) xcd_barrier(bar); } while (0)

    if (PHM(0) && IN(0)) { p0_prologue(C); __syncthreads(); SEAM(0); }

    for (int l = 0; l < DEPTH; ++l) {
        const int pb = 1 + PH_PER_LAYER * l;
        const bool odd = (l & 1) != 0;
        if (INL(0)) {
            const Ctx P = launder(C);
            if (l == 0) norm_phase<false, 1, false, true>(P, l, P.a->in[I_X], P.a->in[I_NMIX], 0, ((bf16*)(P.a->ws + WS_WBG)));
            else if (odd) norm_phase<true, 0, false, false>(P, l, nullptr, P.a->in[I_NMIX], 0, nullptr);
            else norm_phase<true, 1, false, false>(P, l, nullptr, P.a->in[I_NMIX], 0, ((bf16*)(P.a->ws + WS_WBG)) + (size_t)(l >> 1) * 16 * 1024);
            SEAM(pb + 0);
        }
        if (INL(1)) {
            const Ctx P = launder(C); const int bx = (P.vcu % (P.G / 8)) * 8 + P.vcu / (P.G / 8);
            pg8::Gemm g{((bf16*)(P.a->ws + WS_H)), ((bf16*)(P.a->ws + WS_WIN)) + (size_t)l * 3072 * 1024, 1024}; pg8::StaticOrder S; S.init(NTOK, QKVW, P.G, bx);
            pg8::EpiQKV E{((bf16*)(P.a->ws + WS_QKV)), QKVW, C2, odd ? 4 : 2, 0.125f, odd ? -1 : 6};
            pg8::gemm_phase<pg8::EpiQKV, pg8::StaticOrder, false, true>(P.lds, P.tid, g, S, E);
            SEAM(pb + 1);
        }
        if (INL(2) || INL(3)) {
            if (!odd) {
                LAS float* lamp = (LAS float*)(lctl + 64);
                LAS int* itemp = (LAS int*)(lctl + 65);
                if (C.wave == 0) { const float* lp = C.a->in[I_ELAM] + (size_t)(l >> 1) * 256; const float a = wave_sum(lp[C.lane] * lp[64 + C.lane]), bq = wave_sum(lp[128 + C.lane] * lp[192 + C.lane]);
                    if (C.lane == 0) *lamp = __expf(a) - __expf(bq); }
                const float lam_init = 0.8f - 0.6f * __expf(-0.3f * (float)l);
                const int myx = (int)(xb_xcc_id() & 7u);
#pragma unroll 1
                for (int pass_ = 0; pass_ < 2; ++pass_) {
                    if (!(pass_ == 0 ? INL(2) : INL(3))) continue;
                    const int nqb = pass_ == 0 ? 8 : 24, qb_hi = pass_ == 0 ? 31 : 23, nitem = 32 + 4 * nqb;
#pragma unroll 1
                    for (int kx = 0; kx < 8; ++kx) {
                        const int xq = (myx + kx) & 7;
                        unsigned* qctr = ((unsigned*)(C.a->ws + WS_CTL)) + CW_QUEUE + 1024 + (((l >> 1) * 2 + pass_) * 8 + xq) * 16;
                        for (;;) {
                            __syncthreads();
                            if (C.tid == 0) *itemp = (int)__hip_atomic_fetch_add(qctr, 1u, __ATOMIC_RELAXED, __HIP_MEMORY_SCOPE_AGENT);
                            __syncthreads();
                            const int item = __builtin_amdgcn_readfirstlane(*itemp);
                            const float lam = *lamp + lam_init;
                            if (item >= nitem) break;
                            const Ctx P = launder(C);
                            if (item < 32) { const int oct = 7 - (item >> 2), bh = 4 * xq + (item & 3);
                                if (pass_ == 0) gla_local_unit(P, l, bh >> 2, bh & 3, oct); else gla_scan_unit(P, l, bh >> 2, bh & 3, oct); }
                            else { const int k = item - 32, bh = 4 * xq + (k & 3), qb = qb_hi - (k >> 2); diffattn_unit(P, l, bh >> 2, bh & 3, qb, lam, lam_init); }
                        }
                    }
                    if (pass_ == 0) { SEAM(pb + 2); } else { SEAM(pb + 3); }
                }
            } else if (INL(3)) {
                const Ctx P = launder(C);
                const int gw = P.vcu * 8 + P.wave, NGW = P.G * 8;
                for (int u = gw; u < NBATCH * 16 * 128; u += NGW) { const int hs = u & 1, qt = (u >> 1) & 127, hp = (u >> 8) & 7, b = u >> 11;
                    const int u2 = u + NGW; const bool hn = u2 < NBATCH * 16 * 128;
                    stickbreak_wave_unit(P, b, 2 * hp + hs, qt, hn ? (u2 >> 11) : -1, 2 * ((u2 >> 8) & 7) + (u2 & 1), (u2 >> 1) & 127); }
                __syncthreads();
                SEAM(pb + 3);
            }
        }
        if (INL(4)) {
            const Ctx P = launder(C); const int bx = (P.vcu % (P.G / 8)) * 8 + P.vcu / (P.G / 8);
            pg8::Gemm g{(const bf16*)(P.a->ws + WS_O), (const bf16*)(P.a->ws + WS_WOUT + (size_t)l * 1024 * 1024), 512}; pg8::StaticOrder S; S.init(NTOK, DM, P.G, bx);
            const float* gate1 = ((float*)(P.a->ws + WS_MOD)) + (size_t)l * 8 * 6144 + 2 * 1024;
            if (l == 0) { pg8::EpiResid<true> E{P.a->in[I_X], (bf16*)(P.a->ws + WS_XB), gate1}; pg8::gemm_phase<pg8::EpiResid<true>, pg8::StaticOrder, false, true, true>(P.lds, P.tid, g, S, E); }
            else { pg8::EpiResid<false> E{nullptr, (bf16*)(P.a->ws + WS_XB), gate1}; pg8::gemm_phase<pg8::EpiResid<false>, pg8::StaticOrder, false, true, true>(P.lds, P.tid, g, S, E); }
            SEAM(pb + 4);
        }
        if (INL(5)) {
            const Ctx P = launder(C);
            norm_phase<false, 2, false, false>(P, l, nullptr, P.a->in[I_NFFN], 3, ((bf16*)(P.a->ws + WS_WR)) + (size_t)l * 36 * 1024);
            SEAM(pb + 5);
        }
        if (INL(6)) {
            const Ctx P = launder(C); const int bx = (P.vcu % (P.G / 8)) * 8 + P.vcu / (P.G / 8);
            LAS int* tb = (LAS int*)(P.lds + LCTL_OFF + 64); LAS int* cl = (LAS int*)(P.lds + LCTL_OFF + 512);
            const int* cnt = (const int*)(((unsigned*)(P.a->ws + WS_CTL)) + CW_CNT + 64 * l);
            __syncthreads();
            if (P.tid < 32) {
                const int cv = (int)__hip_atomic_load(cnt + P.tid, __ATOMIC_RELAXED, __HIP_MEMORY_SCOPE_AGENT); cl[P.tid] = cv; int t = (cv + 255) >> 8;
#pragma unroll
                for (int d = 1; d < 32; d <<= 1) { const int v = __shfl_up(t, d); if (P.tid >= d) t += v; }
                tb[P.tid + 1] = t; if (P.tid == 0) tb[0] = 0; }
            __syncthreads();
            const int T = __builtin_amdgcn_readfirstlane(tb[32]);
            pg8::GroupedOrder S{tb, T, P.G, bx, ((int*)(P.a->ws + WS_PLIST)), cl};
            pg8::Gemm g{(const bf16*)(P.a->ws + WS_H8), (const bf16*)(P.a->ws + WS_WGU + (size_t)l * 32 * 1024 * 1024), 512};
            pg8::EpiSwiGLU8 E{(unsigned char*)(P.a->ws + WS_O), ((float*)(P.a->ws + WS_WLIST))};
            pg8::gemm_phase<pg8::EpiSwiGLU8, pg8::GroupedOrder, true, true, true>(P.lds, P.tid, g, S, E);
            SEAM(pb + 6);
        }
        if (INL(7)) {
            const Ctx P = launder(C); const int bx = (P.vcu % (P.G / 8)) * 8 + P.vcu / (P.G / 8);
            LAS int* tb = (LAS int*)(P.lds + LCTL_OFF + 64); LAS int* cl = (LAS int*)(P.lds + LCTL_OFF + 512);
            if (!INL(6)) {
            const int* cnt = (const int*)(((unsigned*)(P.a->ws + WS_CTL)) + CW_CNT + 64 * l);
            __syncthreads();
            if (P.tid < 32) {
                const int cv = (int)__hip_atomic_load(cnt + P.tid, __ATOMIC_RELAXED, __HIP_MEMORY_SCOPE_AGENT); cl[P.tid] = cv; int t = (cv + 255) >> 8;
#pragma unroll
                for (int d = 1; d < 32; d <<= 1) { const int v = __shfl_up(t, d); if (P.tid >= d) t += v; }
                tb[P.tid + 1] = t; if (P.tid == 0) tb[0] = 0; }
            __syncthreads();
            }
            const int T = __builtin_amdgcn_readfirstlane(tb[32]);
            pg8::GroupedOrder S{tb, T, P.G, bx, ((int*)(P.a->ws + WS_PLIST)), cl};
            pg8::Gemm g{(const bf16*)(P.a->ws + WS_O), (const bf16*)(P.a->ws + WS_WD + (size_t)l * 32 * 1024 * 512), 256};
            pg8::EpiScatterY E{((bf16*)(P.a->ws + WS_QKV)), ((int*)(P.a->ws + WS_PLIST))};
            pg8::gemm_phase<pg8::EpiScatterY, pg8::GroupedOrder, false, true, true>(P.lds, P.tid, g, S, E);
            SEAM(pb + 7);
        }
    }
    if (PHM(9) && IN(N_PHASES - 1)) { const Ctx P = launder(C); norm_phase<true, 0, true, false>(P, DEPTH, nullptr, P.a->in[I_NFIN], 0, nullptr); }
#undef IN
#undef INL
#undef SEAM
}

extern "C" void kernel_launch(void* const* d_in, const int* in_sizes, int n_in, void* d_out, int out_size, void* d_ws, size_t ws_size, hipStream_t stream) {
    static int grid = 0;
    if (grid == 0) {
        if (n_in != 24 || in_sizes[0] != NTOK * DM || out_size != NTOK * DM || ws_size < WS_END) { fprintf(stderr, "kernel_launch: unexpected shapes (n_in %d, in0 %d, out %d, ws %zu)\n", n_in, n_in > 0 ? in_sizes[0] : -1, out_size, ws_size); grid = -1; return; }
        int dev = 0, cus = 0, per_cu = 0;
        if (hipGetDevice(&dev) != hipSuccess || hipDeviceGetAttribute(&cus, hipDeviceAttributeMultiprocessorCount, dev) != hipSuccess) { grid = -1; return; }
        if (hipFuncSetAttribute((const void*)fwd, hipFuncAttributeMaxDynamicSharedMemorySize, LDS_BYTES) != hipSuccess) { fprintf(stderr, "kernel_launch: hipFuncSetAttribute failed\n"); grid = -1; return; }
        if (hipOccupancyMaxActiveBlocksPerMultiprocessor(&per_cu, (const void*)fwd, 512, LDS_BYTES) != hipSuccess || per_cu < 1) fprintf(stderr, "kernel_launch: occupancy query reports %d\n", per_cu);
        (void)hipGetLastError();
        grid = cus;
        if (grid != 256) { fprintf(stderr, "kernel_launch: built for a 256-CU device (one workgroup per CU), found %d CUs\n", cus); grid = -1; return; }
    }
    if (grid < 0) return;
    if (hipMemsetAsync((char*)d_ws + WS_CTL, 0, CTL_ZERO_BYTES, stream) != hipSuccess) return;
    Args a{};
    for (int i = 0; i < 24; ++i) a.in[i] = (const float*)d_in[i];
    a.out = (float*)d_out; a.ws = (unsigned char*)d_ws;
    a.ph_lo = 0; a.ph_hi = N_PHASES;
    hipLaunchKernelGGL(fwd, dim3(grid), dim3(512), LDS_BYTES, stream, a);
}
```

```cpp
#include <hip/hip_runtime.h>
#include <cstdio>
#include <cstdint>

#define GAS __attribute__((address_space(1)))
#define LAS __attribute__((address_space(3)))
typedef unsigned short bf16;
typedef short bf16x8 __attribute__((ext_vector_type(8)));
typedef short s16x4 __attribute__((ext_vector_type(4)));
typedef float f32x4 __attribute__((ext_vector_type(4)));
typedef float f32x2 __attribute__((ext_vector_type(2)));
typedef float f32x16 __attribute__((ext_vector_type(16)));
typedef unsigned u32x4 __attribute__((ext_vector_type(4)));
typedef unsigned u32x2 __attribute__((ext_vector_type(2)));

constexpr int NTOK = 32768, DM = 1024, SEQ = 4096, NBATCH = 8, DEPTH = 4;
constexpr int QKVW = 3072;
constexpr int NEXP = 32;
constexpr float EPS = 1e-6f;
constexpr float LOG2E = 1.4426950408889634f;
constexpr float C2 = 0.125f * 1.4426950408889634f;
constexpr int E_AQ = 0, E_AK = 512, E_AV = 1024, E_BQ = 1536, E_BK = 1792, E_BV = 2048, E_BR = 2560;
constexpr int O_Q = 0, O_K = 1024, O_V = 2048;

constexpr size_t MiB = 1u << 20;
constexpr size_t WS_CTL = 0, CTL_ZERO_BYTES = 1 * MiB;
constexpr size_t WS_MOD = 2 * MiB;
constexpr size_t WS_WR = 3 * MiB;
constexpr size_t WS_WBG = 3 * MiB + 512 * 1024;
constexpr size_t WS_PLIST = 4 * MiB;
constexpr size_t WS_WLIST = 8 * MiB;
constexpr size_t WS_BG = 12 * MiB;
constexpr size_t WS_WIN = 16 * MiB;
constexpr size_t WS_WOUT = 40 * MiB;
constexpr size_t WS_WGU = 48 * MiB;
constexpr size_t WS_WD = 304 * MiB;
constexpr size_t WS_H = 432 * MiB;
constexpr size_t WS_QKV = 498 * MiB;
constexpr size_t WS_O = 690 * MiB;
constexpr size_t WS_GQD = 768 * MiB;
constexpr size_t WS_GIN = 784 * MiB;
constexpr size_t WS_GKV = 816 * MiB;
constexpr size_t WS_GAD = 880 * MiB;
constexpr size_t WS_GKA = 880 * MiB + 512 * 1024;
constexpr size_t WS_XB = 889 * MiB;
constexpr size_t WS_H8 = 953 * MiB;
constexpr size_t WS_END = 987 * MiB;
constexpr int CW_BAR = 4096;
constexpr int CW_CNT = 16384;
constexpr int CW_DBG = 24576;
constexpr int CW_QUEUE = 20480;
constexpr int RING_BYTES = 147456;
constexpr int LCTL_OFF = RING_BYTES;
constexpr int LDS_BYTES = RING_BYTES + 4096;

__device__ __forceinline__ unsigned f2bf(float f) { unsigned u = __builtin_bit_cast(unsigned, f); return (u + 0x7fffu + ((u >> 16) & 1u)) >> 16; }
__device__ __forceinline__ unsigned pk2(float lo, float hi) { return f2bf(lo) | (f2bf(hi) << 16); }
typedef __bf16 bf16x2_t __attribute__((ext_vector_type(2)));
__device__ __forceinline__ unsigned cvt_pk_bf16(float lo, float hi) { f32x2 v = {lo, hi}; bf16x2_t b = __builtin_convertvector(v, bf16x2_t); return __builtin_bit_cast(unsigned, b); }
__device__ __forceinline__ unsigned cvt1_bf16(float x) { return cvt_pk_bf16(x, 0.f); }
typedef int v4i32 __attribute__((ext_vector_type(4)));
typedef int v8i32 __attribute__((ext_vector_type(8)));
__device__ __forceinline__ unsigned pk4_fp8(float a, float b, float c, float d) {
    a = __builtin_fminf(__builtin_fmaxf(a, -448.f), 448.f); b = __builtin_fminf(__builtin_fmaxf(b, -448.f), 448.f); c = __builtin_fminf(__builtin_fmaxf(c, -448.f), 448.f); d = __builtin_fminf(__builtin_fmaxf(d, -448.f), 448.f);
    int pk = 0; pk = __builtin_amdgcn_cvt_pk_fp8_f32(a, b, pk, false); pk = __builtin_amdgcn_cvt_pk_fp8_f32(c, d, pk, true); return (unsigned)pk; }
constexpr float F8_ACT_SCALE = 16.f, F8_W_SCALE = 64.f;
constexpr int F8_SC_ACT = 0x7b7b7b7b, F8_SC_W = 0x79797979;
__device__ __forceinline__ float bf2f(unsigned short x) { return __builtin_bit_cast(float, (unsigned)x << 16); }
__device__ __forceinline__ float bflo(unsigned x) { return __builtin_bit_cast(float, x << 16); }
__device__ __forceinline__ float bfhi(unsigned x) { return __builtin_bit_cast(float, x & 0xffff0000u); }
__device__ __forceinline__ int crow(int r, int hi) { return (r & 3) + 8 * (r >> 2) + 4 * hi; }
__device__ __forceinline__ float ex2(float x) { return __builtin_amdgcn_exp2f(x); }
__device__ __forceinline__ float lg2(float x) { return __builtin_amdgcn_logf(x); }
__device__ __forceinline__ void swap32(float& a, float& b) { asm volatile("s_nop 1\n\tv_permlane32_swap_b32 %0, %1\n\ts_nop 1" : "+v"(a), "+v"(b)); }
__device__ __forceinline__ void swap16(float& a, float& b) { asm volatile("s_nop 1\n\tv_permlane16_swap_b32 %0, %1\n\ts_nop 1" : "+v"(a), "+v"(b)); }
#define LDS_WAIT() asm volatile("s_waitcnt lgkmcnt(0)" ::: "memory")
#define LBAR() do { asm volatile("s_waitcnt lgkmcnt(0)" ::: "memory"); __builtin_amdgcn_s_barrier(); asm volatile("" ::: "memory"); } while (0)

namespace pg8 {
typedef unsigned short bf16_t;
constexpr int BM = 256, BK = 64, HALF = 128, HTB = HALF * BK * 2, STAGE_BYTES = 8 * HTB, NXCD = 8, WGM = 8;
__host__ __device__ __forceinline__ int lds_byte(int r, int c) { const int st = (r >> 4) * 2 + (c >> 5), rr = r & 15, cc = c & 31, ob = rr * 64 + cc * 2; return st * 1024 + (ob ^ (((ob >> 9) & 1) << 5)); }
__host__ __device__ __forceinline__ void stage_rc(int b, int& R, int& C) { const int st = b / 1024, sb = b % 1024, swz = sb ^ (((sb >> 9) & 1) << 5); R = (st >> 1) * 16 + swz / 64; C = (st & 1) * 32 + (swz % 64) / 2; }
__host__ __device__ __forceinline__ int perm32(int rho) { const int n = rho >> 4, i = rho & 15; return 8 * (i >> 2) + 4 * n + (i & 3); }

struct Unit { int pm, pn, e, t0, ne; };
struct Gemm { const bf16_t* A; const bf16_t* Bt; int K; };

struct StaticOrder {
    int nM, nN, nwg, G, c;
    __device__ void init(int M, int N, int G_, int c_) { nM = M / BM; nN = N / BM; nwg = nM * nN; G = G_; c = c_; }
    __device__ bool next(int i, Unit& u) const {
        const long L = (long)i * G + c; if (L >= nwg) return false;
        int wgid = (int)L; { const int q = nwg / NXCD, r = nwg % NXCD, xcd = wgid % NXCD, off = wgid / NXCD; wgid = (xcd < r ? xcd * (q + 1) : r * (q + 1) + (xcd - r) * q) + off; }
        const int nig = WGM * nN, gid = wgid / nig, fm = gid * WGM, gsz = (nM - fm) < WGM ? (nM - fm) : WGM;
        u.pm = fm + ((wgid % nig) % gsz); u.pn = (wgid % nig) / gsz; u.e = 0; u.t0 = 0; u.ne = 0; return true;
    }
    __device__ __forceinline__ int arow(const Unit&, int) const { return 0; }
};

struct GroupedOrder {
    const LAS int* tb; int T, G, c; const int* plist; const LAS int* cl;
    __device__ __forceinline__ bool next(int i, Unit& u) const {
        const int nun = T * 4; const long L = (long)i * G + c; if (L >= nun) return false;
        int w = (int)L; { const int q = nun / NXCD, r = nun % NXCD, xcd = w % NXCD, off = w / NXCD; w = (xcd < r ? xcd * (q + 1) : r * (q + 1) + (xcd - r) * q) + off; }
        const int ti = w >> 2, pnl = w & 3;
        int e = 0;
#pragma unroll
        for (int step = 16; step >= 1; step >>= 1) { const int v = __builtin_amdgcn_readfirstlane(tb[e + step]); if (v <= ti) e += step; }
        u.pm = ti; u.pn = e * 4 + pnl; u.e = e; u.t0 = ti - __builtin_amdgcn_readfirstlane(tb[e]); u.ne = __builtin_amdgcn_readfirstlane(cl[e]); return true;
    }
    __device__ __forceinline__ int arow(const Unit& u, int r) const {
        const int pos = u.t0 * 256 + r; const int pr = plist[(size_t)u.e * NTOK + pos];
        return pos < u.ne ? (pr >> 1) : NTOK;
    }
};

struct EpiQKV {
    static constexpr bool PERM = true;
    bf16_t* O; int ldc; float s_lo; int n_lo; float s_one; int i_one;
    __device__ __forceinline__ void operator()(const f32x4 (&acc)[2][2][4][2], const Unit& u, int wr, int wc, int fr, int fq) const {
        const int row0 = u.pm * BM + wr * 64 + fr; const int col0 = u.pn * BM + wc * 32 + 8 * fq;
        const float sc = (u.pn < n_lo) ? s_lo : ((u.pn == i_one) ? s_one : 1.f);
#pragma unroll
        for (int ai = 0; ai < 2; ++ai)
#pragma unroll
            for (int m = 0; m < 4; ++m) { bf16_t* rowp = O + (size_t)(row0 + ai * HALF + m * 16) * ldc + col0;
#pragma unroll
                for (int bj = 0; bj < 2; ++bj) { f32x4 v0 = acc[ai][bj][m][0] * sc, v1 = acc[ai][bj][m][1] * sc;
                    u32x4 w; w.x = cvt_pk_bf16(v0[0], v0[1]); w.y = cvt_pk_bf16(v0[2], v0[3]); w.z = cvt_pk_bf16(v1[0], v1[1]); w.w = cvt_pk_bf16(v1[2], v1[3]);
                    *(u32x4*)(rowp + bj * HALF) = w; } }
    }
};
template <bool BASE_F32> struct EpiResid {
    static constexpr bool PERM = true;
    const float* base32; bf16_t* xb; const float* gate;
    __device__ __forceinline__ void operator()(const f32x4 (&acc)[2][2][4][2], const Unit& u, int wr, int wc, int fr_, int fq_) const {
        int fr = fr_, fq = fq_; asm volatile("" : "+v"(fr), "+v"(fq));
        const int b = (u.pm * BM) >> 12; const float* gp = gate + (size_t)b * 6144;
        const int col0 = u.pn * BM + wc * 32 + 8 * fq;
        if constexpr (!BASE_F32) {
            const unsigned ob0 = (unsigned)(((u.pm * BM + wr * 64 + fr) * DM + col0) * 2);
#pragma unroll
            for (int bj = 0; bj < 2; ++bj) { const f32x4 g0 = *(const f32x4*)(gp + col0 + bj * HALF), g1 = *(const f32x4*)(gp + col0 + bj * HALF + 4);
                u32x4 xr[2][4];
#pragma unroll
                for (int ai = 0; ai < 2; ++ai)
#pragma unroll
                    for (int m = 0; m < 4; ++m) { const unsigned ob = ob0 + (unsigned)(((ai * HALF + m * 16) * DM + bj * HALF) * 2); xr[ai][m] = *(const u32x4*)((const char*)xb + ob); }
#pragma unroll
                for (int ai = 0; ai < 2; ++ai)
#pragma unroll
                    for (int m = 0; m < 4; ++m) { const unsigned ob = ob0 + (unsigned)(((ai * HALF + m * 16) * DM + bj * HALF) * 2); const u32x4 r = xr[ai][m];
                        const f32x4 x0 = (f32x4){bflo(r.x), bfhi(r.x), bflo(r.y), bfhi(r.y)}, x1 = (f32x4){bflo(r.z), bfhi(r.z), bflo(r.w), bfhi(r.w)};
                        const f32x4 y0 = x0 + g0 * acc[ai][bj][m][0], y1 = x1 + g1 * acc[ai][bj][m][1];
                        u32x4 w; w.x = cvt_pk_bf16(y0[0], y0[1]); w.y = cvt_pk_bf16(y0[2], y0[3]); w.z = cvt_pk_bf16(y1[0], y1[1]); w.w = cvt_pk_bf16(y1[2], y1[3]);
                        *(u32x4*)((char*)xb + ob) = w; } }
            return;
        }
#pragma unroll
        for (int bj = 0; bj < 2; ++bj) { const f32x4 g0 = *(const f32x4*)(gp + col0 + bj * HALF), g1 = *(const f32x4*)(gp + col0 + bj * HALF + 4);
#pragma unroll
            for (int ai = 0; ai < 2; ++ai) {
                f32x4 x0[4], x1[4];
#pragma unroll
                for (int m = 0; m < 4; ++m) { const size_t off = (size_t)(u.pm * BM + ai * HALF + wr * 64 + m * 16 + fr) * DM + col0 + bj * HALF;
                    if (BASE_F32) { x0[m] = *(const f32x4*)(base32 + off); x1[m] = *(const f32x4*)(base32 + off + 4); }
                    else { const u32x4 xr = *(const u32x4*)(xb + off); x0[m] = (f32x4){bflo(xr.x), bfhi(xr.x), bflo(xr.y), bfhi(xr.y)}; x1[m] = (f32x4){bflo(xr.z), bfhi(xr.z), bflo(xr.w), bfhi(xr.w)}; } }
#pragma unroll
                for (int m = 0; m < 4; ++m) { const size_t off = (size_t)(u.pm * BM + ai * HALF + wr * 64 + m * 16 + fr) * DM + col0 + bj * HALF;
                    const f32x4 y0 = x0[m] + g0 * acc[ai][bj][m][0], y1 = x1[m] + g1 * acc[ai][bj][m][1];
                    u32x4 w; w.x = cvt_pk_bf16(y0[0], y0[1]); w.y = cvt_pk_bf16(y0[2], y0[3]); w.z = cvt_pk_bf16(y1[0], y1[1]); w.w = cvt_pk_bf16(y1[2], y1[3]);
                    *(u32x4*)(xb + off) = w; } } }
    }
};
struct EpiSwiGLU {
    static constexpr bool PERM = true;
    bf16_t* ACT; const float* wlist; const int* cnt;
    __device__ __forceinline__ void operator()(const f32x4 (&acc)[2][2][4][2], const Unit& u, int wr, int wc, int fr, int fq) const {
        const int n_e = cnt[u.e]; const int col0 = (u.pn & 3) * 128 + wc * 32 + 8 * fq;
#pragma unroll
        for (int ai = 0; ai < 2; ++ai)
#pragma unroll
            for (int m = 0; m < 4; ++m) { const int rloc = ai * HALF + wr * 64 + m * 16 + fr; const int pos = u.t0 * 256 + rloc;
                const float w = pos < n_e ? wlist[(size_t)u.e * NTOK + pos] : 0.f;
                float r[8];
#pragma unroll
                for (int n = 0; n < 2; ++n)
#pragma unroll
                    for (int i = 0; i < 4; ++i) { const float g = acc[ai][0][m][n][i], uu = acc[ai][1][m][n][i];
                        r[n * 4 + i] = g * __builtin_amdgcn_rcpf(1.f + __expf(-g)) * uu * w; }
                u32x4 o; o.x = cvt_pk_bf16(r[0], r[1]); o.y = cvt_pk_bf16(r[2], r[3]); o.z = cvt_pk_bf16(r[4], r[5]); o.w = cvt_pk_bf16(r[6], r[7]);
                *(u32x4*)(ACT + (size_t)(u.pm * BM + rloc) * 512 + col0) = o; }
    }
};
struct EpiSwiGLU8 {
    static constexpr bool PERM = true;
    unsigned char* ACT8; const float* wlist;
    __device__ __forceinline__ void operator()(const f32x4 (&acc)[2][2][4][2], const Unit& u, int wr, int wc, int fr_, int fq_) const {
        int fr = fr_, fq = fq_; asm volatile("" : "+v"(fr), "+v"(fq));
        const int n_e = u.ne; const int col0 = (u.pn & 3) * 128 + wc * 32 + 8 * fq;
        float w8[8];
#pragma unroll
        for (int q = 0; q < 8; ++q) { const int pos = u.t0 * 256 + (q >> 2) * HALF + wr * 64 + (q & 3) * 16 + fr; w8[q] = wlist[(size_t)u.e * NTOK + pos]; }
#pragma unroll
        for (int ai = 0; ai < 2; ++ai)
#pragma unroll
            for (int m = 0; m < 4; ++m) { const int rloc = ai * HALF + wr * 64 + m * 16 + fr; const int pos = u.t0 * 256 + rloc;
                const float w = pos < n_e ? w8[ai * 4 + m] * F8_ACT_SCALE : 0.f;
                float r[8];
#pragma unroll
                for (int n = 0; n < 2; ++n)
#pragma unroll
                    for (int i = 0; i < 4; ++i) { const float g = acc[ai][0][m][n][i], uu = acc[ai][1][m][n][i];
                        r[n * 4 + i] = g * __builtin_amdgcn_rcpf(1.f + __expf(-g)) * uu * w; }
                u32x2 o; o.x = pk4_fp8(r[0], r[1], r[2], r[3]); o.y = pk4_fp8(r[4], r[5], r[6], r[7]);
                *(u32x2*)(ACT8 + (size_t)(u.pm * BM + rloc) * 512 + col0) = o; }
    }
};
struct EpiScatterY {
    static constexpr bool PERM = true;
    bf16_t* Y; const int* plist;
    __device__ __forceinline__ void operator()(const f32x4 (&acc)[2][2][4][2], const Unit& u, int wr, int wc, int fr_, int fq_) const {
        int fr = fr_, fq = fq_; asm volatile("" : "+v"(fr), "+v"(fq));
        const int n_e = u.ne; const int col0 = (u.pn & 3) * 256 + wc * 32 + 8 * fq;
        int yr[8];
#pragma unroll
        for (int q = 0; q < 8; ++q) { const int pos = u.t0 * 256 + (q >> 2) * HALF + wr * 64 + (q & 3) * 16 + fr; yr[q] = plist[(size_t)u.e * NTOK + pos]; }
#pragma unroll
        for (int ai = 0; ai < 2; ++ai)
#pragma unroll
            for (int m = 0; m < 4; ++m) { const int rloc = ai * HALF + wr * 64 + m * 16 + fr; const int pos = u.t0 * 256 + rloc;
                const int yrow = pos < n_e ? yr[ai * 4 + m] : 2 * NTOK;
                unsigned char* rowp = (unsigned char*)Y + (size_t)yrow * DM + col0;
#pragma unroll
                for (int bj = 0; bj < 2; ++bj) { const f32x4 v0 = acc[ai][bj][m][0] * 32.f, v1 = acc[ai][bj][m][1] * 32.f;
                    u32x2 w; w.x = pk4_fp8(v0[0], v0[1], v0[2], v0[3]); w.y = pk4_fp8(v1[0], v1[1], v1[2], v1[3]);
                    *(u32x2*)(rowp + bj * HALF) = w; } }
    }
};

__device__ __forceinline__ void glds_s(const char* sbase_, unsigned voff, unsigned lds_dst) {
    const unsigned long long pb_ = (unsigned long long)sbase_;
    const char* sbase = (const char*)(((unsigned long long)(unsigned)__builtin_amdgcn_readfirstlane((int)(pb_ >> 32)) << 32) | (unsigned long long)(unsigned)__builtin_amdgcn_readfirstlane((int)(unsigned)pb_));
    unsigned keep;
    asm volatile("s_mov_b32 %0, m0\n\ts_mov_b32 m0, %3\n\ts_nop 0\n\tglobal_load_lds_dwordx4 %1, %2\n\ts_mov_b32 m0, %0"
                 : "=&s"(keep) : "v"(voff), "s"(sbase), "s"(lds_dst) : "memory");
}
template <class Epi, class Sched, bool GATHER, bool ALIGN_EPI, bool F8 = false>
__device__ __forceinline__ void gemm_phase(LAS unsigned char* lds, const int tid, const Gemm g, const Sched& S, const Epi& E) {
    const int wid = __builtin_amdgcn_readfirstlane(tid >> 6), lane = tid & 63, wr = wid >> 2, wc = wid & 3, fr = lane & 15, fq = lane >> 4;
    int K_ = g.K; asm volatile("" : "+s"(K_));
    const int K = K_, nt = K / BK;
    unsigned voffB[2]; int sR[2], sC[2];
#pragma unroll
    for (int i = 0; i < 2; ++i) { int R, C; stage_rc(tid * 16 + i * 8192, R, C); const int Rb = Epi::PERM ? ((R & ~31) + perm32(R & 31)) : R;
        voffB[i] = (unsigned)(Rb * K + C) * 2u; sR[i] = R; sC[i] = C; }
    const size_t kstep = (size_t)(BK * 2);
    const size_t hstep = (size_t)HALF * K * 2;
    const size_t tstep = 2 * hstep;
    const unsigned ldsw = (unsigned)wid * 1024u;
    const unsigned ldsbase = (unsigned)__builtin_amdgcn_readfirstlane((int)(unsigned)(uintptr_t)lds);
    const int aoff = lds_byte(wr * 64 + fr, fq * 8), boff = lds_byte(wc * 32 + fr, fq * 8);
    constexpr int KOFF = 1024;
#define PG8_SA(b, h) (((b) * 2 + (h)) * HTB)
#define PG8_SB(b, h) ((4 + (b) * 2 + (h)) * HTB)
#define PG8_STAGE_B(bufoff, gbase) do { _Pragma("unroll") for (int _i = 0; _i < 2; ++_i) glds_s((const char*)(gbase), voffB[_i], ldsbase + (unsigned)(bufoff) + ldsw + (unsigned)(_i * 8192)); } while (0)
#define PG8_STAGE_A(bufoff, gbase, o) do { _Pragma("unroll") for (int _i = 0; _i < 2; ++_i) glds_s((const char*)(gbase), (o)[_i], ldsbase + (unsigned)(bufoff) + ldsw + (unsigned)(_i * 8192)); } while (0)
#define PG8_LD8(p) __builtin_shufflevector(*(const LAS v4i32*)(p), *(const LAS v4i32*)((p) + KOFF), 0, 1, 2, 3, 4, 5, 6, 7)
#define PG8_LDA8(dst, b, h) do { _Pragma("unroll") for (int m = 0; m < 4; ++m) dst[m] = PG8_LD8(lds + PG8_SA(b, h) + aoff + m * 2048); } while (0)
#define PG8_LDB8(dst, b, h) do { _Pragma("unroll") for (int n = 0; n < 2; ++n) dst[n] = PG8_LD8(lds + PG8_SB(b, h) + boff + n * 2048); } while (0)
#define PG8_MMA8(ai, bj, A8, B8) do { __builtin_amdgcn_s_setprio(1); _Pragma("unroll") for (int m = 0; m < 4; ++m) _Pragma("unroll") for (int n = 0; n < 2; ++n) \
        asm volatile("v_mfma_scale_f32_16x16x128_f8f6f4 %0, %1, %2, %0, %3, %4 op_sel_hi:[0,0,0]" : "+v"(acc[ai][bj][m][n]) : "v"(B8[n]), "v"(A8[m]), "v"(sc_w), "v"(sc_a)); \
        __builtin_amdgcn_s_setprio(0); } while (0)
#define PG8_LDA(dst, b, h) do { _Pragma("unroll") for (int m = 0; m < 4; ++m) _Pragma("unroll") for (int k = 0; k < 2; ++k) dst[m][k] = *(const LAS bf16x8*)(lds + PG8_SA(b, h) + aoff + m * 2048 + k * KOFF); } while (0)
#define PG8_LDB(dst, b, h) do { _Pragma("unroll") for (int n = 0; n < 2; ++n) _Pragma("unroll") for (int k = 0; k < 2; ++k) dst[n][k] = *(const LAS bf16x8*)(lds + PG8_SB(b, h) + boff + n * 2048 + k * KOFF); } while (0)
#define PG8_MMA(ai, bj, At, Bt) do { __builtin_amdgcn_s_setprio(1); _Pragma("unroll") for (int m = 0; m < 4; ++m) _Pragma("unroll") for (int n = 0; n < 2; ++n) _Pragma("unroll") for (int k = 0; k < 2; ++k) \
        acc[ai][bj][m][n] = __builtin_amdgcn_mfma_f32_16x16x32_bf16(Bt[n][k], At[m][k], acc[ai][bj][m][n], 0, 0, 0); __builtin_amdgcn_s_setprio(0); } while (0)
#define PG8_WAIT_V(n) asm volatile("s_waitcnt vmcnt(" #n ")" ::: "memory")
#define PG8_WAIT_L(n) asm volatile("s_waitcnt lgkmcnt(" #n ")" ::: "memory")
#define PG8_BAR __builtin_amdgcn_s_barrier()
#define PG8_SCHED __builtin_amdgcn_sched_barrier(0)
#define PG8_SETOFF(o, u) do { _Pragma("unroll") for (int _h = 0; _h < 2; ++_h) _Pragma("unroll") for (int _i = 0; _i < 2; ++_i) \
        (o)[_h][_i] = GATHER ? ((unsigned)S.arow(u, _h * HALF + sR[_i]) * (unsigned)(K * 2) + (unsigned)(sC[_i] * 2)) : (unsigned)(((_h * HALF + sR[_i]) * K + sC[_i]) * 2); } while (0)
    Unit cur, nxt; int ui = 0;
    if (!S.next(0, cur)) return;
    unsigned offA[2][2], noffA[2][2];
    PG8_SETOFF(offA, cur);
    f32x4 acc[2][2][4][2];
#pragma unroll
    for (int a = 0; a < 2; ++a)
#pragma unroll
        for (int b = 0; b < 2; ++b)
#pragma unroll
            for (int m = 0; m < 4; ++m)
#pragma unroll
                for (int n = 0; n < 2; ++n) acc[a][b][m][n] = (f32x4){0.f, 0.f, 0.f, 0.f};
    bf16x8 At[4][2], B0[2][2], B1[2][2];
    v8i32 At8[4], B08[2], B18[2];
    int sc_w = F8_SC_W, sc_a = F8_SC_ACT; asm volatile("" : "+v"(sc_w), "+v"(sc_a));
    const char* cA = GATHER ? (const char*)g.A : (const char*)g.A + (size_t)cur.pm * tstep; const char* cB = (const char*)g.Bt + (size_t)cur.pn * tstep;
    PG8_STAGE_B(PG8_SB(0, 0), cB); PG8_STAGE_B(PG8_SB(0, 1), cB + hstep); PG8_STAGE_A(PG8_SA(0, 0), cA, offA[0]); PG8_STAGE_A(PG8_SA(0, 1), cA, offA[1]);
    if (wr == 1) PG8_BAR;
    PG8_WAIT_V(2); PG8_BAR;
    PG8_STAGE_B(PG8_SB(1, 0), cB + kstep); PG8_STAGE_A(PG8_SA(1, 0), cA + kstep, offA[0]); PG8_STAGE_B(PG8_SB(1, 1), cB + hstep + kstep);
    PG8_WAIT_V(6); PG8_BAR;
    for (;;) {
        const bool has_next = S.next(ui + 1, nxt);
        if (GATHER) { if (has_next) { PG8_SETOFF(noffA, nxt); } else {
#pragma unroll
            for (int h = 0; h < 2; ++h)
#pragma unroll
                for (int i = 0; i < 2; ++i) noffA[h][i] = offA[h][i]; } }
        const char* nA = GATHER ? cA : (has_next ? (const char*)g.A + (size_t)nxt.pm * tstep : cA); const char* nB = has_next ? (const char*)g.Bt + (size_t)nxt.pn * tstep : cB;
        for (int t = 0; t < nt; t += 2) {
            const bool last = (t == nt - 2);
            const char* a1 = cA + (size_t)(t + 1) * kstep;
            const char* a2 = last ? nA : cA + (size_t)(t + 2) * kstep; const char* b2 = last ? nB : cB + (size_t)(t + 2) * kstep;
            const char* a3 = a2 + kstep; const char* b3 = b2 + kstep;
            unsigned o2[2][2];
#pragma unroll
            for (int h = 0; h < 2; ++h)
#pragma unroll
                for (int i = 0; i < 2; ++i) o2[h][i] = (GATHER && last) ? noffA[h][i] : offA[h][i];
            if constexpr (F8) {
            PG8_LDB8(B08, 0, 0); PG8_LDB8(B18, 0, 1); PG8_SCHED; PG8_LDA8(At8, 0, 0); PG8_STAGE_A(PG8_SA(1, 1), a1, offA[1]);
            PG8_WAIT_V(8); PG8_WAIT_L(0); PG8_BAR; PG8_MMA8(0, 0, At8, B08); PG8_MMA8(0, 1, At8, B18); PG8_BAR; PG8_SCHED;
            PG8_LDA8(At8, 0, 1); PG8_STAGE_B(PG8_SB(0, 0), b2); PG8_STAGE_B(PG8_SB(0, 1), b2 + hstep); PG8_STAGE_A(PG8_SA(0, 0), a2, o2[0]);
            PG8_WAIT_V(8); PG8_WAIT_L(0); PG8_BAR; PG8_MMA8(1, 0, At8, B08); PG8_MMA8(1, 1, At8, B18); PG8_BAR; PG8_SCHED;
            PG8_LDB8(B08, 1, 0); PG8_LDB8(B18, 1, 1); PG8_SCHED; PG8_LDA8(At8, 1, 0); PG8_STAGE_A(PG8_SA(0, 1), a2, o2[1]);
            PG8_WAIT_V(8); PG8_WAIT_L(0); PG8_BAR; PG8_MMA8(0, 0, At8, B08); PG8_MMA8(0, 1, At8, B18); PG8_BAR; PG8_SCHED;
            PG8_LDA8(At8, 1, 1); PG8_STAGE_B(PG8_SB(1, 0), b3); PG8_STAGE_B(PG8_SB(1, 1), b3 + hstep); PG8_STAGE_A(PG8_SA(1, 0), a3, o2[0]);
            PG8_WAIT_V(8); PG8_WAIT_L(0); PG8_BAR; PG8_MMA8(1, 0, At8, B08); PG8_MMA8(1, 1, At8, B18); PG8_BAR; PG8_SCHED;
            } else {
            PG8_LDB(B0, 0, 0); PG8_LDB(B1, 0, 1); PG8_SCHED; PG8_LDA(At, 0, 0); PG8_STAGE_A(PG8_SA(1, 1), a1, offA[1]);
            PG8_WAIT_V(8); PG8_WAIT_L(0); PG8_BAR; PG8_MMA(0, 0, At, B0); PG8_MMA(0, 1, At, B1); PG8_BAR; PG8_SCHED;
            PG8_LDA(At, 0, 1); PG8_STAGE_B(PG8_SB(0, 0), b2); PG8_STAGE_B(PG8_SB(0, 1), b2 + hstep); PG8_STAGE_A(PG8_SA(0, 0), a2, o2[0]);
            PG8_WAIT_V(8); PG8_WAIT_L(0); PG8_BAR; PG8_MMA(1, 0, At, B0); PG8_MMA(1, 1, At, B1); PG8_BAR; PG8_SCHED;
            PG8_LDB(B0, 1, 0); PG8_LDB(B1, 1, 1); PG8_SCHED; PG8_LDA(At, 1, 0); PG8_STAGE_A(PG8_SA(0, 1), a2, o2[1]);
            PG8_WAIT_V(8); PG8_WAIT_L(0); PG8_BAR; PG8_MMA(0, 0, At, B0); PG8_MMA(0, 1, At, B1); PG8_BAR; PG8_SCHED;
            PG8_LDA(At, 1, 1); PG8_STAGE_B(PG8_SB(1, 0), b3); PG8_STAGE_B(PG8_SB(1, 1), b3 + hstep); PG8_STAGE_A(PG8_SA(1, 0), a3, o2[0]);
            PG8_WAIT_V(8); PG8_WAIT_L(0); PG8_BAR; PG8_MMA(1, 0, At, B0); PG8_MMA(1, 1, At, B1); PG8_BAR; PG8_SCHED;
            }
        }
        if constexpr (ALIGN_EPI) { if (wr == 0) PG8_BAR; }
        if constexpr (F8) asm volatile("s_nop 15\n\ts_nop 15" ::: "memory");
        E(acc, cur, wr, wc, fr, fq);
        if (!has_next) break;
#pragma unroll
        for (int a = 0; a < 2; ++a)
#pragma unroll
            for (int b = 0; b < 2; ++b)
#pragma unroll
                for (int m = 0; m < 4; ++m)
#pragma unroll
                    for (int n = 0; n < 2; ++n) acc[a][b][m][n] = (f32x4){0.f, 0.f, 0.f, 0.f};
        cur = nxt; cA = nA; cB = nB; ++ui;
#pragma unroll
        for (int h = 0; h < 2; ++h)
#pragma unroll
            for (int i = 0; i < 2; ++i) offA[h][i] = noffA[h][i];
        if constexpr (ALIGN_EPI) { if (wr == 1) PG8_BAR; }
    }
    PG8_WAIT_V(0);
    if constexpr (!ALIGN_EPI) { if (wr == 0) PG8_BAR; }
    PG8_BAR;
#undef PG8_SA
#undef PG8_SB
#undef PG8_STAGE_A
#undef PG8_STAGE_B
#undef PG8_LDA
#undef PG8_LDA8
#undef PG8_LD8
#undef PG8_LDB8
#undef PG8_MMA8
#undef PG8_LDB
#undef PG8_MMA
#undef PG8_WAIT_V
#undef PG8_WAIT_L
#undef PG8_BAR
#undef PG8_SCHED
#undef PG8_SETOFF
}
}

#define XB_TMO      128
#define XB_XCNT(j)  (256  + 64 * (j))
#define XB_XSUB(j)  (1280 + 64 * (j))
#define XB_XGEN(j)  (2304 + 64 * (j))
#define XB_TOP      3328
#define XB_TOPGEN   3392
#define XCD_BAR_WORDS 3456
#define XB_SPIN_CAP (1u << 18)
__device__ __forceinline__ unsigned xb_ld(unsigned* p)              { return __hip_atomic_load(p, __ATOMIC_RELAXED, __HIP_MEMORY_SCOPE_AGENT); }
__device__ __forceinline__ unsigned xb_add(unsigned* p, unsigned v) { return __hip_atomic_fetch_add(p, v, __ATOMIC_RELAXED, __HIP_MEMORY_SCOPE_AGENT); }
__device__ __forceinline__ unsigned xb_xcc_id() { return (unsigned)__builtin_amdgcn_s_getreg((3 << 11) | 20) & 0xFu; }
#define XB_SPIN(cond, bar) do { unsigned _sp = 0; while (cond) { __builtin_amdgcn_s_sleep(1); \
    if ((++_sp & 255u) == 0u) { if (xb_ld(&(bar)[XB_TMO])) break; if (_sp > XB_SPIN_CAP) { atomicAdd(&(bar)[XB_TMO], 1u); break; } } } } while (0)
struct XcdBarrier { unsigned* bar; unsigned x; volatile LAS unsigned* st; };
__device__ __forceinline__ XcdBarrier xcd_barrier_post(unsigned* bar, volatile LAS unsigned* st) {
    XcdBarrier b; b.bar = bar; b.x = xb_xcc_id(); b.st = st;
    if (threadIdx.x == 0) (void)xb_add(&bar[XB_XCNT(b.x)], 1u);
    return b;
}
__device__ __forceinline__ void xcd_barrier_complete(unsigned* bar, unsigned x, unsigned& nloc, unsigned& nx) {
    const unsigned G = gridDim.x * gridDim.y * gridDim.z;
    unsigned sum, cnt, mine, sp = 0u;
    for (;;) {
        sum = 0u; cnt = 0u; mine = 0u;
#pragma unroll 1
        for (unsigned j = 0; j < 16; ++j) { const unsigned c = xb_ld(&bar[XB_XCNT(j)]); sum += c; cnt += (c > 0u) ? 1u : 0u; mine = (j == x) ? c : mine; }
        if (sum == G) break;
        __builtin_amdgcn_s_sleep(1);
        if ((++sp & 255u) == 0u) { if (xb_ld(&bar[XB_TMO])) break; if (sp > XB_SPIN_CAP) { atomicAdd(&bar[XB_TMO], 1u); break; } }
    }
    nloc = mine > 0u ? mine : 1u; nx = cnt > 0u ? cnt : 1u;
}
__device__ __forceinline__ void xcd_barrier(const XcdBarrier& b) {
    asm volatile("s_waitcnt vmcnt(0)" ::: "memory");
    __syncthreads();
    if (threadIdx.x == 0) {
        unsigned* bar = b.bar;
        __builtin_amdgcn_s_waitcnt(0);
        unsigned nloc = b.st[0], nx = b.st[1];
        if (nloc == 0u) { xcd_barrier_complete(bar, b.x, nloc, nx); b.st[0] = nloc; b.st[1] = nx; }
        const unsigned old = xb_add(&bar[XB_XSUB(b.x)], 1u);
        const unsigned gen = old / nloc;
        if (old + 1u == (gen + 1u) * nloc) {
            __builtin_amdgcn_fence(__ATOMIC_RELEASE, "agent");
            asm volatile("s_waitcnt vmcnt(0)" ::: "memory");
            const unsigned og = xb_add(&bar[XB_TOP], 1u);
            const unsigned tg = og / nx;
            if (og + 1u == (tg + 1u) * nx) xb_add(&bar[XB_TOPGEN], 1u);
            else XB_SPIN(xb_ld(&bar[XB_TOPGEN]) == tg, bar);
            __builtin_amdgcn_fence(__ATOMIC_ACQUIRE, "agent");
            xb_add(&bar[XB_XGEN(b.x)], 1u);
            asm volatile("s_waitcnt vmcnt(0)" ::: "memory");
        } else {
            XB_SPIN(xb_ld(&bar[XB_XGEN(b.x)]) == gen, bar);
            __builtin_amdgcn_fence(__ATOMIC_ACQUIRE, "agent");
            asm volatile("s_waitcnt vmcnt(0)" ::: "memory");
        }
    }
    __syncthreads();
}

struct Args {
    const float* in[24]; float* out; unsigned char* ws; int ph_lo, ph_hi;
};
struct Ctx {
    LAS unsigned char* lds;
    int tid, lane, wave, vcu, G;
    const Args* a;
};
__device__ __forceinline__ Ctx launder(const Ctx& C) {
    Ctx P = C; int t = C.tid; asm volatile("" : "+v"(t)); P.tid = t; P.lane = t & 63; P.wave = __builtin_amdgcn_readfirstlane(t >> 6);
    int v = C.vcu, g = C.G; asm volatile("" : "+s"(v), "+s"(g)); P.vcu = v; P.G = g;
    unsigned lo = (unsigned)(uintptr_t)C.lds; asm volatile("" : "+s"(lo)); P.lds = (LAS unsigned char*)(uintptr_t)lo;
    return P;
}
enum { I_X = 0, I_C, I_WADA, I_BADA, I_NMIX, I_NFFN, I_NFIN, I_RELB, I_EWIN, I_ELAM, I_ESUBLN, I_EGK2, I_EBGK, I_EGLAN, I_EWOUT, I_OWIN, I_OWOUT,
       I_RGW, I_RGB, I_REW, I_REB, I_WG, I_WU, I_WDN };

__device__ __forceinline__ float wave_sum(float v) {
#pragma unroll
    for (int o = 1; o < 64; o <<= 1) v += __shfl_xor(v, o);
    return v;
}
template <int CTRL> __device__ __forceinline__ float dpp_mov(float v) { return __builtin_bit_cast(float, __builtin_amdgcn_update_dpp(0, __builtin_bit_cast(int, v), CTRL, 0xf, 0xf, true)); }
__device__ __forceinline__ float sum8_dpp(float v) { v += dpp_mov<0xB1>(v); v += dpp_mov<0x4E>(v); v += dpp_mov<0x141>(v); return v; }
__device__ __forceinline__ float sum16_dpp(float v) { v = sum8_dpp(v); v += dpp_mov<0x140>(v); return v; }

__device__ __forceinline__ float reduce4(const float (&v)[4], int) {
    float a0 = v[0], a2 = v[2], a1 = v[1], a3 = v[3];
    swap32(a0, a2); swap32(a1, a3);
    float A0 = a0 + a2, A1 = a1 + a3;
    swap16(A0, A1);
    const float c = A0 + A1;
    return sum16_dpp(c);
}

__device__ __forceinline__ void transpose_item(const float* W, int ldw, int K, bf16* WT, size_t drow0, LAS float* scr, int k0, int n0, int lane) {
#pragma unroll 8
    for (int i = 0; i < 32; ++i) { const int kk = 2 * i + (lane >> 5); scr[kk * 33 + (lane & 31)] = W[(size_t)(k0 + kk) * ldw + n0 + (lane & 31)]; }
    LDS_WAIT(); asm volatile("" ::: "memory");
    const int c = lane & 7;
#pragma unroll
    for (int j = 0; j < 4; ++j) { const int n = (lane >> 3) + 8 * j; const LAS float* s = scr + (8 * c) * 33 + n;
        u32x4 o; o.x = pk2(s[0 * 33], s[1 * 33]); o.y = pk2(s[2 * 33], s[3 * 33]); o.z = pk2(s[4 * 33], s[5 * 33]); o.w = pk2(s[6 * 33], s[7 * 33]);
        *(u32x4*)(WT + (drow0 + n) * K + k0 + 8 * c) = o; }
    LDS_WAIT(); asm volatile("" ::: "memory");
}
__device__ __forceinline__ void transpose_item8w(const float* W, int ldw, int K, unsigned char* WT8, size_t drow0, LAS float* scr, int k0, int n0, int lane) {
#pragma unroll 16
    for (int i = 0; i < 64; ++i) { const int kk = 2 * i + (lane >> 5); scr[kk * 33 + (lane & 31)] = __builtin_nontemporal_load(W + (size_t)(k0 + kk) * ldw + n0 + (lane & 31)); }
    LDS_WAIT(); asm volatile("" ::: "memory");
    const int n = lane & 31, kh = lane >> 5;
    unsigned char* op = WT8 + (drow0 + n) * K + k0 + 64 * kh;
#pragma unroll
    for (int q = 0; q < 4; ++q) { u32x4 o;
#pragma unroll
        for (int w = 0; w < 4; ++w) { const LAS float* p = scr + (64 * kh + 16 * q + 4 * w) * 33 + n; o[w] = pk4_fp8(p[0] * F8_W_SCALE, p[33] * F8_W_SCALE, p[66] * F8_W_SCALE, p[99] * F8_W_SCALE); }
        *(u32x4*)(op + 16 * q) = o; }
    LDS_WAIT(); asm volatile("" ::: "memory");
}
__device__ __forceinline__ void transpose_item8(const float* W, int ldw, int K, unsigned char* WT8, size_t drow0, LAS float* scr, int k0, int n0, int lane) {
#pragma unroll 8
    for (int i = 0; i < 32; ++i) { const int kk = 2 * i + (lane >> 5); scr[kk * 33 + (lane & 31)] = W[(size_t)(k0 + kk) * ldw + n0 + (lane & 31)]; }
    LDS_WAIT(); asm volatile("" ::: "memory");
    const int c = lane & 7;
#pragma unroll
    for (int j = 0; j < 4; ++j) { const int n = (lane >> 3) + 8 * j; const LAS float* s = scr + (8 * c) * 33 + n;
        u32x2 o; o.x = pk4_fp8(s[0 * 33] * F8_W_SCALE, s[1 * 33] * F8_W_SCALE, s[2 * 33] * F8_W_SCALE, s[3 * 33] * F8_W_SCALE); o.y = pk4_fp8(s[4 * 33] * F8_W_SCALE, s[5 * 33] * F8_W_SCALE, s[6 * 33] * F8_W_SCALE, s[7 * 33] * F8_W_SCALE);
        *(u32x2*)(WT8 + (drow0 + n) * K + k0 + 8 * c) = o; }
    LDS_WAIT(); asm volatile("" ::: "memory");
}
__device__ __forceinline__ void p0_prologue(const Ctx& C) {
    LAS float* sc = (LAS float*)(C.lds);
    LAS float* part = (LAS float*)(C.lds + 32768);
    for (int i = C.tid; i < 8192; i += 512) { const float cv = C.a->in[I_C][i]; sc[i] = cv / (1.f + __expf(-cv)); }
    __syncthreads();
    for (int it = blockIdx.x; it < 384; it += C.G) {
        const int l = it / 96, e0 = (it % 96) * 64;
        float acc[8];
#pragma unroll
        for (int b = 0; b < 8; ++b) acc[b] = 0.f;
        const float* wp = C.a->in[I_WADA] + ((size_t)l * 1024 + C.wave * 128) * 6144 + e0 + C.lane;
#pragma unroll 16
        for (int dd = 0; dd < 128; ++dd) { const float w = __builtin_nontemporal_load(wp + (size_t)dd * 6144);
#pragma unroll
            for (int b = 0; b < 8; ++b) acc[b] += sc[b * 1024 + C.wave * 128 + dd] * w; }
#pragma unroll
        for (int b = 0; b < 8; ++b) part[(C.wave * 8 + b) * 64 + C.lane] = acc[b];
        __syncthreads();
        { const int b = C.tid >> 6, col = C.tid & 63; float s = C.a->in[I_BADA][l * 6144 + e0 + col];
#pragma unroll
          for (int w = 0; w < 8; ++w) s += part[(w * 8 + b) * 64 + col];
          ((float*)(C.a->ws + WS_MOD))[((size_t)l * 8 + b) * 6144 + e0 + col] = s; }
        __syncthreads();
    }
    const int gt = blockIdx.x * 512 + C.tid, NGT = C.G * 512;
    for (int i = gt; i < 4 * 36 * 1024; i += NGT) { const int l = i / (36 * 1024), jj = (i >> 10) % 36, d = i & 1023;
        const float v = jj < 4 ? C.a->in[I_RGW][((size_t)l * 1024 + d) * 4 + jj] : C.a->in[I_REW][((size_t)l * 1024 + d) * 32 + (jj - 4)];
        ((bf16*)(C.a->ws + WS_WR))[i] = (bf16)f2bf(v); }
    for (int i = gt; i < 2 * 16 * 1024; i += NGT) { const int ii = i >> 14, r = (i >> 10) & 15, d = i & 1023;
        ((bf16*)(C.a->ws + WS_WBG))[i] = (bf16)f2bf(C.a->in[I_EWIN][((size_t)ii * 1024 + d) * 3088 + 3072 + r]); }
    for (int i = gt; i < 256; i += NGT) ((unsigned*)(C.a->ws + WS_H8 + (size_t)NTOK * DM))[i] = 0u;
    LAS float* scr = (LAS float*)(C.lds + C.wave * 16896);
    const int gw = C.vcu * 8 + C.wave, NGW = C.G * 8;
    constexpr int I_IN = 16 * 96, I_OUT = 16 * 16, I_E = 128;
    constexpr int NITEMS = 4 * I_IN + 4 * I_OUT + 3 * 128 * I_E;
    for (int it = gw; it < NITEMS; it += NGW) {
        int r = it;
        if (r < 4 * I_IN) { const int l = r / I_IN, q = r % I_IN, kb = q / 96, nb = q % 96; const int i = l >> 1;
            const float* W = (l & 1) ? C.a->in[I_OWIN] + (size_t)i * 1024 * 3072 : C.a->in[I_EWIN] + (size_t)i * 1024 * 3088;
            transpose_item(W, (l & 1) ? 3072 : 3088, 1024, ((bf16*)(C.a->ws + WS_WIN)) + (size_t)l * 3072 * 1024, (size_t)nb * 32, scr, kb * 64, nb * 32, C.lane); continue; }
        r -= 4 * I_IN;
        if (r < 4 * I_OUT) { const int l = r / I_OUT, q = r % I_OUT, kb = q / 32, nb = q % 32; const int i = l >> 1;
            const float* W = ((l & 1) ? C.a->in[I_OWOUT] : C.a->in[I_EWOUT]) + (size_t)i * 1024 * 1024;
            transpose_item8w(W, 1024, 1024, (unsigned char*)(C.a->ws + WS_WOUT) + (size_t)l * 1024 * 1024, (size_t)nb * 32, scr, kb * 128, nb * 32, C.lane); continue; }
        r -= 4 * I_OUT;
        const int job = r / I_E, q = r % I_E, typ = job / 128, le = job % 128;
        if (typ < 2) { const int kb = q / 16, nb = q % 16, n0 = nb * 32;
            const float* W = C.a->in[typ == 0 ? I_WG : I_WU] + (size_t)le * 1024 * 512;
            const size_t drow0 = (size_t)(n0 >> 7) * 256 + (n0 & 127) + (typ ? 128 : 0);
            transpose_item8w(W, 512, 1024, ((unsigned char*)(C.a->ws + WS_WGU)) + (size_t)le * 1024 * 1024, drow0, scr, kb * 128, n0, C.lane);
        } else { const int kb = q / 32, nb = q % 32;
            const float* W = C.a->in[I_WDN] + (size_t)le * 512 * 1024;
            transpose_item8w(W, 1024, 512, ((unsigned char*)(C.a->ws + WS_WD)) + (size_t)le * 1024 * 512, (size_t)nb * 32, scr, kb * 128, nb * 32, C.lane); }
    }
}

template <bool COMBINE, int EXTRA, bool FINAL, bool XIN_F32>
__device__ __forceinline__ void norm_phase(const Ctx& C, int l, const float* xin, const float* normw, int shift_chunk, const bf16* WX) {
    constexpr int NX = EXTRA == 1 ? 16 : (EXTRA == 2 ? 36 : 0);
    constexpr int NR = 4;
    constexpr int NCB = (NX + 15) / 16;
    constexpr int WPITCH = 2064;
    LAS unsigned char* wl = C.lds;
    LAS unsigned char* atile = C.lds + 99072 + C.wave * 4160;
    LAS float* lgbase = (LAS float*)(C.lds + 99072 + 8 * 4160);
    LAS int* ent_p = (LAS int*)(C.lds + 99072 + 8 * 4160 + 8 * 768);
    LAS int* ent_e = ent_p + 256;
    LAS float* ent_w = (LAS float*)(ent_e + 256);
    LAS int* lcnt = (LAS int*)(ent_w + 256);
    LAS int* lbase = lcnt + 32;
    LAS int* erank = lbase + 32;
    if (EXTRA) { for (int i = C.tid; i < NCB * 16 * 128; i += 512) { const int row = i >> 7, c16 = i & 127;
            *(LAS u32x4*)(wl + row * WPITCH + c16 * 16) = row < NX ? ((const u32x4*)WX)[i] : (u32x4){0u, 0u, 0u, 0u}; }
        if (EXTRA == 2) { if (C.tid < 32) lcnt[C.tid] = 0; }
        __syncthreads(); }
    const int gw = C.vcu * 8 + C.wave, NGW = C.G * 8, lane = C.lane;
    float* X = C.a->out; bf16* XBp = (bf16*)(C.a->ws + WS_XB); bf16* Hb = (bf16*)(C.a->ws + WS_H); const bf16* Yb = (const bf16*)(C.a->ws + WS_QKV); const float* MOD = (const float*)(C.a->ws + WS_MOD);
    int pass = 0;
    for (int rg = gw; rg < NTOK / NR; rg += NGW, ++pass) {
        const int t0 = rg * NR, b = t0 >> 12;
        f32x4 v[NR][4];
#pragma unroll
        for (int r = 0; r < NR; ++r)
#pragma unroll
            for (int j = 0; j < 4; ++j) {
                if (XIN_F32) v[r][j] = *(const f32x4*)(xin + (size_t)(t0 + r) * DM + 4 * lane + 256 * j);
                else { const u32x2 xr = *(const u32x2*)(XBp + (size_t)(t0 + r) * DM + 4 * lane + 256 * j); v[r][j] = (f32x4){bflo(xr.x), bfhi(xr.x), bflo(xr.y), bfhi(xr.y)}; } }
        if (COMBINE) {
            const float* g2p = MOD + ((size_t)((FINAL ? 3 : l - 1) * 8 + b)) * 6144 + 5 * 1024;
            int y0[NR][4], y1[NR][4]; f32x4 g2[4];
#pragma unroll
            for (int j = 0; j < 4; ++j) { g2[j] = *(const f32x4*)(g2p + 4 * lane + 256 * j);
#pragma unroll
                for (int r = 0; r < NR; ++r) { y0[r][j] = *(const int*)((const unsigned char*)Yb + (size_t)(2 * (t0 + r)) * DM + 4 * lane + 256 * j);
                    y1[r][j] = *(const int*)((const unsigned char*)Yb + (size_t)(2 * (t0 + r) + 1) * DM + 4 * lane + 256 * j); } }
#pragma unroll
            for (int j = 0; j < 4; ++j)
#pragma unroll
                for (int r = 0; r < NR; ++r) {
                    const f32x2 a0 = __builtin_amdgcn_cvt_pk_f32_fp8(y0[r][j], false), a1 = __builtin_amdgcn_cvt_pk_f32_fp8(y0[r][j], true), b0 = __builtin_amdgcn_cvt_pk_f32_fp8(y1[r][j], false), b1 = __builtin_amdgcn_cvt_pk_f32_fp8(y1[r][j], true);
                    f32x4 ys; ys[0] = (a0[0] + b0[0]) * (1.f / 32.f); ys[1] = (a0[1] + b0[1]) * (1.f / 32.f); ys[2] = (a1[0] + b1[0]) * (1.f / 32.f); ys[3] = (a1[1] + b1[1]) * (1.f / 32.f);
                    v[r][j] = v[r][j] + g2[j] * ys; }
            if (!FINAL) {
#pragma unroll
                for (int j = 0; j < 4; ++j)
#pragma unroll
                    for (int r = 0; r < NR; ++r) { u32x2 xo; xo.x = cvt_pk_bf16(v[r][j][0], v[r][j][1]); xo.y = cvt_pk_bf16(v[r][j][2], v[r][j][3]); *(u32x2*)(XBp + (size_t)(t0 + r) * DM + 4 * lane + 256 * j) = xo; } }
        }
        float ss[NR];
#pragma unroll
        for (int r = 0; r < NR; ++r) { float s_ = 0.f;
#pragma unroll
            for (int j = 0; j < 4; ++j) s_ += (v[r][j][0] * v[r][j][0] + v[r][j][1] * v[r][j][1]) + (v[r][j][2] * v[r][j][2] + v[r][j][3] * v[r][j][3]);
            ss[r] = s_; }
        const float red = reduce4(ss, lane);
        const float rstd_l = 1.0f / sqrtf(red * (1.f / DM) + EPS);
        float rs[NR];
#pragma unroll
        for (int r = 0; r < NR; ++r) rs[r] = __builtin_bit_cast(float, __builtin_amdgcn_readlane(__builtin_bit_cast(int, rstd_l), 16 * r));
        if (FINAL) {
#pragma unroll
            for (int j = 0; j < 4; ++j) { const f32x4 gn = *(const f32x4*)(normw + 4 * lane + 256 * j);
#pragma unroll
                for (int r = 0; r < NR; ++r) v[r][j] = v[r][j] * rs[r] * gn; }
#pragma unroll
            for (int j = 0; j < 4; ++j)
#pragma unroll
                for (int r = 0; r < NR; ++r) *(f32x4*)(X + (size_t)(t0 + r) * DM + 4 * lane + 256 * j) = v[r][j];
            continue;
        }
        u32x2 hp[NR][4];
        const float* mp = MOD + ((size_t)(l * 8 + b)) * 6144 + (size_t)shift_chunk * 1024;
#pragma unroll
        for (int j = 0; j < 4; ++j) { const f32x4 sh = *(const f32x4*)(mp + 4 * lane + 256 * j), scl = *(const f32x4*)(mp + 1024 + 4 * lane + 256 * j);
            const f32x4 gn = *(const f32x4*)(normw + (size_t)l * DM + 4 * lane + 256 * j); const f32x4 cmb = gn * (scl + 1.0f);
#pragma unroll
            for (int r = 0; r < NR; ++r) v[r][j] = v[r][j] * rs[r] * cmb + sh; }
#pragma unroll
        for (int j = 0; j < 4; ++j) {
#pragma unroll
            for (int r = 0; r < NR; ++r) {
                u32x2 o; o.x = cvt_pk_bf16(v[r][j][0], v[r][j][1]); o.y = cvt_pk_bf16(v[r][j][2], v[r][j][3]); hp[r][j] = o;
                if (EXTRA == 2) *(unsigned*)(C.a->ws + WS_H8 + (size_t)(t0 + r) * DM + 4 * lane + 256 * j) = pk4_fp8(v[r][j][0] * F8_ACT_SCALE, v[r][j][1] * F8_ACT_SCALE, v[r][j][2] * F8_ACT_SCALE, v[r][j][3] * F8_ACT_SCALE);
                else *(u32x2*)(Hb + (size_t)(t0 + r) * DM + 4 * lane + 256 * j) = o; } }
        if (EXTRA) {
            LAS float* lgb = lgbase + C.wave * (NR * 48);
            const int l15 = lane & 15, quad = lane >> 4;
            f32x4 lacc[NCB > 0 ? NCB : 1];
#pragma unroll
            for (int cb = 0; cb < NCB; ++cb) lacc[cb] = (f32x4){0.f, 0.f, 0.f, 0.f};
#pragma unroll
            for (int half = 0; half < 2; ++half) {
#pragma unroll
                for (int r = 0; r < NR; ++r)
#pragma unroll
                    for (int jl = 0; jl < 2; ++jl) *(LAS u32x2*)(atile + r * 1040 + (4 * lane + 256 * jl) * 2) = hp[r][2 * half + jl];
                LDS_WAIT();
#pragma unroll 4
                for (int ks = 0; ks < 16; ++ks) { const bf16x8 af = *(const LAS bf16x8*)(atile + (l15 & 3) * 1040 + (8 * quad + 32 * ks) * 2);
#pragma unroll
                    for (int cb = 0; cb < NCB; ++cb) { const bf16x8 bfv = *(const LAS bf16x8*)(wl + (16 * cb + l15) * WPITCH + (512 * half + 8 * quad + 32 * ks) * 2);
                        lacc[cb] = __builtin_amdgcn_mfma_f32_16x16x32_bf16(af, bfv, lacc[cb], 0, 0, 0); } }
                LDS_WAIT();
            }
            if (quad == 0) {
#pragma unroll
                for (int cb = 0; cb < NCB; ++cb)
#pragma unroll
                    for (int jj = 0; jj < 4; ++jj) lgb[jj * 48 + 16 * cb + l15] = lacc[cb][jj]; }
            LDS_WAIT();
            float lg[NX > 0 ? NX : 1];
#pragma unroll
            for (int jj = 0; jj < NX; ++jj) lg[jj] = lgb[(lane >> 4) * 48 + jj];
            const int row = lane >> 4, tok = t0 + row;
            if (EXTRA == 1) {
                if ((lane & 15) == 0) { float* BGp = (float*)(C.a->ws + WS_BG);
#pragma unroll
                    for (int q = 0; q < 4; ++q) *(f32x4*)(BGp + (size_t)tok * 16 + 4 * q) = (f32x4){lg[4 * q], lg[4 * q + 1], lg[4 * q + 2], lg[4 * q + 3]}; }
            } else {
                float gl[4];
#pragma unroll
                for (int q = 0; q < 4; ++q) gl[q] = lg[q] + C.a->in[I_RGB][l * 4 + q];
                int gs = 0; float gm = gl[0];
#pragma unroll
                for (int q = 1; q < 4; ++q) if (gl[q] > gm) { gm = gl[q]; gs = q; }
                float gsum = 0.f;
#pragma unroll
                for (int q = 0; q < 4; ++q) gsum += __expf(gl[q] - gm);
                const float gval = 1.0f / gsum;
                float el[8];
#pragma unroll
                for (int q = 0; q < 8; ++q) { const float e0 = lg[4 + q], e1 = lg[12 + q], e2 = lg[20 + q], e3 = lg[28 + q];
                    el[q] = (gs == 0 ? e0 : (gs == 1 ? e1 : (gs == 2 ? e2 : e3))) + C.a->in[I_REB][l * 32 + gs * 8 + q]; }
                int i0 = 0; float m0 = el[0];
#pragma unroll
                for (int q = 1; q < 8; ++q) if (el[q] > m0) { m0 = el[q]; i0 = q; }
                int i1 = -1; float m1 = -3.0e38f;
#pragma unroll
                for (int q = 0; q < 8; ++q) if (q != i0 && el[q] > m1) { m1 = el[q]; i1 = q; }
                const float w0 = gval / (1.0f + __expf(m1 - m0)), w1 = gval - w0;
                if ((lane & 15) == 0) { const int ei = (pass * 8 + C.wave) * 8 + row * 2;
                    ent_p[ei] = tok * 2; ent_e[ei] = gs * 8 + i0; ent_w[ei] = w0;
                    ent_p[ei + 1] = tok * 2 + 1; ent_e[ei + 1] = gs * 8 + i1; ent_w[ei + 1] = w1; }
            }
        }
    }
    if (EXTRA == 2) {
        __syncthreads();
        const int npass_blk = (NTOK / NR - C.vcu * 8 + NGW - 1) / NGW;
        const int nent = npass_blk * 64;
        int* gcnt = (int*)(C.a->ws + WS_CTL) + CW_CNT + 64 * l;
        int* PL = (int*)(C.a->ws + WS_PLIST); float* WL = (float*)(C.a->ws + WS_WLIST);
        for (int i = C.tid; i < nent; i += 512) { const int p_ = i >> 6, w_ = (i >> 3) & 7; const bool valid = (C.vcu * 8 + w_ + p_ * NGW) < NTOK / NR;
            if (valid) erank[i] = atomicAdd((int*)&lcnt[ent_e[i]], 1); else erank[i] = -1; }
        __syncthreads();
        if (C.tid < 32) lbase[C.tid] = __hip_atomic_fetch_add(gcnt + C.tid, lcnt[C.tid], __ATOMIC_RELAXED, __HIP_MEMORY_SCOPE_AGENT);
        __syncthreads();
        for (int i = C.tid; i < nent; i += 512) { const int rk = erank[i]; if (rk >= 0) { const int e = ent_e[i]; const int pos = lbase[e] + rk;
            PL[(size_t)e * NTOK + pos] = ent_p[i]; WL[(size_t)e * NTOK + pos] = ent_w[i]; } }
    }
    __syncthreads();
}

typedef short v4i16_t __attribute__((ext_vector_type(4)));
__device__ __forceinline__ s16x4 vtr(const LAS unsigned char* p) { return __builtin_bit_cast(s16x4, __builtin_amdgcn_ds_read_tr16_b64_v4i16((LAS v4i16_t*)p)); }
__device__ __forceinline__ float pl32_other(float m, int hi) { float a = m, b = m; swap32(a, b); return hi ? a : b; }
__device__ __forceinline__ float pl32_max(float m) { float a = m, b = m; swap32(a, b); return fmaxf(a, b); }
__device__ __forceinline__ float pl32_sum(float m) { float a = m, b = m; swap32(a, b); return a + b; }
__device__ __forceinline__ int t5_bucket(int rel) { const int n = rel < 0 ? -rel : rel;
    const int bk = n < 8 ? n : (n < 12 ? 8 : (n < 16 ? 9 : (n < 23 ? 10 : (n < 32 ? 11 : (n < 46 ? 12 : (n < 64 ? 13 : (n < 91 ? 14 : 15)))))));
    return bk + (rel > 0 ? 16 : 0); }

__device__ __forceinline__ int kswz(int row, int c) { return row * 128 + ((c ^ ((row >> 1) & 7)) << 4); }

__device__ __forceinline__ void diffattn_unit(const Ctx& C, int l, int b, int h, int qb, float lam, float lam_init) {
    LAS unsigned char* lds = C.lds;
    const int tid = C.tid, lane = C.lane, wave = C.wave, r32 = lane & 31, hi = lane >> 5, qt = wave & 3, m = wave >> 2;
    const int i16 = lane & 15, q4 = i16 >> 2, p4 = i16 & 3, half16 = (lane >> 4) & 1;
    const size_t tokbase = (size_t)b * SEQ; const int q0 = qb * 128, c0 = q0 >> 6, ntile = c0 + 2, cw = c0 + (qt >> 1);
    LAS float* lut = (LAS float*)(lds + 131072);
    const float rb15 = C.a->in[I_RELB][15 * 4 + h], rbt = C.a->in[I_RELB][t5_bucket((tid < 255 ? tid : 254) - 191) * 4 + h];
    const float b15 = rb15 * LOG2E;
    if (tid < 255) lut[tid] = rbt * LOG2E - b15;
    const bf16* qp = ((bf16*)(C.a->ws + WS_QKV)) + (tokbase + q0 + 32 * qt + r32) * QKVW + E_AQ + h * 128 + m * 64 + 8 * hi;
    bf16x8 qr[4];
#pragma unroll
    for (int d0 = 0; d0 < 4; ++d0) qr[d0] = *(const bf16x8*)(qp + 16 * d0);
    unsigned koff[2], voff[2];
#pragma unroll
    for (int i = 0; i < 2; ++i) { const int p = wave * 128 + i * 64 + lane;
        { const int mm = p >> 9, pp = p & 511, row = pp >> 3, pc = pp & 7, c = pc ^ ((row >> 1) & 7); koff[i] = (unsigned)((row * QKVW + E_AK + h * 128 + mm * 64 + c * 8) * 2); }
        { const int blk = p >> 8, row = (p >> 2) & 63, c4 = p & 3; voff[i] = (unsigned)((row * QKVW + E_AV + h * 128 + blk * 32 + c4 * 8) * 2); } }
    const unsigned ldsb = (unsigned)__builtin_amdgcn_readfirstlane((int)(unsigned)(uintptr_t)lds) + (unsigned)wave * 2048u;
    const char* tilebase = (const char*)(C.a->ws + WS_QKV) + tokbase * (size_t)(QKVW * 2);
#define DA_DMA(j, bi) do { const char* tb_ = tilebase + (size_t)(j) * (64 * QKVW * 2); const unsigned db_ = ldsb + (unsigned)(bi) * 32768u; \
        pg8::glds_s(tb_, koff[0], db_); pg8::glds_s(tb_, koff[1], db_ + 1024u); pg8::glds_s(tb_, voff[0], db_ + 16384u); pg8::glds_s(tb_, voff[1], db_ + 16384u + 1024u); } while (0)
    f32x16 o[4];
#pragma unroll
    for (int k = 0; k < 4; ++k)
#pragma unroll
        for (int i = 0; i < 16; ++i) o[k][i] = 0.f;
    float lsum = 0.f;
    f32x16 negm;
#pragma unroll
    for (int i = 0; i < 16; ++i) negm[i] = b15;
    __syncthreads();
    DA_DMA(0, 0); DA_DMA(1, 1);
    asm volatile("s_waitcnt vmcnt(4)" ::: "memory");
    __builtin_amdgcn_s_barrier(); asm volatile("" ::: "memory");
#define DA_LDV(vb_, s) do { _Pragma("unroll") for (int k = 0; k < 4; ++k) { va[s][k][0] = vtr((vb_) + k * 4096 + (s) * 1024); va[s][k][1] = vtr((vb_) + k * 4096 + (s) * 1024 + 512); } } while (0)
#define DA_PVS(s) do { const bf16x8 pf = __builtin_bit_cast(bf16x8, pwh[s]); _Pragma("unroll") for (int k = 0; k < 4; ++k) { const s16x4 lo = va[s][k][0], hh = va[s][k][1]; \
                const bf16x8 vf = (bf16x8){lo[0], lo[1], lo[2], lo[3], hh[0], hh[1], hh[2], hh[3]}; o[k] = __builtin_amdgcn_mfma_f32_32x32x16_bf16(vf, pf, o[k], 0, 0, 0); } } while (0)
#define DA_PV(vb_) do { s16x4 va[4][4][2]; DA_LDV(vb_, 0); DA_LDV(vb_, 1); __builtin_amdgcn_sched_barrier(0); \
        DA_PVS(0); DA_LDV(vb_, 2); __builtin_amdgcn_sched_barrier(0); DA_PVS(1); DA_LDV(vb_, 3); __builtin_amdgcn_sched_barrier(0); DA_PVS(2); DA_PVS(3); } while (0)
    u32x4 pwh[4]; int pbi = -1;
#pragma unroll
    for (int s = 0; s < 4; ++s) pwh[s] = (u32x4){0u, 0u, 0u, 0u};
    for (int j = 0; j < ntile; ++j) {
        const int bi = j & 3;
        if (j + 2 < ntile) { DA_DMA(j + 2, (j + 2) & 3); }
        if (pbi >= 0) {
            const LAS unsigned char* vp = lds + pbi * 32768 + 16384 + half16 * 32 + p4 * 8 + (4 * hi + q4) * 64;
            DA_PV(vp); pbi = -1; }
        if (j <= cw) {
            const LAS unsigned char* kb = lds + bi * 32768 + m * 8192;
            bf16x8 ka[4][2];
#pragma unroll
            for (int d0 = 0; d0 < 4; ++d0) { const int c = 2 * d0 + hi; ka[d0][0] = *(const LAS bf16x8*)(kb + kswz(r32, c)); ka[d0][1] = *(const LAS bf16x8*)(kb + kswz(32 + r32, c)); }
            __builtin_amdgcn_sched_barrier(0);
            f32x16 s0 = negm, s1 = negm;
#pragma unroll
            for (int d0 = 0; d0 < 4; ++d0) {
                s0 = __builtin_amdgcn_mfma_f32_32x32x16_bf16(ka[d0][0], qr[d0], s0, 0, 0, 0); s1 = __builtin_amdgcn_mfma_f32_32x32x16_bf16(ka[d0][1], qr[d0], s1, 0, 0, 0); }
            if (j + 2 >= cw) { const int base = 64 * j - (q0 + 32 * qt + r32) + 191;
#pragma unroll
                for (int i = 0; i < 16; ++i) { const int kv = crow(i, hi); s0[i] += lut[base + kv]; s1[i] += lut[base + kv + 32]; } }
            float tm = fmaxf(fmaxf(s0[0], s0[1]), s1[0]);
#pragma unroll
            for (int i = 1; i < 16; ++i) tm = fmaxf(fmaxf(tm, s0[i]), s1[i]);
            tm = fmaxf(tm, s0[1]);
            tm = pl32_max(tm);
            if (__any(tm > 8.f) || j == 0) { const float dl = (j == 0) ? tm : fmaxf(tm, 0.f); const float f = ex2(-dl);
                lsum *= f;
#pragma unroll
                for (int k = 0; k < 4; ++k)
#pragma unroll
                    for (int i = 0; i < 16; ++i) o[k][i] *= f;
#pragma unroll
                for (int i = 0; i < 16; ++i) { s0[i] -= dl; s1[i] -= dl; negm[i] -= dl; } }
            float ps = 0.f;
#pragma unroll
            for (int i = 0; i < 16; ++i) { s0[i] = ex2(s0[i]); s1[i] = ex2(s1[i]); ps += s0[i] + s1[i]; }
            lsum += ps;
#pragma unroll
            for (int s = 0; s < 2; ++s) {
                pwh[s].x = cvt_pk_bf16(s0[8 * s + 0], s0[8 * s + 1]); pwh[s].y = cvt_pk_bf16(s0[8 * s + 2], s0[8 * s + 3]); pwh[s].z = cvt_pk_bf16(s0[8 * s + 4], s0[8 * s + 5]); pwh[s].w = cvt_pk_bf16(s0[8 * s + 6], s0[8 * s + 7]);
                pwh[2 + s].x = cvt_pk_bf16(s1[8 * s + 0], s1[8 * s + 1]); pwh[2 + s].y = cvt_pk_bf16(s1[8 * s + 2], s1[8 * s + 3]); pwh[2 + s].z = cvt_pk_bf16(s1[8 * s + 4], s1[8 * s + 5]); pwh[2 + s].w = cvt_pk_bf16(s1[8 * s + 6], s1[8 * s + 7]); }
            if (m == 0) { const LAS unsigned char* vb = lds + bi * 32768 + 16384 + half16 * 32 + p4 * 8 + (4 * hi + q4) * 64; DA_PV(vb); }
            else pbi = bi;
        }
        if (j + 2 < ntile) asm volatile("s_waitcnt vmcnt(4) lgkmcnt(0)" ::: "memory"); else asm volatile("s_waitcnt vmcnt(0) lgkmcnt(0)" ::: "memory");
        __builtin_amdgcn_s_barrier(); asm volatile("" ::: "memory");
    }
    if (pbi >= 0) { const LAS unsigned char* vp = lds + pbi * 32768 + 16384 + half16 * 32 + p4 * 8 + (4 * hi + q4) * 64; DA_PV(vp); }
    __syncthreads();
#undef DA_LDV
#undef DA_PVS
#undef DA_PV
#undef DA_DMA
    const float linv = 1.0f / pl32_sum(lsum);
    LAS float* ox = (LAS float*)lds + qt * 4096;
    if (m == 1) {
#pragma unroll
        for (int k = 0; k < 4; ++k)
#pragma unroll
            for (int i = 0; i < 16; ++i) ox[(k * 16 + i) * 64 + lane] = o[k][i] * linv;
    }
    __syncthreads();
    if (m == 0) {
        float ssq = 0.f;
#pragma unroll
        for (int k = 0; k < 4; ++k)
#pragma unroll
            for (int i = 0; i < 16; ++i) { const float v = o[k][i] * linv - lam * ox[(k * 16 + i) * 64 + lane]; o[k][i] = v; ssq += v * v; }
        ssq = pl32_sum(ssq);
        const float rstd = (1.0f / sqrtf(ssq * (1.f / 128.f) + EPS)) * (1.0f - lam_init) * F8_ACT_SCALE;
        unsigned char* op = (unsigned char*)(C.a->ws + WS_O) + (tokbase + q0 + 32 * qt + r32) * DM + h * 128;
        const float* sg = C.a->in[I_ESUBLN] + (l >> 1) * 128; unsigned pko[4][4];
#pragma unroll
        for (int k = 0; k < 4; ++k)
#pragma unroll
            for (int g = 0; g < 4; ++g) { const int dv = 32 * k + 8 * g + 4 * hi; const f32x4 gg = *(const f32x4*)(sg + dv);
                pko[k][g] = pk4_fp8(o[k][4 * g] * rstd * gg[0], o[k][4 * g + 1] * rstd * gg[1], o[k][4 * g + 2] * rstd * gg[2], o[k][4 * g + 3] * rstd * gg[3]); }
        (void)op;
        LAS unsigned char* stg = (LAS unsigned char*)ox;
#pragma unroll
        for (int k = 0; k < 4; ++k)
#pragma unroll
            for (int g = 0; g < 4; ++g) { const int dv = 32 * k + 8 * g + 4 * hi; *(LAS unsigned*)(stg + r32 * 128 + dv) = pko[k][g]; }
        LDS_WAIT();
        { const int orow = lane >> 3, opc = lane & 7;
          unsigned char* ob = (unsigned char*)(C.a->ws + WS_O) + (tokbase + q0 + 32 * qt + orow) * DM + h * 128 + opc * 16;
#pragma unroll
          for (int t = 0; t < 4; ++t) { const u32x4 w = *(const LAS u32x4*)(stg + (8 * t + orow) * 128 + opc * 16); *(u32x4*)(ob + (size_t)(8 * t) * DM) = w; } }
    }
    __syncthreads();
}

__device__ __forceinline__ void gla_local_unit(const Ctx& C, int l, int b, int h, int oct) {
    LAS unsigned char* lds = C.lds;
    constexpr int PT = 144;
    constexpr int SET = 46080;
    LAS unsigned char* PP = lds + 2 * SET;
    LAS unsigned char* OUT = PP + 9216;
    LAS float* GT = (LAS float*)(OUT + 18432);
    LAS float* AD = GT + 512;
    LAS float* BGL = AD + 128 + 512;
    const int tid = C.tid, lane = C.lane, wave = C.wave, l15 = lane & 15, quad = lane >> 4;
    const int i = l >> 1; const size_t tokbase = (size_t)b * SEQ; const int cfirst = oct * 8;
    const int d = tid & 63; const int tg = wave;
    const bf16* QKV = (const bf16*)(C.a->ws + WS_QKV); const float* BGg = (const float*)(C.a->ws + WS_BG);
    const size_t item0 = ((size_t)(b * 4 + h)) * 64;
    float w2[16];
#pragma unroll
    for (int r = 0; r < 16; ++r) w2[r] = C.a->in[I_EGK2][((size_t)i * 16 + r) * 256 + h * 64 + d];
    const float bgk = C.a->in[I_EBGK][i * 256 + h * 64 + d];
    const int e0 = 16 * wave;
    const int ot = tid >> 3, oj = tid & 7;
    unsigned short qraw[8], kraw[8]; u32x4 vraw[2]; f32x4 bgreg = (f32x4){0.f, 0.f, 0.f, 0.f};
    float cs[8];
#define GLA_LOAD_QKV(c_) do { const size_t tk0_ = tokbase + 64 * (size_t)(c_); \
        _Pragma("unroll") for (int t = 0; t < 8; ++t) { const size_t tk = tk0_ + 8 * tg + t; qraw[t] = QKV[tk * QKVW + E_BQ + h * 64 + d]; kraw[t] = QKV[tk * QKVW + E_BK + h * 64 + d]; } \
        _Pragma("unroll") for (int ii = 0; ii < 2; ++ii) { const int id = tid + 512 * ii, s_ = id >> 4, c8 = id & 15; vraw[ii] = *(const u32x4*)(QKV + (tk0_ + s_) * QKVW + E_BV + h * 128 + 8 * c8); } } while (0)
#define GLA_LOAD_BG(c_) do { if (tid < 256) bgreg = *(const f32x4*)(BGg + (tokbase + 64 * (size_t)(c_) + (tid >> 2)) * 16 + (tid & 3) * 4); } while (0)
#define GLA_STORE_BG(slot) do { if (tid < 256) *(LAS f32x4*)(BGL + (slot) * 1024 + (tid >> 2) * 16 + (tid & 3) * 4) = bgreg; } while (0)
#define GLA_PREP1(slot) do { float run = 0.f; \
        _Pragma("unroll") for (int t = 0; t < 8; ++t) { const LAS float* bgp = BGL + (slot) * 1024 + (8 * tg + t) * 16; float z = bgk; \
            _Pragma("unroll") for (int q_ = 0; q_ < 4; ++q_) { const f32x4 bv = *(const LAS f32x4*)(bgp + 4 * q_); z += bv[0] * w2[4 * q_] + bv[1] * w2[4 * q_ + 1] + bv[2] * w2[4 * q_ + 2] + bv[3] * w2[4 * q_ + 3]; } \
            const float ls = fminf(z, 0.f) - __logf(1.f + __expf(-fabsf(z))); run += ls * (1.f / 16.f); cs[t] = run; } \
        GT[tg * 64 + d] = run; } while (0)
#define GLA_PREP2(setp, adslot) do { LAS unsigned char* QD_ = (setp); LAS unsigned char* KI_ = (setp) + 9216; LAS unsigned char* KDT_ = (setp) + 18432; LAS unsigned char* VT_ = (setp) + 27648; \
        float pre = 0.f, tot = 0.f; \
        _Pragma("unroll") for (int g = 0; g < 8; ++g) { const float x = GT[g * 64 + d]; tot += x; if (g < tg) pre += x; } \
        float kd[8]; const float etot = __expf(tot); \
        _Pragma("unroll") for (int t = 0; t < 8; ++t) { const float bb = pre + cs[t]; const float qv = bf2f(qraw[t]), kv = bf2f(kraw[t]); \
            const float eb = __expf(bb), ib = __builtin_amdgcn_rcpf(eb); \
            *(LAS unsigned short*)(QD_ + (8 * tg + t) * PT + d * 2) = (unsigned short)cvt1_bf16(qv * eb); \
            *(LAS unsigned short*)(KI_ + (8 * tg + t) * PT + d * 2) = (unsigned short)cvt1_bf16(kv * ib); \
            kd[t] = kv * (etot * ib); } \
        u32x4 kdw; kdw.x = cvt_pk_bf16(kd[0], kd[1]); kdw.y = cvt_pk_bf16(kd[2], kd[3]); kdw.z = cvt_pk_bf16(kd[4], kd[5]); kdw.w = cvt_pk_bf16(kd[6], kd[7]); \
        *(LAS u32x4*)(KDT_ + d * PT + 16 * tg) = kdw; \
        if (tg == 0) AD[(adslot) * 64 + d] = etot; \
        _Pragma("unroll") for (int ii = 0; ii < 2; ++ii) { const int id = tid + 512 * ii, s_ = id >> 4, c8 = id & 15; \
            _Pragma("unroll") for (int jj = 0; jj < 8; ++jj) *(LAS unsigned short*)(VT_ + (8 * c8 + jj) * PT + s_ * 2) = (unsigned short)((vraw[ii][jj >> 1] >> ((jj & 1) * 16)) & 0xffffu); } } while (0)
    f32x4 agg[4];
#pragma unroll
    for (int db = 0; db < 4; ++db) agg[db] = (f32x4){0.f, 0.f, 0.f, 0.f};
    float aprod = 1.f;
    const int clast = cfirst + 7;
    GLA_LOAD_BG(cfirst); GLA_STORE_BG(0); GLA_LOAD_BG(cfirst + 1); GLA_STORE_BG(1);
    GLA_LOAD_QKV(cfirst);
    __syncthreads();
    GLA_PREP1(0);
    __syncthreads();
    GLA_PREP2(lds, 0);
    GLA_LOAD_QKV(cfirst + 1); GLA_LOAD_BG(cfirst + 2);
    __syncthreads();
    for (int cc = 0; cc < 8; ++cc) {
        const int c = cfirst + cc; const size_t item = item0 + c;
        const int cb = cc & 1, nb = cb ^ 1;
        LAS unsigned char* QD = lds + cb * SET; LAS unsigned char* KI = QD + 9216; LAS unsigned char* KDT = QD + 18432; LAS unsigned char* VT = QD + 27648;
        GLA_STORE_BG(cb);
        if (cc + 1 < 8) GLA_PREP1(nb);
        { const int tb = wave >> 1;
#pragma unroll
          for (int sq = 0; sq < 2; ++sq) { const int sb = 2 * (wave & 1) + sq; f32x4 sc = (f32x4){0.f, 0.f, 0.f, 0.f};
              if (sb <= tb) {
#pragma unroll
                  for (int ks = 0; ks < 2; ++ks) { const bf16x8 a = *(const LAS bf16x8*)(QD + (16 * tb + l15) * PT + (8 * quad + 32 * ks) * 2), bb = *(const LAS bf16x8*)(KI + (16 * sb + l15) * PT + (8 * quad + 32 * ks) * 2);
                      sc = __builtin_amdgcn_mfma_f32_16x16x32_bf16(a, bb, sc, 0, 0, 0); } }
#pragma unroll
              for (int jj = 0; jj < 4; ++jj) { const int t = 16 * tb + 4 * quad + jj, s_ = 16 * sb + l15; const float v = (s_ <= t) ? sc[jj] : 0.f;
                  *(LAS unsigned short*)(PP + t * PT + s_ * 2) = (unsigned short)cvt1_bf16(v); } } }
        { const u32x4 qv = *(const LAS u32x4*)(QD + ot * PT + oj * 16); *(u32x4*)((bf16*)(C.a->ws + WS_GQD) + item * 4096 + ot * 64 + oj * 8) = qv;
          if (tid < 64) { const float ad_ = AD[cb * 64 + tid]; ((float*)(C.a->ws + WS_GAD))[item * 64 + tid] = ad_; aprod *= ad_; } }
        LBAR();
        if (cc + 1 < 8) GLA_PREP2(lds + nb * SET, nb);
        bf16x8 vfrag[2], pq_[4][2], kq_[4][2];
#pragma unroll
        for (int ks = 0; ks < 2; ++ks) { vfrag[ks] = *(const LAS bf16x8*)(VT + (e0 + l15) * PT + (8 * quad + 32 * ks) * 2);
#pragma unroll
            for (int tb = 0; tb < 4; ++tb) { pq_[tb][ks] = *(const LAS bf16x8*)(PP + (16 * tb + l15) * PT + (8 * quad + 32 * ks) * 2); kq_[tb][ks] = *(const LAS bf16x8*)(KDT + (16 * tb + l15) * PT + (8 * quad + 32 * ks) * 2); } }
        __builtin_amdgcn_sched_barrier(0);
#pragma unroll
        for (int tb = 0; tb < 4; ++tb) { f32x4 oa = (f32x4){0.f, 0.f, 0.f, 0.f};
#pragma unroll
            for (int ks = 0; ks < 2; ++ks) oa = __builtin_amdgcn_mfma_f32_16x16x32_bf16(pq_[tb][ks], vfrag[ks], oa, 0, 0, 0);
#pragma unroll
            for (int jj = 0; jj < 4; ++jj) *(LAS unsigned short*)(OUT + (16 * tb + 4 * quad + jj) * 272 + (e0 + l15) * 2) = (unsigned short)cvt1_bf16(oa[jj]); }
        { float* kvp = (float*)(C.a->ws + WS_GKV) + item * 8192;
#pragma unroll
          for (int db = 0; db < 4; ++db) { f32x4 sa = (f32x4){0.f, 0.f, 0.f, 0.f};
#pragma unroll
            for (int ks = 0; ks < 2; ++ks) sa = __builtin_amdgcn_mfma_f32_16x16x32_bf16(vfrag[ks], kq_[db][ks], sa, 0, 0, 0);
#pragma unroll
            for (int jj = 0; jj < 4; ++jj) kvp[(e0 + 4 * quad + jj) * 64 + 16 * db + l15] = sa[jj];
            agg[db] = agg[db] * AD[cb * 64 + 16 * db + l15] + sa; } }
        { const int c2 = c + 2 <= clast ? c + 2 : clast, c3 = c + 3 <= clast ? c + 3 : clast; GLA_LOAD_QKV(c2); GLA_LOAD_BG(c3); }
        LBAR();
        { const u32x4 o0 = *(const LAS u32x4*)(OUT + ot * 272 + oj * 32), o1 = *(const LAS u32x4*)(OUT + ot * 272 + oj * 32 + 16);
          bf16* gp = (bf16*)(C.a->ws + WS_GIN) + item * 8192 + ot * 128 + oj * 16; *(u32x4*)gp = o0; *(u32x4*)(gp + 8) = o1; }
    }
    { float* ga = (float*)(C.a->ws + WS_GKA) + ((size_t)(b * 4 + h) * 8 + oct) * 8256;
#pragma unroll
      for (int db = 0; db < 4; ++db)
#pragma unroll
          for (int jj = 0; jj < 4; ++jj) ga[(e0 + 4 * quad + jj) * 64 + 16 * db + l15] = agg[db][jj];
      if (tid < 64) ga[8192 + tid] = aprod; }
    __syncthreads();
#undef GLA_LOAD_QKV
#undef GLA_LOAD_BG
#undef GLA_STORE_BG
#undef GLA_PREP1
#undef GLA_PREP2
}

__device__ __forceinline__ void gla_scan_unit(const Ctx& C, int l, int b, int h, int oct) {
    LAS unsigned char* lds = C.lds;
    constexpr int PT = 144;
    LAS unsigned char* QD = lds;
    LAS unsigned char* ST = lds + 2 * 9216;
    LAS unsigned char* OUT = ST + 18432;
    const int tid = C.tid, lane = C.lane, wave = C.wave, l15 = lane & 15, quad = lane >> 4;
    const int i = l >> 1; const size_t tokbase = (size_t)b * SEQ; const int cfirst = oct * 8;
    const bf16* QKV = (const bf16*)(C.a->ws + WS_QKV); bf16* Og = (bf16*)(C.a->ws + WS_O);
    const float* GKV = (const float*)(C.a->ws + WS_GKV); const float* GAD = (const float*)(C.a->ws + WS_GAD); const bf16* GQD = (const bf16*)(C.a->ws + WS_GQD); const bf16* GIN = (const bf16*)(C.a->ws + WS_GIN);
    const size_t item0 = ((size_t)(b * 4 + h)) * 64;
    const int e0 = 16 * wave;
    const int ot = tid >> 3, oj = tid & 7;
    const int se = tid >> 2, sd = (tid & 3) * 16;
    float gg[16];
#pragma unroll
    for (int k = 0; k < 16; ++k) gg[k] = C.a->in[I_EGLAN][i * 128 + 16 * oj + k];
    f32x4 S[4];
#pragma unroll
    for (int k = 0; k < 4; ++k) S[k] = (f32x4){0.f, 0.f, 0.f, 0.f};
    for (int oo = 0; oo < oct; ++oo) { const float* ga = (const float*)(C.a->ws + WS_GKA) + ((size_t)(b * 4 + h) * 8 + oo) * 8256;
#pragma unroll
        for (int k = 0; k < 4; ++k) { const f32x4 kv = *(const f32x4*)(ga + se * 64 + sd + 4 * k), av = *(const f32x4*)(ga + 8192 + sd + 4 * k); S[k] = S[k] * av + kv; } }
    for (int cc = 0; cc < 8; ++cc) {
        const int c = cfirst + cc; const size_t item = item0 + c; const size_t tok0 = tokbase + 64 * c; const int cb = cc & 1;
        const u32x4 qv = *(const u32x4*)(GQD + item * 4096 + ot * 64 + oj * 8);
        f32x4 kv[4], av[4];
#pragma unroll
        for (int k = 0; k < 4; ++k) { kv[k] = *(const f32x4*)(GKV + item * 8192 + se * 64 + sd + 4 * k); av[k] = *(const f32x4*)(GAD + item * 64 + sd + 4 * k); }
        const u32x4 in0 = *(const u32x4*)(GIN + item * 8192 + ot * 128 + oj * 16), in1 = *(const u32x4*)(GIN + item * 8192 + ot * 128 + oj * 16 + 8);
        const u32x4 rg0 = *(const u32x4*)(QKV + (tok0 + ot) * QKVW + E_BR + h * 128 + 16 * oj), rg1 = *(const u32x4*)(QKV + (tok0 + ot) * QKVW + E_BR + h * 128 + 16 * oj + 8);
        { u32x4 w0, w1; w0.x = cvt_pk_bf16(S[0][0], S[0][1]); w0.y = cvt_pk_bf16(S[0][2], S[0][3]); w0.z = cvt_pk_bf16(S[1][0], S[1][1]); w0.w = cvt_pk_bf16(S[1][2], S[1][3]);
          w1.x = cvt_pk_bf16(S[2][0], S[2][1]); w1.y = cvt_pk_bf16(S[2][2], S[2][3]); w1.z = cvt_pk_bf16(S[3][0], S[3][1]); w1.w = cvt_pk_bf16(S[3][2], S[3][3]);
          *(LAS u32x4*)(ST + se * PT + sd * 2) = w0; *(LAS u32x4*)(ST + se * PT + sd * 2 + 16) = w1; }
        *(LAS u32x4*)(QD + cb * 9216 + ot * PT + oj * 16) = qv;
        LBAR();
        { bf16x8 sq_[2], aq_[4][2];
#pragma unroll
          for (int ks = 0; ks < 2; ++ks) { sq_[ks] = *(const LAS bf16x8*)(ST + (e0 + l15) * PT + (8 * quad + 32 * ks) * 2);
#pragma unroll
              for (int tb = 0; tb < 4; ++tb) aq_[tb][ks] = *(const LAS bf16x8*)(QD + cb * 9216 + (16 * tb + l15) * PT + (8 * quad + 32 * ks) * 2); }
          __builtin_amdgcn_sched_barrier(0);
#pragma unroll
          for (int tb = 0; tb < 4; ++tb) { f32x4 oa = (f32x4){0.f, 0.f, 0.f, 0.f};
#pragma unroll
            for (int ks = 0; ks < 2; ++ks) oa = __builtin_amdgcn_mfma_f32_16x16x32_bf16(aq_[tb][ks], sq_[ks], oa, 0, 0, 0);
#pragma unroll
            for (int jj = 0; jj < 4; ++jj) *(LAS unsigned short*)(OUT + (16 * tb + 4 * quad + jj) * 272 + (e0 + l15) * 2) = (unsigned short)cvt1_bf16(oa[jj]); } }
#pragma unroll
        for (int k = 0; k < 4; ++k) S[k] = S[k] * av[k] + kv[k];
        LBAR();
        { const u32x4 o0 = *(const LAS u32x4*)(OUT + ot * 272 + oj * 32), o1 = *(const LAS u32x4*)(OUT + ot * 272 + oj * 32 + 16);
          float ov[16];
#pragma unroll
          for (int k = 0; k < 4; ++k) { ov[2 * k] = bflo(o0[k]) + bflo(in0[k]); ov[2 * k + 1] = bfhi(o0[k]) + bfhi(in0[k]); ov[8 + 2 * k] = bflo(o1[k]) + bflo(in1[k]); ov[8 + 2 * k + 1] = bfhi(o1[k]) + bfhi(in1[k]); }
          float q = 0.f;
#pragma unroll
          for (int k = 0; k < 16; ++k) q += ov[k] * ov[k];
          q = sum8_dpp(q);
          const float rstd = 1.0f / sqrtf(q * (1.f / 128.f) + EPS);
          u32x4 w0, w1;
#pragma unroll
          for (int k = 0; k < 4; ++k) {
              { const float ra = bflo(rg0[k]), rb = bfhi(rg0[k]); const float sa = ra * __builtin_amdgcn_rcpf(1.f + __expf(-ra)), sb2 = rb * __builtin_amdgcn_rcpf(1.f + __expf(-rb));
                w0[k] = cvt_pk_bf16(ov[2 * k] * rstd * gg[2 * k] * sa, ov[2 * k + 1] * rstd * gg[2 * k + 1] * sb2); ov[2 * k] *= rstd * gg[2 * k] * sa * F8_ACT_SCALE; ov[2 * k + 1] *= rstd * gg[2 * k + 1] * sb2 * F8_ACT_SCALE; }
              { const float ra = bflo(rg1[k]), rb = bfhi(rg1[k]); const float sa = ra * __builtin_amdgcn_rcpf(1.f + __expf(-ra)), sb2 = rb * __builtin_amdgcn_rcpf(1.f + __expf(-rb));
                w1[k] = cvt_pk_bf16(ov[8 + 2 * k] * rstd * gg[8 + 2 * k] * sa, ov[8 + 2 * k + 1] * rstd * gg[8 + 2 * k + 1] * sb2); ov[8 + 2 * k] *= rstd * gg[8 + 2 * k] * sa * F8_ACT_SCALE; ov[8 + 2 * k + 1] *= rstd * gg[8 + 2 * k + 1] * sb2 * F8_ACT_SCALE; } }
          (void)w0; (void)w1;
          u32x4 w8; w8.x = pk4_fp8(ov[0], ov[1], ov[2], ov[3]); w8.y = pk4_fp8(ov[4], ov[5], ov[6], ov[7]); w8.z = pk4_fp8(ov[8], ov[9], ov[10], ov[11]); w8.w = pk4_fp8(ov[12], ov[13], ov[14], ov[15]);
          *(u32x4*)((unsigned char*)Og + (tok0 + ot) * DM + 512 + h * 128 + 16 * oj) = w8; }
    }
    __syncthreads();
}

__device__ __forceinline__ void stickbreak_wave_unit(const Ctx& C, int b, int h, int qt, int nb_, int nh_, int nqt_) {
    LAS unsigned char* kl = C.lds + 65536 + C.wave * 8192;
    LAS unsigned char* vl = C.lds + C.wave * 8192;
    const int lane = C.lane, r32 = lane & 31, hi = lane >> 5;
    const int i16 = lane & 15, q4 = i16 >> 2, p4 = i16 & 3, half16 = (lane >> 4) & 1;
    const size_t tokbase = (size_t)b * SEQ; const int q0 = qt * 32;
    const bf16* qp = ((bf16*)(C.a->ws + WS_QKV)) + (tokbase + q0 + r32) * QKVW + O_Q + h * 64 + 8 * hi;
    bf16x8 qr[4];
#pragma unroll
    for (int d0 = 0; d0 < 4; ++d0) qr[d0] = *(const bf16x8*)(qp + 16 * d0);
    f32x16 o[2];
#pragma unroll
    for (int k = 0; k < 2; ++k)
#pragma unroll
        for (int i = 0; i < 16; ++i) o[k][i] = 0.f;
    float R = 0.f;
    const int jd = q0 >> 6, qloc = (q0 & 63) + r32;
    u32x4 kr[8];
    const unsigned vdst = (unsigned)__builtin_amdgcn_readfirstlane((int)(unsigned)(uintptr_t)vl);
    const unsigned tdst = (unsigned)__builtin_amdgcn_readfirstlane((int)(unsigned)(uintptr_t)(C.lds + 131072 + C.wave * 1024));
    const char* qkvb = (const char*)(C.a->ws + WS_QKV);
    unsigned nt1 = 0u, nt2 = 0u, nt3 = 0u;
    if (nb_ >= 0) { const unsigned tb2 = (unsigned)nb_ * SEQ, q02 = (unsigned)nqt_ * 32u, k02 = tb2 + ((q02 >> 6) << 6), l31 = (unsigned)(lane & 31);
        const unsigned oq = ((tb2 + q02 + l31) * QKVW + O_Q + nh_ * 64) * 2u, ok0 = ((k02 + l31) * QKVW + O_K + nh_ * 64) * 2u, ok1 = ((k02 + 32u + l31) * QKVW + O_K + nh_ * 64) * 2u,
                       ov0 = ((k02 + l31) * QKVW + O_V + nh_ * 64) * 2u, ov1 = ((k02 + 32u + l31) * QKVW + O_V + nh_ * 64) * 2u;
        nt1 = hi ? ok0 : oq; nt2 = hi ? ov0 : ok1; nt3 = ov1; }
    const unsigned vtch = (unsigned)((((unsigned)tokbase + (unsigned)lane) * QKVW + O_V + h * 64) * 2);
#define SB_LOAD(jj) do { _Pragma("unroll") for (int i = 0; i < 8; ++i) { const int id = lane + 64 * i, row = id >> 3, c = id & 7; \
        kr[i] = *(const u32x4*)(((const bf16*)(C.a->ws + WS_QKV)) + (tokbase + 64 * (jj) + row) * QKVW + O_K + h * 64 + c * 8); } } while (0)
    SB_LOAD(jd);
    for (int j = jd; j >= 0; --j) {
        if (j < jd - 1) { SB_LOAD(j); }
#pragma unroll
        for (int i = 0; i < 8; ++i) { const int id = lane + 64 * i, row = id >> 3, c = id & 7; *(LAS u32x4*)(kl + kswz(row, c)) = kr[i]; }
        { const char* vbase = (const char*)(C.a->ws + WS_QKV) + (tokbase + 64 * (size_t)j) * (size_t)(QKVW * 2);
#pragma unroll
          for (int i = 0; i < 8; ++i) { const int p = i * 64 + lane; const unsigned vo = (unsigned)((((p >> 2) & 63) * QKVW + O_V + h * 64 + (p >> 8) * 32 + (p & 3) * 8) * 2);
              pg8::glds_s(vbase, vo, vdst + (unsigned)(i * 1024)); } }
        if (j > 0 && j == jd) { SB_LOAD(j - 1); }
        if (j > 0 && j == jd) pg8::glds_s(qkvb, vtch + (unsigned)(j - 1) * (unsigned)(64 * QKVW * 2), tdst);
        if (j == jd && nb_ >= 0) { pg8::glds_s(qkvb, nt1, tdst); pg8::glds_s(qkvb, nt2, tdst); pg8::glds_s(qkvb, nt3, tdst); }
        LDS_WAIT();
        f32x16 s0, s1;
#pragma unroll
        for (int i = 0; i < 16; ++i) { s0[i] = 0.f; s1[i] = 0.f; }
#pragma unroll
        for (int d0 = 0; d0 < 4; ++d0) { const int c = 2 * d0 + hi;
            const bf16x8 a0 = *(const LAS bf16x8*)(kl + kswz(r32, c)), a1 = *(const LAS bf16x8*)(kl + kswz(32 + r32, c));
            s0 = __builtin_amdgcn_mfma_f32_32x32x16_bf16(a0, qr[d0], s0, 0, 0, 0); s1 = __builtin_amdgcn_mfma_f32_32x32x16_bf16(a1, qr[d0], s1, 0, 0, 0); }
        const bool diag = (j == jd);
        const float eR = ex2(R);
#pragma unroll
        for (int i = 0; i < 16; ++i) { const int kv = crow(i, hi);
            { const float r = __builtin_amdgcn_rcpf(1.f + ex2(fminf(s0[i], 100.f))); s0[i] = (!diag || (kv < qloc)) ? r : 1.f; }
            { const float r = __builtin_amdgcn_rcpf(1.f + ex2(fminf(s1[i], 100.f))); s1[i] = (!diag || (kv + 32 < qloc)) ? r : 1.f; } }
        float own[8], oth[8];
#pragma unroll
        for (int g = 0; g < 4; ++g) { own[g] = (s0[4 * g] * s0[4 * g + 1]) * (s0[4 * g + 2] * s0[4 * g + 3]); own[4 + g] = (s1[4 * g] * s1[4 * g + 1]) * (s1[4 * g + 2] * s1[4 * g + 3]); }
#pragma unroll
        for (int g = 0; g < 8; ++g) oth[g] = pl32_other(own[g], hi);
        float T[8]; { float so = 1.f, sp_ = 1.f;
#pragma unroll
            for (int g = 7; g >= 0; --g) { T[g] = so * sp_ * (hi ? 1.f : oth[g]); so *= own[g]; sp_ *= oth[g]; }
            const float tot = so * sp_;
#pragma unroll
            for (int g = 0; g < 4; ++g) {
                { const float p4 = eR * T[g], p3 = p4 * s0[4 * g + 3], p2 = p3 * s0[4 * g + 2], p1 = p2 * s0[4 * g + 1], p0 = p1 * s0[4 * g];
                  s0[4 * g + 3] = p4 - p3; s0[4 * g + 2] = p3 - p2; s0[4 * g + 1] = p2 - p1; s0[4 * g] = p1 - p0; }
                { const float p4 = eR * T[4 + g], p3 = p4 * s1[4 * g + 3], p2 = p3 * s1[4 * g + 2], p1 = p2 * s1[4 * g + 1], p0 = p1 * s1[4 * g];
                  s1[4 * g + 3] = p4 - p3; s1[4 * g + 2] = p3 - p2; s1[4 * g + 1] = p2 - p1; s1[4 * g] = p1 - p0; } }
            R += lg2(tot); }
        if (j == jd) { if (nb_ >= 0) { if (j > 0) asm volatile("s_waitcnt vmcnt(12)" ::: "memory"); else asm volatile("s_waitcnt vmcnt(3)" ::: "memory"); }
                       else { if (j > 0) asm volatile("s_waitcnt vmcnt(9)" ::: "memory"); else asm volatile("s_waitcnt vmcnt(0)" ::: "memory"); } }
        else asm volatile("s_waitcnt vmcnt(0)" ::: "memory");
        const LAS unsigned char* vb = vl + half16 * 32 + p4 * 8 + (4 * hi + q4) * 64;
#pragma unroll
        for (int s = 0; s < 4; ++s) {
            u32x4 pw;
            if (s < 2) { pw.x = cvt_pk_bf16(s0[8 * s + 0], s0[8 * s + 1]); pw.y = cvt_pk_bf16(s0[8 * s + 2], s0[8 * s + 3]); pw.z = cvt_pk_bf16(s0[8 * s + 4], s0[8 * s + 5]); pw.w = cvt_pk_bf16(s0[8 * s + 6], s0[8 * s + 7]); }
            else { const int t = s - 2; pw.x = cvt_pk_bf16(s1[8 * t + 0], s1[8 * t + 1]); pw.y = cvt_pk_bf16(s1[8 * t + 2], s1[8 * t + 3]); pw.z = cvt_pk_bf16(s1[8 * t + 4], s1[8 * t + 5]); pw.w = cvt_pk_bf16(s1[8 * t + 6], s1[8 * t + 7]); }
            const bf16x8 pf = __builtin_bit_cast(bf16x8, pw);
#pragma unroll
            for (int k = 0; k < 2; ++k) { const s16x4 lo = vtr(vb + k * 4096 + s * 1024), hh = vtr(vb + k * 4096 + s * 1024 + 512);
                const bf16x8 vf = (bf16x8){lo[0], lo[1], lo[2], lo[3], hh[0], hh[1], hh[2], hh[3]};
                o[k] = __builtin_amdgcn_mfma_f32_32x32x16_bf16(vf, pf, o[k], 0, 0, 0); }
        }
        LDS_WAIT();
        if (__all(R < -40.f)) break;
    }
#undef SB_LOAD
#pragma unroll
    for (int k = 0; k < 2; ++k)
#pragma unroll
        for (int g = 0; g < 4; ++g) { const int dv = 32 * k + 8 * g + 4 * hi;
            *(LAS unsigned*)(kl + r32 * 64 + dv) = pk4_fp8(o[k][4 * g] * F8_ACT_SCALE, o[k][4 * g + 1] * F8_ACT_SCALE, o[k][4 * g + 2] * F8_ACT_SCALE, o[k][4 * g + 3] * F8_ACT_SCALE); }
    LDS_WAIT();
    { const int orow = lane >> 2, opc = lane & 3;
      const u32x4 w0 = *(const LAS u32x4*)(kl + orow * 64 + opc * 16), w1 = *(const LAS u32x4*)(kl + (16 + orow) * 64 + opc * 16);
      unsigned char* ob = (unsigned char*)(C.a->ws + WS_O) + (tokbase + q0 + orow) * DM + h * 64 + opc * 16;
      *(u32x4*)ob = w0; *(u32x4*)(ob + (size_t)16 * DM) = w1; }
    LDS_WAIT();
}


constexpr int PH_PER_LAYER = 8, N_PHASES = 1 + DEPTH * PH_PER_LAYER + 1;

__global__ void __launch_bounds__(512, 2) fwd(Args args) {
    extern __shared__ __attribute__((aligned(16))) unsigned char lds_raw[];
    Ctx C;
    C.lds = (LAS unsigned char*)lds_raw;
    C.tid = threadIdx.x; C.lane = C.tid & 63; C.wave = __builtin_amdgcn_readfirstlane(C.tid >> 6);
    C.G = gridDim.x; { const int bx = blockIdx.x; C.vcu = (C.G % 8 == 0) ? (bx % 8) * (C.G / 8) + bx / 8 : bx; }
    C.a = &args;
    LAS unsigned* lctl = (LAS unsigned*)(C.lds + LCTL_OFF);
    for (int u = C.tid; u < 1024; u += 512) lctl[u] = 0u;
    __syncthreads();
    const int lo = args.ph_lo, hi = args.ph_hi;
    XcdBarrier bar; bar.bar = ((unsigned*)(C.a->ws + WS_CTL)) + CW_BAR; bar.x = 0; bar.st = nullptr;
    if (hi - lo > 1) bar = xcd_barrier_post(((unsigned*)(C.a->ws + WS_CTL)) + CW_BAR, (volatile LAS unsigned*)lctl);
#ifndef PH_MASK
#define PH_MASK 0xffff
#endif
#define PHM(kind) ((PH_MASK >> (kind)) & 1)
#define IN(k) (lo <= (k) && (k) < hi)
#define INL(p) (PHM((p) + 1) && IN(pb + (p)))
#define SEAM(k) do { if (IN(k) && IN((k) + 1)) xcd_barrier(bar); } while (0)

    if (PHM(0) && IN(0)) { p0_prologue(C); __syncthreads(); SEAM(0); }

    for (int l = 0; l < DEPTH; ++l) {
        const int pb = 1 + PH_PER_LAYER * l;
        const bool odd = (l & 1) != 0;
        if (INL(0)) {
            const Ctx P = launder(C);
            if (l == 0) norm_phase<false, 1, false, true>(P, l, P.a->in[I_X], P.a->in[I_NMIX], 0, ((bf16*)(P.a->ws + WS_WBG)));
            else if (odd) norm_phase<true, 0, false, false>(P, l, nullptr, P.a->in[I_NMIX], 0, nullptr);
            else norm_phase<true, 1, false, false>(P, l, nullptr, P.a->in[I_NMIX], 0, ((bf16*)(P.a->ws + WS_WBG)) + (size_t)(l >> 1) * 16 * 1024);
            SEAM(pb + 0);
        }
        if (INL(1)) {
            const Ctx P = launder(C); const int bx = (P.vcu % (P.G / 8)) * 8 + P.vcu / (P.G / 8);
            pg8::Gemm g{((bf16*)(P.a->ws + WS_H)), ((bf16*)(P.a->ws + WS_WIN)) + (size_t)l * 3072 * 1024, 1024}; pg8::StaticOrder S; S.init(NTOK, QKVW, P.G, bx);
            pg8::EpiQKV E{((bf16*)(P.a->ws + WS_QKV)), QKVW, C2, odd ? 4 : 2, 0.125f, odd ? -1 : 6};
            pg8::gemm_phase<pg8::EpiQKV, pg8::StaticOrder, false, true>(P.lds, P.tid, g, S, E);
            SEAM(pb + 1);
        }
        if (INL(2) || INL(3)) {
            if (!odd) {
                LAS float* lamp = (LAS float*)(lctl + 64);
                LAS int* itemp = (LAS int*)(lctl + 65);
                if (C.wave == 0) { const float* lp = C.a->in[I_ELAM] + (size_t)(l >> 1) * 256; const float a = wave_sum(lp[C.lane] * lp[64 + C.lane]), bq = wave_sum(lp[128 + C.lane] * lp[192 + C.lane]);
                    if (C.lane == 0) *lamp = __expf(a) - __expf(bq); }
                const float lam_init = 0.8f - 0.6f * __expf(-0.3f * (float)l);
                const int myx = (int)(xb_xcc_id() & 7u);
#pragma unroll 1
                for (int pass_ = 0; pass_ < 2; ++pass_) {
                    if (!(pass_ == 0 ? INL(2) : INL(3))) continue;
                    const int nqb = pass_ == 0 ? 8 : 24, qb_hi = pass_ == 0 ? 31 : 23, nitem = 32 + 4 * nqb;
#pragma unroll 1
                    for (int kx = 0; kx < 8; ++kx) {
                        const int xq = (myx + kx) & 7;
                        unsigned* qctr = ((unsigned*)(C.a->ws + WS_CTL)) + CW_QUEUE + 1024 + (((l >> 1) * 2 + pass_) * 8 + xq) * 16;
                        for (;;) {
                            __syncthreads();
                            if (C.tid == 0) *itemp = (int)__hip_atomic_fetch_add(qctr, 1u, __ATOMIC_RELAXED, __HIP_MEMORY_SCOPE_AGENT);
                            __syncthreads();
                            const int item = __builtin_amdgcn_readfirstlane(*itemp);
                            const float lam = *lamp + lam_init;
                            if (item >= nitem) break;
                            const Ctx P = launder(C);
                            if (item < 32) { const int oct = 7 - (item >> 2), bh = 4 * xq + (item & 3);
                                if (pass_ == 0) gla_local_unit(P, l, bh >> 2, bh & 3, oct); else gla_scan_unit(P, l, bh >> 2, bh & 3, oct); }
                            else { const int k = item - 32, bh = 4 * xq + (k & 3), qb = qb_hi - (k >> 2); diffattn_unit(P, l, bh >> 2, bh & 3, qb, lam, lam_init); }
                        }
                    }
                    if (pass_ == 0) { SEAM(pb + 2); } else { SEAM(pb + 3); }
                }
            } else if (INL(3)) {
                const Ctx P = launder(C);
                const int gw = P.vcu * 8 + P.wave, NGW = P.G * 8;
                for (int u = gw; u < NBATCH * 16 * 128; u += NGW) { const int hs = u & 1, qt = (u >> 1) & 127, hp = (u >> 8) & 7, b = u >> 11;
                    const int u2 = u + NGW; const bool hn = u2 < NBATCH * 16 * 128;
                    stickbreak_wave_unit(P, b, 2 * hp + hs, qt, hn ? (u2 >> 11) : -1, 2 * ((u2 >> 8) & 7) + (u2 & 1), (u2 >> 1) & 127); }
                __syncthreads();
                SEAM(pb + 3);
            }
        }
        if (INL(4)) {
            const Ctx P = launder(C); const int bx = (P.vcu % (P.G / 8)) * 8 + P.vcu / (P.G / 8);
            pg8::Gemm g{(const bf16*)(P.a->ws + WS_O), (const bf16*)(P.a->ws + WS_WOUT + (size_t)l * 1024 * 1024), 512}; pg8::StaticOrder S; S.init(NTOK, DM, P.G, bx);
            const float* gate1 = ((float*)(P.a->ws + WS_MOD)) + (size_t)l * 8 * 6144 + 2 * 1024;
            if (l == 0) { pg8::EpiResid<true> E{P.a->in[I_X], (bf16*)(P.a->ws + WS_XB), gate1}; pg8::gemm_phase<pg8::EpiResid<true>, pg8::StaticOrder, false, true, true>(P.lds, P.tid, g, S, E); }
            else { pg8::EpiResid<false> E{nullptr, (bf16*)(P.a->ws + WS_XB), gate1}; pg8::gemm_phase<pg8::EpiResid<false>, pg8::StaticOrder, false, true, true>(P.lds, P.tid, g, S, E); }
            SEAM(pb + 4);
        }
        if (INL(5)) {
            const Ctx P = launder(C);
            norm_phase<false, 2, false, false>(P, l, nullptr, P.a->in[I_NFFN], 3, ((bf16*)(P.a->ws + WS_WR)) + (size_t)l * 36 * 1024);
            SEAM(pb + 5);
        }
        if (INL(6)) {
            const Ctx P = launder(C); const int bx = (P.vcu % (P.G / 8)) * 8 + P.vcu / (P.G / 8);
            LAS int* tb = (LAS int*)(P.lds + LCTL_OFF + 64); LAS int* cl = (LAS int*)(P.lds + LCTL_OFF + 512);
            const int* cnt = (const int*)(((unsigned*)(P.a->ws + WS_CTL)) + CW_CNT + 64 * l);
            __syncthreads();
            if (P.tid < 32) {
                const int cv = (int)__hip_atomic_load(cnt + P.tid, __ATOMIC_RELAXED, __HIP_MEMORY_SCOPE_AGENT); cl[P.tid] = cv; int t = (cv + 255) >> 8;
#pragma unroll
                for (int d = 1; d < 32; d <<= 1) { const int v = __shfl_up(t, d); if (P.tid >= d) t += v; }
                tb[P.tid + 1] = t; if (P.tid == 0) tb[0] = 0; }
            __syncthreads();
            const int T = __builtin_amdgcn_readfirstlane(tb[32]);
            pg8::GroupedOrder S{tb, T, P.G, bx, ((int*)(P.a->ws + WS_PLIST)), cl};
            pg8::Gemm g{(const bf16*)(P.a->ws + WS_H8), (const bf16*)(P.a->ws + WS_WGU + (size_t)l * 32 * 1024 * 1024), 512};
            pg8::EpiSwiGLU8 E{(unsigned char*)(P.a->ws + WS_O), ((float*)(P.a->ws + WS_WLIST))};
            pg8::gemm_phase<pg8::EpiSwiGLU8, pg8::GroupedOrder, true, true, true>(P.lds, P.tid, g, S, E);
            SEAM(pb + 6);
        }
        if (INL(7)) {
            const Ctx P = launder(C); const int bx = (P.vcu % (P.G / 8)) * 8 + P.vcu / (P.G / 8);
            LAS int* tb = (LAS int*)(P.lds + LCTL_OFF + 64); LAS int* cl = (LAS int*)(P.lds + LCTL_OFF + 512);
            if (!INL(6)) {
            const int* cnt = (const int*)(((unsigned*)(P.a->ws + WS_CTL)) + CW_CNT + 64 * l);
            __syncthreads();
            if (P.tid < 32) {
                const int cv = (int)__hip_atomic_load(cnt + P.tid, __ATOMIC_RELAXED, __HIP_MEMORY_SCOPE_AGENT); cl[P.tid] = cv; int t = (cv + 255) >> 8;
#pragma unroll
                for (int d = 1; d < 32; d <<= 1) { const int v = __shfl_up(t, d); if (P.tid >= d) t += v; }
                tb[P.tid + 1] = t; if (P.tid == 0) tb[0] = 0; }
            __syncthreads();
            }
            const int T = __builtin_amdgcn_readfirstlane(tb[32]);
            pg8::GroupedOrder S{tb, T, P.G, bx, ((int*)(P.a->ws + WS_PLIST)), cl};
            pg8::Gemm g{(const bf16*)(P.a->ws + WS_O), (const bf16*)(P.a->ws + WS_WD + (size_t)l * 32 * 1024 * 512), 256};
            pg8::EpiScatterY E{((bf16*)(P.a->ws + WS_QKV)), ((int*)(P.a->ws + WS_PLIST))};
            pg8::gemm_phase<pg8::EpiScatterY, pg8::GroupedOrder, false, true, true>(P.lds, P.tid, g, S, E);
            SEAM(pb + 7);
        }
    }
    if (PHM(9) && IN(N_PHASES - 1)) { const Ctx P = launder(C); norm_phase<true, 0, true, false>(P, DEPTH, nullptr, P.a->in[I_NFIN], 0, nullptr); }
#undef IN
#undef INL
#undef SEAM
}

extern "C" void kernel_launch(void* const* d_in, const int* in_sizes, int n_in, void* d_out, int out_size, void* d_ws, size_t ws_size, hipStream_t stream) {
    static int grid = 0;
    if (grid == 0) {
        if (n_in != 24 || in_sizes[0] != NTOK * DM || out_size != NTOK * DM || ws_size < WS_END) { fprintf(stderr, "kernel_launch: unexpected shapes (n_in %d, in0 %d, out %d, ws %zu)\n", n_in, n_in > 0 ? in_sizes[0] : -1, out_size, ws_size); grid = -1; return; }
        int dev = 0, cus = 0, per_cu = 0;
        if (hipGetDevice(&dev) != hipSuccess || hipDeviceGetAttribute(&cus, hipDeviceAttributeMultiprocessorCount, dev) != hipSuccess) { grid = -1; return; }
        if (hipFuncSetAttribute((const void*)fwd, hipFuncAttributeMaxDynamicSharedMemorySize, LDS_BYTES) != hipSuccess) { fprintf(stderr, "kernel_launch: hipFuncSetAttribute failed\n"); grid = -1; return; }
        if (hipOccupancyMaxActiveBlocksPerMultiprocessor(&per_cu, (const void*)fwd, 512, LDS_BYTES) != hipSuccess || per_cu < 1) fprintf(stderr, "kernel_launch: occupancy query reports %d\n", per_cu);
        (void)hipGetLastError();
        grid = cus;
        if (grid != 256) { fprintf(stderr, "kernel_launch: built for a 256-CU device (one workgroup per CU), found %d CUs\n", cus); grid = -1; return; }
    }
    if (grid < 0) return;
    if (hipMemsetAsync((char*)d_ws + WS_CTL, 0, CTL_ZERO_BYTES, stream) != hipSuccess) return;
    Args a{};
    for (int i = 0; i < 24; ++i) a.in[i] = (const float*)d_in[i];
    a.out = (float*)d_out; a.ws = (unsigned char*)d_ws;
    a.ph_lo = 0; a.ph_hi = N_PHASES;
    hipLaunchKernelGGL(fwd, dim3(grid), dim3(512), LDS_BYTES, stream, a);
}
```

```cpp
#include <hip/hip_runtime.h>
#include <cstdio>
#include <cstdint>

#define GAS __attribute__((address_space(1)))
#define LAS __attribute__((address_space(3)))
typedef unsigned short bf16;
typedef short bf16x8 __attribute__((ext_vector_type(8)));
typedef short s16x4 __attribute__((ext_vector_type(4)));
typedef float f32x4 __attribute__((ext_vector_type(4)));
typedef float f32x2 __attribute__((ext_vector_type(2)));
typedef float f32x16 __attribute__((ext_vector_type(16)));
typedef unsigned u32x4 __attribute__((ext_vector_type(4)));
typedef unsigned u32x2 __attribute__((ext_vector_type(2)));

constexpr int NTOK = 32768, DM = 1024, SEQ = 4096, NBATCH = 8, DEPTH = 4;
constexpr int QKVW = 3072;
constexpr int NEXP = 32;
constexpr float EPS = 1e-6f;
constexpr float LOG2E = 1.4426950408889634f;
constexpr float C2 = 0.125f * 1.4426950408889634f;
constexpr int E_AQ = 0, E_AK = 512, E_AV = 1024, E_BQ = 1536, E_BK = 1792, E_BV = 2048, E_BR = 2560;
constexpr int O_Q = 0, O_K = 1024, O_V = 2048;

constexpr size_t MiB = 1u << 20;
constexpr size_t WS_CTL = 0, CTL_ZERO_BYTES = 1 * MiB;
constexpr size_t WS_MOD = 2 * MiB;
constexpr size_t WS_WR = 3 * MiB;
constexpr size_t WS_WBG = 3 * MiB + 512 * 1024;
constexpr size_t WS_PLIST = 4 * MiB;
constexpr size_t WS_WLIST = 8 * MiB;
constexpr size_t WS_BG = 12 * MiB;
constexpr size_t WS_WIN = 16 * MiB;
constexpr size_t WS_WOUT = 40 * MiB;
constexpr size_t WS_WGU = 48 * MiB;
constexpr size_t WS_WD = 304 * MiB;
constexpr size_t WS_H = 432 * MiB;
constexpr size_t WS_QKV = 498 * MiB;
constexpr size_t WS_O = 690 * MiB;
constexpr size_t WS_GQD = 768 * MiB;
constexpr size_t WS_GIN = 784 * MiB;
constexpr size_t WS_GKV = 816 * MiB;
constexpr size_t WS_GAD = 880 * MiB;
constexpr size_t WS_GKA = 880 * MiB + 512 * 1024;
constexpr size_t WS_XB = 889 * MiB;
constexpr size_t WS_H8 = 953 * MiB;
constexpr size_t WS_END = 987 * MiB;
constexpr int CW_BAR = 4096;
constexpr int CW_CNT = 16384;
constexpr int CW_DBG = 24576;
constexpr int CW_QUEUE = 20480;
constexpr int RING_BYTES = 147456;
constexpr int LCTL_OFF = RING_BYTES;
constexpr int LDS_BYTES = RING_BYTES + 4096;

__device__ __forceinline__ unsigned f2bf(float f) { unsigned u = __builtin_bit_cast(unsigned, f); return (u + 0x7fffu + ((u >> 16) & 1u)) >> 16; }
__device__ __forceinline__ unsigned pk2(float lo, float hi) { return f2bf(lo) | (f2bf(hi) << 16); }
typedef __bf16 bf16x2_t __attribute__((ext_vector_type(2)));
__device__ __forceinline__ unsigned cvt_pk_bf16(float lo, float hi) { f32x2 v = {lo, hi}; bf16x2_t b = __builtin_convertvector(v, bf16x2_t); return __builtin_bit_cast(unsigned, b); }
__device__ __forceinline__ unsigned cvt1_bf16(float x) { return cvt_pk_bf16(x, 0.f); }
typedef int v4i32 __attribute__((ext_vector_type(4)));
typedef int v8i32 __attribute__((ext_vector_type(8)));
__device__ __forceinline__ unsigned pk4_fp8(float a, float b, float c, float d) {
    a = __builtin_fminf(__builtin_fmaxf(a, -448.f), 448.f); b = __builtin_fminf(__builtin_fmaxf(b, -448.f), 448.f); c = __builtin_fminf(__builtin_fmaxf(c, -448.f), 448.f); d = __builtin_fminf(__builtin_fmaxf(d, -448.f), 448.f);
    int pk = 0; pk = __builtin_amdgcn_cvt_pk_fp8_f32(a, b, pk, false); pk = __builtin_amdgcn_cvt_pk_fp8_f32(c, d, pk, true); return (unsigned)pk; }
constexpr float F8_ACT_SCALE = 16.f, F8_W_SCALE = 64.f;
constexpr int F8_SC_ACT = 0x7b7b7b7b, F8_SC_W = 0x79797979;
__device__ __forceinline__ float bf2f(unsigned short x) { return __builtin_bit_cast(float, (unsigned)x << 16); }
__device__ __forceinline__ float bflo(unsigned x) { return __builtin_bit_cast(float, x << 16); }
__device__ __forceinline__ float bfhi(unsigned x) { return __builtin_bit_cast(float, x & 0xffff0000u); }
__device__ __forceinline__ int crow(int r, int hi) { return (r & 3) + 8 * (r >> 2) + 4 * hi; }
__device__ __forceinline__ float ex2(float x) { return __builtin_amdgcn_exp2f(x); }
__device__ __forceinline__ float lg2(float x) { return __builtin_amdgcn_logf(x); }
__device__ __forceinline__ void swap32(float& a, float& b) { asm volatile("s_nop 1\n\tv_permlane32_swap_b32 %0, %1\n\ts_nop 1" : "+v"(a), "+v"(b)); }
__device__ __forceinline__ void swap16(float& a, float& b) { asm volatile("s_nop 1\n\tv_permlane16_swap_b32 %0, %1\n\ts_nop 1" : "+v"(a), "+v"(b)); }
#define LDS_WAIT() asm volatile("s_waitcnt lgkmcnt(0)" ::: "memory")
#define LBAR() do { asm volatile("s_waitcnt lgkmcnt(0)" ::: "memory"); __builtin_amdgcn_s_barrier(); asm volatile("" ::: "memory"); } while (0)

namespace pg8 {
typedef unsigned short bf16_t;
constexpr int BM = 256, BK = 64, HALF = 128, HTB = HALF * BK * 2, STAGE_BYTES = 8 * HTB, NXCD = 8, WGM = 8;
__host__ __device__ __forceinline__ int lds_byte(int r, int c) { const int st = (r >> 4) * 2 + (c >> 5), rr = r & 15, cc = c & 31, ob = rr * 64 + cc * 2; return st * 1024 + (ob ^ (((ob >> 9) & 1) << 5)); }
__host__ __device__ __forceinline__ void stage_rc(int b, int& R, int& C) { const int st = b / 1024, sb = b % 1024, swz = sb ^ (((sb >> 9) & 1) << 5); R = (st >> 1) * 16 + swz / 64; C = (st & 1) * 32 + (swz % 64) / 2; }
__host__ __device__ __forceinline__ int perm32(int rho) { const int n = rho >> 4, i = rho & 15; return 8 * (i >> 2) + 4 * n + (i & 3); }

struct Unit { int pm, pn, e, t0, ne; };
struct Gemm { const bf16_t* A; const bf16_t* Bt; int K; };

struct StaticOrder {
    int nM, nN, nwg, G, c;
    __device__ void init(int M, int N, int G_, int c_) { nM = M / BM; nN = N / BM; nwg = nM * nN; G = G_; c = c_; }
    __device__ bool next(int i, Unit& u) const {
        const long L = (long)i * G + c; if (L >= nwg) return false;
        int wgid = (int)L; { const int q = nwg / NXCD, r = nwg % NXCD, xcd = wgid % NXCD, off = wgid / NXCD; wgid = (xcd < r ? xcd * (q + 1) : r * (q + 1) + (xcd - r) * q) + off; }
        const int nig = WGM * nN, gid = wgid / nig, fm = gid * WGM, gsz = (nM - fm) < WGM ? (nM - fm) : WGM;
        u.pm = fm + ((wgid % nig) % gsz); u.pn = (wgid % nig) / gsz; u.e = 0; u.t0 = 0; u.ne = 0; return true;
    }
    __device__ __forceinline__ int arow(const Unit&, int) const { return 0; }
};

struct GroupedOrder {
    const LAS int* tb; int T, G, c; const int* plist; const LAS int* cl;
    __device__ __forceinline__ bool next(int i, Unit& u) const {
        const int nun = T * 4; const long L = (long)i * G + c; if (L >= nun) return false;
        int w = (int)L; { const int q = nun / NXCD, r = nun % NXCD, xcd = w % NXCD, off = w / NXCD; w = (xcd < r ? xcd * (q + 1) : r * (q + 1) + (xcd - r) * q) + off; }
        const int ti = w >> 2, pnl = w & 3;
        int e = 0;
#pragma unroll
        for (int step = 16; step >= 1; step >>= 1) { const int v = __builtin_amdgcn_readfirstlane(tb[e + step]); if (v <= ti) e += step; }
        u.pm = ti; u.pn = e * 4 + pnl; u.e = e; u.t0 = ti - __builtin_amdgcn_readfirstlane(tb[e]); u.ne = __builtin_amdgcn_readfirstlane(cl[e]); return true;
    }
    __device__ __forceinline__ int arow(const Unit& u, int r) const {
        const int pos = u.t0 * 256 + r; const int pr = plist[(size_t)u.e * NTOK + pos];
        return pos < u.ne ? (pr >> 1) : NTOK;
    }
};

struct EpiQKV {
    static constexpr bool PERM = true;
    bf16_t* O; int ldc; float s_lo; int n_lo; float s_one; int i_one;
    __device__ __forceinline__ void operator()(const f32x4 (&acc)[2][2][4][2], const Unit& u, int wr, int wc, int fr, int fq) const {
        const int row0 = u.pm * BM + wr * 64 + fr; const int col0 = u.pn * BM + wc * 32 + 8 * fq;
        const float sc = (u.pn < n_lo) ? s_lo : ((u.pn == i_one) ? s_one : 1.f);
#pragma unroll
        for (int ai = 0; ai < 2; ++ai)
#pragma unroll
            for (int m = 0; m < 4; ++m) { bf16_t* rowp = O + (size_t)(row0 + ai * HALF + m * 16) * ldc + col0;
#pragma unroll
                for (int bj = 0; bj < 2; ++bj) { f32x4 v0 = acc[ai][bj][m][0] * sc, v1 = acc[ai][bj][m][1] * sc;
                    u32x4 w; w.x = cvt_pk_bf16(v0[0], v0[1]); w.y = cvt_pk_bf16(v0[2], v0[3]); w.z = cvt_pk_bf16(v1[0], v1[1]); w.w = cvt_pk_bf16(v1[2], v1[3]);
                    *(u32x4*)(rowp + bj * HALF) = w; } }
    }
};
template <bool BASE_F32> struct EpiResid {
    static constexpr bool PERM = true;
    const float* base32; bf16_t* xb; const float* gate;
    __device__ __forceinline__ void operator()(const f32x4 (&acc)[2][2][4][2], const Unit& u, int wr, int wc, int fr_, int fq_) const {
        int fr = fr_, fq = fq_; asm volatile("" : "+v"(fr), "+v"(fq));
        const int b = (u.pm * BM) >> 12; const float* gp = gate + (size_t)b * 6144;
        const int col0 = u.pn * BM + wc * 32 + 8 * fq;
        if constexpr (!BASE_F32) {
            const unsigned ob0 = (unsigned)(((u.pm * BM + wr * 64 + fr) * DM + col0) * 2);
#pragma unroll
            for (int bj = 0; bj < 2; ++bj) { const f32x4 g0 = *(const f32x4*)(gp + col0 + bj * HALF), g1 = *(const f32x4*)(gp + col0 + bj * HALF + 4);
                u32x4 xr[2][4];
#pragma unroll
                for (int ai = 0; ai < 2; ++ai)
#pragma unroll
                    for (int m = 0; m < 4; ++m) { const unsigned ob = ob0 + (unsigned)(((ai * HALF + m * 16) * DM + bj * HALF) * 2); xr[ai][m] = *(const u32x4*)((const char*)xb + ob); }
#pragma unroll
                for (int ai = 0; ai < 2; ++ai)
#pragma unroll
                    for (int m = 0; m < 4; ++m) { const unsigned ob = ob0 + (unsigned)(((ai * HALF + m * 16) * DM + bj * HALF) * 2); const u32x4 r = xr[ai][m];
                        const f32x4 x0 = (f32x4){bflo(r.x), bfhi(r.x), bflo(r.y), bfhi(r.y)}, x1 = (f32x4){bflo(r.z), bfhi(r.z), bflo(r.w), bfhi(r.w)};
                        const f32x4 y0 = x0 + g0 * acc[ai][bj][m][0], y1 = x1 + g1 * acc[ai][bj][m][1];
                        u32x4 w; w.x = cvt_pk_bf16(y0[0], y0[1]); w.y = cvt_pk_bf16(y0[2], y0[3]); w.z = cvt_pk_bf16(y1[0], y1[1]); w.w = cvt_pk_bf16(y1[2], y1[3]);
                        *(u32x4*)((char*)xb + ob) = w; } }
            return;
        }
#pragma unroll
        for (int bj = 0; bj < 2; ++bj) { const f32x4 g0 = *(const f32x4*)(gp + col0 + bj * HALF), g1 = *(const f32x4*)(gp + col0 + bj * HALF + 4);
#pragma unroll
            for (int ai = 0; ai < 2; ++ai) {
                f32x4 x0[4], x1[4];
#pragma unroll
                for (int m = 0; m < 4; ++m) { const size_t off = (size_t)(u.pm * BM + ai * HALF + wr * 64 + m * 16 + fr) * DM + col0 + bj * HALF;
                    if (BASE_F32) { x0[m] = *(const f32x4*)(base32 + off); x1[m] = *(const f32x4*)(base32 + off + 4); }
                    else { const u32x4 xr = *(const u32x4*)(xb + off); x0[m] = (f32x4){bflo(xr.x), bfhi(xr.x), bflo(xr.y), bfhi(xr.y)}; x1[m] = (f32x4){bflo(xr.z), bfhi(xr.z), bflo(xr.w), bfhi(xr.w)}; } }
#pragma unroll
                for (int m = 0; m < 4; ++m) { const size_t off = (size_t)(u.pm * BM + ai * HALF + wr * 64 + m * 16 + fr) * DM + col0 + bj * HALF;
                    const f32x4 y0 = x0[m] + g0 * acc[ai][bj][m][0], y1 = x1[m] + g1 * acc[ai][bj][m][1];
                    u32x4 w; w.x = cvt_pk_bf16(y0[0], y0[1]); w.y = cvt_pk_bf16(y0[2], y0[3]); w.z = cvt_pk_bf16(y1[0], y1[1]); w.w = cvt_pk_bf16(y1[2], y1[3]);
                    *(u32x4*)(xb + off) = w; } } }
    }
};
struct EpiSwiGLU {
    static constexpr bool PERM = true;
    bf16_t* ACT; const float* wlist; const int* cnt;
    __device__ __forceinline__ void operator()(const f32x4 (&acc)[2][2][4][2], const Unit& u, int wr, int wc, int fr, int fq) const {
        const int n_e = cnt[u.e]; const int col0 = (u.pn & 3) * 128 + wc * 32 + 8 * fq;
#pragma unroll
        for (int ai = 0; ai < 2; ++ai)
#pragma unroll
            for (int m = 0; m < 4; ++m) { const int rloc = ai * HALF + wr * 64 + m * 16 + fr; const int pos = u.t0 * 256 + rloc;
                const float w = pos < n_e ? wlist[(size_t)u.e * NTOK + pos] : 0.f;
                float r[8];
#pragma unroll
                for (int n = 0; n < 2; ++n)
#pragma unroll
                    for (int i = 0; i < 4; ++i) { const float g = acc[ai][0][m][n][i], uu = acc[ai][1][m][n][i];
                        r[n * 4 + i] = g * __builtin_amdgcn_rcpf(1.f + __expf(-g)) * uu * w; }
                u32x4 o; o.x = cvt_pk_bf16(r[0], r[1]); o.y = cvt_pk_bf16(r[2], r[3]); o.z = cvt_pk_bf16(r[4], r[5]); o.w = cvt_pk_bf16(r[6], r[7]);
                *(u32x4*)(ACT + (size_t)(u.pm * BM + rloc) * 512 + col0) = o; }
    }
};
struct EpiSwiGLU8 {
    static constexpr bool PERM = true;
    unsigned char* ACT8; const float* wlist;
    __device__ __forceinline__ void operator()(const f32x4 (&acc)[2][2][4][2], const Unit& u, int wr, int wc, int fr_, int fq_) const {
        int fr = fr_, fq = fq_; asm volatile("" : "+v"(fr), "+v"(fq));
        const int n_e = u.ne; const int col0 = (u.pn & 3) * 128 + wc * 32 + 8 * fq;
        float w8[8];
#pragma unroll
        for (int q = 0; q < 8; ++q) { const int pos = u.t0 * 256 + (q >> 2) * HALF + wr * 64 + (q & 3) * 16 + fr; w8[q] = wlist[(size_t)u.e * NTOK + pos]; }
#pragma unroll
        for (int ai = 0; ai < 2; ++ai)
#pragma unroll
            for (int m = 0; m < 4; ++m) { const int rloc = ai * HALF + wr * 64 + m * 16 + fr; const int pos = u.t0 * 256 + rloc;
                const float w = pos < n_e ? w8[ai * 4 + m] * F8_ACT_SCALE : 0.f;
                float r[8];
#pragma unroll
                for (int n = 0; n < 2; ++n)
#pragma unroll
                    for (int i = 0; i < 4; ++i) { const float g = acc[ai][0][m][n][i], uu = acc[ai][1][m][n][i];
                        r[n * 4 + i] = g * __builtin_amdgcn_rcpf(1.f + __expf(-g)) * uu * w; }
                u32x2 o; o.x = pk4_fp8(r[0], r[1], r[2], r[3]); o.y = pk4_fp8(r[4], r[5], r[6], r[7]);
                *(u32x2*)(ACT8 + (size_t)(u.pm * BM + rloc) * 512 + col0) = o; }
    }
};
struct EpiScatterY {
    static constexpr bool PERM = true;
    bf16_t* Y; const int* plist;
    __device__ __forceinline__ void operator()(const f32x4 (&acc)[2][2][4][2], const Unit& u, int wr, int wc, int fr_, int fq_) const {
        int fr = fr_, fq = fq_; asm volatile("" : "+v"(fr), "+v"(fq));
        const int n_e = u.ne; const int col0 = (u.pn & 3) * 256 + wc * 32 + 8 * fq;
        int yr[8];
#pragma unroll
        for (int q = 0; q < 8; ++q) { const int pos = u.t0 * 256 + (q >> 2) * HALF + wr * 64 + (q & 3) * 16 + fr; yr[q] = plist[(size_t)u.e * NTOK + pos]; }
#pragma unroll
        for (int ai = 0; ai < 2; ++ai)
#pragma unroll
            for (int m = 0; m < 4; ++m) { const int rloc = ai * HALF + wr * 64 + m * 16 + fr; const int pos = u.t0 * 256 + rloc;
                const int yrow = pos < n_e ? yr[ai * 4 + m] : 2 * NTOK;
                unsigned char* rowp = (unsigned char*)Y + (size_t)yrow * DM + col0;
#pragma unroll
                for (int bj = 0; bj < 2; ++bj) { const f32x4 v0 = acc[ai][bj][m][0] * 32.f, v1 = acc[ai][bj][m][1] * 32.f;
                    u32x2 w; w.x = pk4_fp8(v0[0], v0[1], v0[2], v0[3]); w.y = pk4_fp8(v1[0], v1[1], v1[2], v1[3]);
                    *(u32x2*)(rowp + bj * HALF) = w; } }
    }
};

__device__ __forceinline__ void glds_s(const char* sbase_, unsigned voff, unsigned lds_dst) {
    const unsigned long long pb_ = (unsigned long long)sbase_;
    const char* sbase = (const char*)(((unsigned long long)(unsigned)__builtin_amdgcn_readfirstlane((int)(pb_ >> 32)) << 32) | (unsigned long long)(unsigned)__builtin_amdgcn_readfirstlane((int)(unsigned)pb_));
    unsigned keep;
    asm volatile("s_mov_b32 %0, m0\n\ts_mov_b32 m0, %3\n\ts_nop 0\n\tglobal_load_lds_dwordx4 %1, %2\n\ts_mov_b32 m0, %0"
                 : "=&s"(keep) : "v"(voff), "s"(sbase), "s"(lds_dst) : "memory");
}
template <class Epi, class Sched, bool GATHER, bool ALIGN_EPI, bool F8 = false>
__device__ __forceinline__ void gemm_phase(LAS unsigned char* lds, const int tid, const Gemm g, const Sched& S, const Epi& E) {
    const int wid = __builtin_amdgcn_readfirstlane(tid >> 6), lane = tid & 63, wr = wid >> 2, wc = wid & 3, fr = lane & 15, fq = lane >> 4;
    int K_ = g.K; asm volatile("" : "+s"(K_));
    const int K = K_, nt = K / BK;
    unsigned voffB[2]; int sR[2], sC[2];
#pragma unroll
    for (int i = 0; i < 2; ++i) { int R, C; stage_rc(tid * 16 + i * 8192, R, C); const int Rb = Epi::PERM ? ((R & ~31) + perm32(R & 31)) : R;
        voffB[i] = (unsigned)(Rb * K + C) * 2u; sR[i] = R; sC[i] = C; }
    const size_t kstep = (size_t)(BK * 2);
    const size_t hstep = (size_t)HALF * K * 2;
    const size_t tstep = 2 * hstep;
    const unsigned ldsw = (unsigned)wid * 1024u;
    const unsigned ldsbase = (unsigned)__builtin_amdgcn_readfirstlane((int)(unsigned)(uintptr_t)lds);
    const int aoff = lds_byte(wr * 64 + fr, fq * 8), boff = lds_byte(wc * 32 + fr, fq * 8);
    constexpr int KOFF = 1024;
#define PG8_SA(b, h) (((b) * 2 + (h)) * HTB)
#define PG8_SB(b, h) ((4 + (b) * 2 + (h)) * HTB)
#define PG8_STAGE_B(bufoff, gbase) do { _Pragma("unroll") for (int _i = 0; _i < 2; ++_i) glds_s((const char*)(gbase), voffB[_i], ldsbase + (unsigned)(bufoff) + ldsw + (unsigned)(_i * 8192)); } while (0)
#define PG8_STAGE_A(bufoff, gbase, o) do { _Pragma("unroll") for (int _i = 0; _i < 2; ++_i) glds_s((const char*)(gbase), (o)[_i], ldsbase + (unsigned)(bufoff) + ldsw + (unsigned)(_i * 8192)); } while (0)
#define PG8_LD8(p) __builtin_shufflevector(*(const LAS v4i32*)(p), *(const LAS v4i32*)((p) + KOFF), 0, 1, 2, 3, 4, 5, 6, 7)
#define PG8_LDA8(dst, b, h) do { _Pragma("unroll") for (int m = 0; m < 4; ++m) dst[m] = PG8_LD8(lds + PG8_SA(b, h) + aoff + m * 2048); } while (0)
#define PG8_LDB8(dst, b, h) do { _Pragma("unroll") for (int n = 0; n < 2; ++n) dst[n] = PG8_LD8(lds + PG8_SB(b, h) + boff + n * 2048); } while (0)
#define PG8_MMA8(ai, bj, A8, B8) do { __builtin_amdgcn_s_setprio(1); _Pragma("unroll") for (int m = 0; m < 4; ++m) _Pragma("unroll") for (int n = 0; n < 2; ++n) \
        asm volatile("v_mfma_scale_f32_16x16x128_f8f6f4 %0, %1, %2, %0, %3, %4 op_sel_hi:[0,0,0]" : "+v"(acc[ai][bj][m][n]) : "v"(B8[n]), "v"(A8[m]), "v"(sc_w), "v"(sc_a)); \
        __builtin_amdgcn_s_setprio(0); } while (0)
#define PG8_LDA(dst, b, h) do { _Pragma("unroll") for (int m = 0; m < 4; ++m) _Pragma("unroll") for (int k = 0; k < 2; ++k) dst[m][k] = *(const LAS bf16x8*)(lds + PG8_SA(b, h) + aoff + m * 2048 + k * KOFF); } while (0)
#define PG8_LDB(dst, b, h) do { _Pragma("unroll") for (int n = 0; n < 2; ++n) _Pragma("unroll") for (int k = 0; k < 2; ++k) dst[n][k] = *(const LAS bf16x8*)(lds + PG8_SB(b, h) + boff + n * 2048 + k * KOFF); } while (0)
#define PG8_MMA(ai, bj, At, Bt) do { __builtin_amdgcn_s_setprio(1); _Pragma("unroll") for (int m = 0; m < 4; ++m) _Pragma("unroll") for (int n = 0; n < 2; ++n) _Pragma("unroll") for (int k = 0; k < 2; ++k) \
        acc[ai][bj][m][n] = __builtin_amdgcn_mfma_f32_16x16x32_bf16(Bt[n][k], At[m][k], acc[ai][bj][m][n], 0, 0, 0); __builtin_amdgcn_s_setprio(0); } while (0)
#define PG8_WAIT_V(n) asm volatile("s_waitcnt vmcnt(" #n ")" ::: "memory")
#define PG8_WAIT_L(n) asm volatile("s_waitcnt lgkmcnt(" #n ")" ::: "memory")
#define PG8_BAR __builtin_amdgcn_s_barrier()
#define PG8_SCHED __builtin_amdgcn_sched_barrier(0)
#define PG8_SETOFF(o, u) do { _Pragma("unroll") for (int _h = 0; _h < 2; ++_h) _Pragma("unroll") for (int _i = 0; _i < 2; ++_i) \
        (o)[_h][_i] = GATHER ? ((unsigned)S.arow(u, _h * HALF + sR[_i]) * (unsigned)(K * 2) + (unsigned)(sC[_i] * 2)) : (unsigned)(((_h * HALF + sR[_i]) * K + sC[_i]) * 2); } while (0)
    Unit cur, nxt; int ui = 0;
    if (!S.next(0, cur)) return;
    unsigned offA[2][2], noffA[2][2];
    PG8_SETOFF(offA, cur);
    f32x4 acc[2][2][4][2];
#pragma unroll
    for (int a = 0; a < 2; ++a)
#pragma unroll
        for (int b = 0; b < 2; ++b)
#pragma unroll
            for (int m = 0; m < 4; ++m)
#pragma unroll
                for (int n = 0; n < 2; ++n) acc[a][b][m][n] = (f32x4){0.f, 0.f, 0.f, 0.f};
    bf16x8 At[4][2], B0[2][2], B1[2][2];
    v8i32 At8[4], B08[2], B18[2];
    int sc_w = F8_SC_W, sc_a = F8_SC_ACT; asm volatile("" : "+v"(sc_w), "+v"(sc_a));
    const char* cA = GATHER ? (const char*)g.A : (const char*)g.A + (size_t)cur.pm * tstep; const char* cB = (const char*)g.Bt + (size_t)cur.pn * tstep;
    PG8_STAGE_B(PG8_SB(0, 0), cB); PG8_STAGE_B(PG8_SB(0, 1), cB + hstep); PG8_STAGE_A(PG8_SA(0, 0), cA, offA[0]); PG8_STAGE_A(PG8_SA(0, 1), cA, offA[1]);
    if (wr == 1) PG8_BAR;
    PG8_WAIT_V(2); PG8_BAR;
    PG8_STAGE_B(PG8_SB(1, 0), cB + kstep); PG8_STAGE_A(PG8_SA(1, 0), cA + kstep, offA[0]); PG8_STAGE_B(PG8_SB(1, 1), cB + hstep + kstep);
    PG8_WAIT_V(6); PG8_BAR;
    for (;;) {
        const bool has_next = S.next(ui + 1, nxt);
        if (GATHER) { if (has_next) { PG8_SETOFF(noffA, nxt); } else {
#pragma unroll
            for (int h = 0; h < 2; ++h)
#pragma unroll
                for (int i = 0; i < 2; ++i) noffA[h][i] = offA[h][i]; } }
        const char* nA = GATHER ? cA : (has_next ? (const char*)g.A + (size_t)nxt.pm * tstep : cA); const char* nB = has_next ? (const char*)g.Bt + (size_t)nxt.pn * tstep : cB;
        for (int t = 0; t < nt; t += 2) {
            const bool last = (t == nt - 2);
            const char* a1 = cA + (size_t)(t + 1) * kstep;
            const char* a2 = last ? nA : cA + (size_t)(t + 2) * kstep; const char* b2 = last ? nB : cB + (size_t)(t + 2) * kstep;
            const char* a3 = a2 + kstep; const char* b3 = b2 + kstep;
            unsigned o2[2][2];
#pragma unroll
            for (int h = 0; h < 2; ++h)
#pragma unroll
                for (int i = 0; i < 2; ++i) o2[h][i] = (GATHER && last) ? noffA[h][i] : offA[h][i];
            if constexpr (F8) {
            PG8_LDB8(B08, 0, 0); PG8_LDB8(B18, 0, 1); PG8_SCHED; PG8_LDA8(At8, 0, 0); PG8_STAGE_A(PG8_SA(1, 1), a1, offA[1]);
            PG8_WAIT_V(8); PG8_WAIT_L(0); PG8_BAR; PG8_MMA8(0, 0, At8, B08); PG8_MMA8(0, 1, At8, B18); PG8_BAR; PG8_SCHED;
            PG8_LDA8(At8, 0, 1); PG8_STAGE_B(PG8_SB(0, 0), b2); PG8_STAGE_B(PG8_SB(0, 1), b2 + hstep); PG8_STAGE_A(PG8_SA(0, 0), a2, o2[0]);
            PG8_WAIT_V(8); PG8_WAIT_L(0); PG8_BAR; PG8_MMA8(1, 0, At8, B08); PG8_MMA8(1, 1, At8, B18); PG8_BAR; PG8_SCHED;
            PG8_LDB8(B08, 1, 0); PG8_LDB8(B18, 1, 1); PG8_SCHED; PG8_LDA8(At8, 1, 0); PG8_STAGE_A(PG8_SA(0, 1), a2, o2[1]);
            PG8_WAIT_V(8); PG8_WAIT_L(0); PG8_BAR; PG8_MMA8(0, 0, At8, B08); PG8_MMA8(0, 1, At8, B18); PG8_BAR; PG8_SCHED;
            PG8_LDA8(At8, 1, 1); PG8_STAGE_B(PG8_SB(1, 0), b3); PG8_STAGE_B(PG8_SB(1, 1), b3 + hstep); PG8_STAGE_A(PG8_SA(1, 0), a3, o2[0]);
            PG8_WAIT_V(8); PG8_WAIT_L(0); PG8_BAR; PG8_MMA8(1, 0, At8, B08); PG8_MMA8(1, 1, At8, B18); PG8_BAR; PG8_SCHED;
            } else {
            PG8_LDB(B0, 0, 0); PG8_LDB(B1, 0, 1); PG8_SCHED; PG8_LDA(At, 0, 0); PG8_STAGE_A(PG8_SA(1, 1), a1, offA[1]);
            PG8_WAIT_V(8); PG8_WAIT_L(0); PG8_BAR; PG8_MMA(0, 0, At, B0); PG8_MMA(0, 1, At, B1); PG8_BAR; PG8_SCHED;
            PG8_LDA(At, 0, 1); PG8_STAGE_B(PG8_SB(0, 0), b2); PG8_STAGE_B(PG8_SB(0, 1), b2 + hstep); PG8_STAGE_A(PG8_SA(0, 0), a2, o2[0]);
            PG8_WAIT_V(8); PG8_WAIT_L(0); PG8_BAR; PG8_MMA(1, 0, At, B0); PG8_MMA(1, 1, At, B1); PG8_BAR; PG8_SCHED;
            PG8_LDB(B0, 1, 0); PG8_LDB(B1, 1, 1); PG8_SCHED; PG8_LDA(At, 1, 0); PG8_STAGE_A(PG8_SA(0, 1), a2, o2[1]);
            PG8_WAIT_V(8); PG8_WAIT_L(0); PG8_BAR; PG8_MMA(0, 0, At, B0); PG8_MMA(0, 1, At, B1); PG8_BAR; PG8_SCHED;
            PG8_LDA(At, 1, 1); PG8_STAGE_B(PG8_SB(1, 0), b3); PG8_STAGE_B(PG8_SB(1, 1), b3 + hstep); PG8_STAGE_A(PG8_SA(1, 0), a3, o2[0]);
            PG8_WAIT_V(8); PG8_WAIT_L(0); PG8_BAR; PG8_MMA(1, 0, At, B0); PG8_MMA(1, 1, At, B1); PG8_BAR; PG8_SCHED;
            }
        }
        if constexpr (ALIGN_EPI) { if (wr == 0) PG8_BAR; }
        if constexpr (F8) asm volatile("s_nop 15\n\ts_nop 15" ::: "memory");
        E(acc, cur, wr, wc, fr, fq);
        if (!has_next) break;
#pragma unroll
        for (int a = 0; a < 2; ++a)
#pragma unroll
            for (int b = 0; b < 2; ++b)
#pragma unroll
                for (int m = 0; m < 4; ++m)
#pragma unroll
                    for (int n = 0; n < 2; ++n) acc[a][b][m][n] = (f32x4){0.f, 0.f, 0.f, 0.f};
        cur = nxt; cA = nA; cB = nB; ++ui;
#pragma unroll
        for (int h = 0; h < 2; ++h)
#pragma unroll
            for (int i = 0; i < 2; ++i) offA[h][i] = noffA[h][i];
        if constexpr (ALIGN_EPI) { if (wr == 1) PG8_BAR; }
    }
    PG8_WAIT_V(0);
    if constexpr (!ALIGN_EPI) { if (wr == 0) PG8_BAR; }
    PG8_BAR;
#undef PG8_SA
#undef PG8_SB
#undef PG8_STAGE_A
#undef PG8_STAGE_B
#undef PG8_LDA
#undef PG8_LDA8
#undef PG8_LD8
#undef PG8_LDB8
#undef PG8_MMA8
#undef PG8_LDB
#undef PG8_MMA
#undef PG8_WAIT_V
#undef PG8_WAIT_L
#undef PG8_BAR
#undef PG8_SCHED
#undef PG8_SETOFF
}
}

#define XB_TMO      128
#define XB_XCNT(j)  (256  + 64 * (j))
#define XB_XSUB(j)  (1280 + 64 * (j))
#define XB_XGEN(j)  (2304 + 64 * (j))
#define XB_TOP      3328
#define XB_TOPGEN   3392
#define XCD_BAR_WORDS 3456
#define XB_SPIN_CAP (1u << 18)
__device__ __forceinline__ unsigned xb_ld(unsigned* p)              { return __hip_atomic_load(p, __ATOMIC_RELAXED, __HIP_MEMORY_SCOPE_AGENT); }
__device__ __forceinline__ unsigned xb_add(unsigned* p, unsigned v) { return __hip_atomic_fetch_add(p, v, __ATOMIC_RELAXED, __HIP_MEMORY_SCOPE_AGENT); }
__device__ __forceinline__ unsigned xb_xcc_id() { return (unsigned)__builtin_amdgcn_s_getreg((3 << 11) | 20) & 0xFu; }
#define XB_SPIN(cond, bar) do { unsigned _sp = 0; while (cond) { __builtin_amdgcn_s_sleep(1); \
    if ((++_sp & 255u) == 0u) { if (xb_ld(&(bar)[XB_TMO])) break; if (_sp > XB_SPIN_CAP) { atomicAdd(&(bar)[XB_TMO], 1u); break; } } } } while (0)
struct XcdBarrier { unsigned* bar; unsigned x; volatile LAS unsigned* st; };
__device__ __forceinline__ XcdBarrier xcd_barrier_post(unsigned* bar, volatile LAS unsigned* st) {
    XcdBarrier b; b.bar = bar; b.x = xb_xcc_id(); b.st = st;
    if (threadIdx.x == 0) (void)xb_add(&bar[XB_XCNT(b.x)], 1u);
    return b;
}
__device__ __forceinline__ void xcd_barrier_complete(unsigned* bar, unsigned x, unsigned& nloc, unsigned& nx) {
    const unsigned G = gridDim.x * gridDim.y * gridDim.z;
    unsigned sum, cnt, mine, sp = 0u;
    for (;;) {
        sum = 0u; cnt = 0u; mine = 0u;
#pragma unroll 1
        for (unsigned j = 0; j < 16; ++j) { const unsigned c = xb_ld(&bar[XB_XCNT(j)]); sum += c; cnt += (c > 0u) ? 1u : 0u; mine = (j == x) ? c : mine; }
        if (sum == G) break;
        __builtin_amdgcn_s_sleep(1);
        if ((++sp & 255u) == 0u) { if (xb_ld(&bar[XB_TMO])) break; if (sp > XB_SPIN_CAP) { atomicAdd(&bar[XB_TMO], 1u); break; } }
    }
    nloc = mine > 0u ? mine : 1u; nx = cnt > 0u ? cnt : 1u;
}
__device__ __forceinline__ void xcd_barrier(const XcdBarrier& b) {
    asm volatile("s_waitcnt vmcnt(0)" ::: "memory");
    __syncthreads();
    if (threadIdx.x == 0) {
        unsigned* bar = b.bar;
        __builtin_amdgcn_s_waitcnt(0);
        unsigned nloc = b.st[0], nx = b.st[1];
        if (nloc == 0u) { xcd_barrier_complete(bar, b.x, nloc, nx); b.st[0] = nloc; b.st[1] = nx; }
        const unsigned old = xb_add(&bar[XB_XSUB(b.x)], 1u);
        const unsigned gen = old / nloc;
        if (old + 1u == (gen + 1u) * nloc) {
            __builtin_amdgcn_fence(__ATOMIC_RELEASE, "agent");
            asm volatile("s_waitcnt vmcnt(0)" ::: "memory");
            const unsigned og = xb_add(&bar[XB_TOP], 1u);
            const unsigned tg = og / nx;
            if (og + 1u == (tg + 1u) * nx) xb_add(&bar[XB_TOPGEN], 1u);
            else XB_SPIN(xb_ld(&bar[XB_TOPGEN]) == tg, bar);
            __builtin_amdgcn_fence(__ATOMIC_ACQUIRE, "agent");
            xb_add(&bar[XB_XGEN(b.x)], 1u);
            asm volatile("s_waitcnt vmcnt(0)" ::: "memory");
        } else {
            XB_SPIN(xb_ld(&bar[XB_XGEN(b.x)]) == gen, bar);
            __builtin_amdgcn_fence(__ATOMIC_ACQUIRE, "agent");
            asm volatile("s_waitcnt vmcnt(0)" ::: "memory");
        }
    }
    __syncthreads();
}

struct Args {
    const float* in[24]; float* out; unsigned char* ws; int ph_lo, ph_hi;
};
struct Ctx {
    LAS unsigned char* lds;
    int tid, lane, wave, vcu, G;
    const Args* a;
};
__device__ __forceinline__ Ctx launder(const Ctx& C) {
    Ctx P = C; int t = C.tid; asm volatile("" : "+v"(t)); P.tid = t; P.lane = t & 63; P.wave = __builtin_amdgcn_readfirstlane(t >> 6);
    int v = C.vcu, g = C.G; asm volatile("" : "+s"(v), "+s"(g)); P.vcu = v; P.G = g;
    unsigned lo = (unsigned)(uintptr_t)C.lds; asm volatile("" : "+s"(lo)); P.lds = (LAS unsigned char*)(uintptr_t)lo;
    return P;
}
enum { I_X = 0, I_C, I_WADA, I_BADA, I_NMIX, I_NFFN, I_NFIN, I_RELB, I_EWIN, I_ELAM, I_ESUBLN, I_EGK2, I_EBGK, I_EGLAN, I_EWOUT, I_OWIN, I_OWOUT,
       I_RGW, I_RGB, I_REW, I_REB, I_WG, I_WU, I_WDN };

__device__ __forceinline__ float wave_sum(float v) {
#pragma unroll
    for (int o = 1; o < 64; o <<= 1) v += __shfl_xor(v, o);
    return v;
}
template <int CTRL> __device__ __forceinline__ float dpp_mov(float v) { return __builtin_bit_cast(float, __builtin_amdgcn_update_dpp(0, __builtin_bit_cast(int, v), CTRL, 0xf, 0xf, true)); }
__device__ __forceinline__ float sum8_dpp(float v) { v += dpp_mov<0xB1>(v); v += dpp_mov<0x4E>(v); v += dpp_mov<0x141>(v); return v; }
__device__ __forceinline__ float sum16_dpp(float v) { v = sum8_dpp(v); v += dpp_mov<0x140>(v); return v; }

__device__ __forceinline__ float reduce4(const float (&v)[4], int) {
    float a0 = v[0], a2 = v[2], a1 = v[1], a3 = v[3];
    swap32(a0, a2); swap32(a1, a3);
    float A0 = a0 + a2, A1 = a1 + a3;
    swap16(A0, A1);
    const float c = A0 + A1;
    return sum16_dpp(c);
}

__device__ __forceinline__ void transpose_item(const float* W, int ldw, int K, bf16* WT, size_t drow0, LAS float* scr, int k0, int n0, int lane) {
#pragma unroll 8
    for (int i = 0; i < 32; ++i) { const int kk = 2 * i + (lane >> 5); scr[kk * 33 + (lane & 31)] = W[(size_t)(k0 + kk) * ldw + n0 + (lane & 31)]; }
    LDS_WAIT(); asm volatile("" ::: "memory");
    const int c = lane & 7;
#pragma unroll
    for (int j = 0; j < 4; ++j) { const int n = (lane >> 3) + 8 * j; const LAS float* s = scr + (8 * c) * 33 + n;
        u32x4 o; o.x = pk2(s[0 * 33], s[1 * 33]); o.y = pk2(s[2 * 33], s[3 * 33]); o.z = pk2(s[4 * 33], s[5 * 33]); o.w = pk2(s[6 * 33], s[7 * 33]);
        *(u32x4*)(WT + (drow0 + n) * K + k0 + 8 * c) = o; }
    LDS_WAIT(); asm volatile("" ::: "memory");
}
__device__ __forceinline__ void transpose_item8w(const float* W, int ldw, int K, unsigned char* WT8, size_t drow0, LAS float* scr, int k0, int n0, int lane) {
#pragma unroll 16
    for (int i = 0; i < 64; ++i) { const int kk = 2 * i + (lane >> 5); scr[kk * 33 + (lane & 31)] = __builtin_nontemporal_load(W + (size_t)(k0 + kk) * ldw + n0 + (lane & 31)); }
    LDS_WAIT(); asm volatile("" ::: "memory");
    const int n = lane & 31, kh = lane >> 5;
    unsigned char* op = WT8 + (drow0 + n) * K + k0 + 64 * kh;
#pragma unroll
    for (int q = 0; q < 4; ++q) { u32x4 o;
#pragma unroll
        for (int w = 0; w < 4; ++w) { const LAS float* p = scr + (64 * kh + 16 * q + 4 * w) * 33 + n; o[w] = pk4_fp8(p[0] * F8_W_SCALE, p[33] * F8_W_SCALE, p[66] * F8_W_SCALE, p[99] * F8_W_SCALE); }
        *(u32x4*)(op + 16 * q) = o; }
    LDS_WAIT(); asm volatile("" ::: "memory");
}
__device__ __forceinline__ void transpose_item8(const float* W, int ldw, int K, unsigned char* WT8, size_t drow0, LAS float* scr, int k0, int n0, int lane) {
#pragma unroll 8
    for (int i = 0; i < 32; ++i) { const int kk = 2 * i + (lane >> 5); scr[kk * 33 + (lane & 31)] = W[(size_t)(k0 + kk) * ldw + n0 + (lane & 31)]; }
    LDS_WAIT(); asm volatile("" ::: "memory");
    const int c = lane & 7;
#pragma unroll
    for (int j = 0; j < 4; ++j) { const int n = (lane >> 3) + 8 * j; const LAS float* s = scr + (8 * c) * 33 + n;
        u32x2 o; o.x = pk4_fp8(s[0 * 33] * F8_W_SCALE, s[1 * 33] * F8_W_SCALE, s[2 * 33] * F8_W_SCALE, s[3 * 33] * F8_W_SCALE); o.y = pk4_fp8(s[4 * 33] * F8_W_SCALE, s[5 * 33] * F8_W_SCALE, s[6 * 33] * F8_W_SCALE, s[7 * 33] * F8_W_SCALE);
        *(u32x2*)(WT8 + (drow0 + n) * K + k0 + 8 * c) = o; }
    LDS_WAIT(); asm volatile("" ::: "memory");
}
__device__ __forceinline__ void p0_prologue(const Ctx& C) {
    LAS float* sc = (LAS float*)(C.lds);
    LAS float* part = (LAS float*)(C.lds + 32768);
    for (int i = C.tid; i < 8192; i += 512) { const float cv = C.a->in[I_C][i]; sc[i] = cv / (1.f + __expf(-cv)); }
    __syncthreads();
    for (int it = blockIdx.x; it < 384; it += C.G) {
        const int l = it / 96, e0 = (it % 96) * 64;
        float acc[8];
#pragma unroll
        for (int b = 0; b < 8; ++b) acc[b] = 0.f;
        const float* wp = C.a->in[I_WADA] + ((size_t)l * 1024 + C.wave * 128) * 6144 + e0 + C.lane;
#pragma unroll 16
        for (int dd = 0; dd < 128; ++dd) { const float w = __builtin_nontemporal_load(wp + (size_t)dd * 6144);
#pragma unroll
            for (int b = 0; b < 8; ++b) acc[b] += sc[b * 1024 + C.wave * 128 + dd] * w; }
#pragma unroll
        for (int b = 0; b < 8; ++b) part[(C.wave * 8 + b) * 64 + C.lane] = acc[b];
        __syncthreads();
        { const int b = C.tid >> 6, col = C.tid & 63; float s = C.a->in[I_BADA][l * 6144 + e0 + col];
#pragma unroll
          for (int w = 0; w < 8; ++w) s += part[(w * 8 + b) * 64 + col];
          ((float*)(C.a->ws + WS_MOD))[((size_t)l * 8 + b) * 6144 + e0 + col] = s; }
        __syncthreads();
    }
    const int gt = blockIdx.x * 512 + C.tid, NGT = C.G * 512;
    for (int i = gt; i < 4 * 36 * 1024; i += NGT) { const int l = i / (36 * 1024), jj = (i >> 10) % 36, d = i & 1023;
        const float v = jj < 4 ? C.a->in[I_RGW][((size_t)l * 1024 + d) * 4 + jj] : C.a->in[I_REW][((size_t)l * 1024 + d) * 32 + (jj - 4)];
        ((bf16*)(C.a->ws + WS_WR))[i] = (bf16)f2bf(v); }
    for (int i = gt; i < 2 * 16 * 1024; i += NGT) { const int ii = i >> 14, r = (i >> 10) & 15, d = i & 1023;
        ((bf16*)(C.a->ws + WS_WBG))[i] = (bf16)f2bf(C.a->in[I_EWIN][((size_t)ii * 1024 + d) * 3088 + 3072 + r]); }
    for (int i = gt; i < 256; i += NGT) ((unsigned*)(C.a->ws + WS_H8 + (size_t)NTOK * DM))[i] = 0u;
    LAS float* scr = (LAS float*)(C.lds + C.wave * 16896);
    const int gw = C.vcu * 8 + C.wave, NGW = C.G * 8;
    constexpr int I_IN = 16 * 96, I_OUT = 16 * 16, I_E = 128;
    constexpr int NITEMS = 4 * I_IN + 4 * I_OUT + 3 * 128 * I_E;
    for (int it = gw; it < NITEMS; it += NGW) {
        int r = it;
        if (r < 4 * I_IN) { const int l = r / I_IN, q = r % I_IN, kb = q / 96, nb = q % 96; const int i = l >> 1;
            const float* W = (l & 1) ? C.a->in[I_OWIN] + (size_t)i * 1024 * 3072 : C.a->in[I_EWIN] + (size_t)i * 1024 * 3088;
            transpose_item(W, (l & 1) ? 3072 : 3088, 1024, ((bf16*)(C.a->ws + WS_WIN)) + (size_t)l * 3072 * 1024, (size_t)nb * 32, scr, kb * 64, nb * 32, C.lane); continue; }
        r -= 4 * I_IN;
        if (r < 4 * I_OUT) { const int l = r / I_OUT, q = r % I_OUT, kb = q / 32, nb = q % 32; const int i = l >> 1;
            const float* W = ((l & 1) ? C.a->in[I_OWOUT] : C.a->in[I_EWOUT]) + (size_t)i * 1024 * 1024;
            transpose_item8w(W, 1024, 1024, (unsigned char*)(C.a->ws + WS_WOUT) + (size_t)l * 1024 * 1024, (size_t)nb * 32, scr, kb * 128, nb * 32, C.lane); continue; }
        r -= 4 * I_OUT;
        const int job = r / I_E, q = r % I_E, typ = job / 128, le = job % 128;
        if (typ < 2) { const int kb = q / 16, nb = q % 16, n0 = nb * 32;
            const float* W = C.a->in[typ == 0 ? I_WG : I_WU] + (size_t)le * 1024 * 512;
            const size_t drow0 = (size_t)(n0 >> 7) * 256 + (n0 & 127) + (typ ? 128 : 0);
            transpose_item8w(W, 512, 1024, ((unsigned char*)(C.a->ws + WS_WGU)) + (size_t)le * 1024 * 1024, drow0, scr, kb * 128, n0, C.lane);
        } else { const int kb = q / 32, nb = q % 32;
            const float* W = C.a->in[I_WDN] + (size_t)le * 512 * 1024;
            transpose_item8w(W, 1024, 512, ((unsigned char*)(C.a->ws + WS_WD)) + (size_t)le * 1024 * 512, (size_t)nb * 32, scr, kb * 128, nb * 32, C.lane); }
    }
}

template <bool COMBINE, int EXTRA, bool FINAL, bool XIN_F32>
__device__ __forceinline__ void norm_phase(const Ctx& C, int l, const float* xin, const float* normw, int shift_chunk, const bf16* WX) {
    constexpr int NX = EXTRA == 1 ? 16 : (EXTRA == 2 ? 36 : 0);
    constexpr int NR = 4;
    constexpr int NCB = (NX + 15) / 16;
    constexpr int WPITCH = 2064;
    LAS unsigned char* wl = C.lds;
    LAS unsigned char* atile = C.lds + 99072 + C.wave * 4160;
    LAS float* lgbase = (LAS float*)(C.lds + 99072 + 8 * 4160);
    LAS int* ent_p = (LAS int*)(C.lds + 99072 + 8 * 4160 + 8 * 768);
    LAS int* ent_e = ent_p + 256;
    LAS float* ent_w = (LAS float*)(ent_e + 256);
    LAS int* lcnt = (LAS int*)(ent_w + 256);
    LAS int* lbase = lcnt + 32;
    LAS int* erank = lbase + 32;
    if (EXTRA) { for (int i = C.tid; i < NCB * 16 * 128; i += 512) { const int row = i >> 7, c16 = i & 127;
            *(LAS u32x4*)(wl + row * WPITCH + c16 * 16) = row < NX ? ((const u32x4*)WX)[i] : (u32x4){0u, 0u, 0u, 0u}; }
        if (EXTRA == 2) { if (C.tid < 32) lcnt[C.tid] = 0; }
        __syncthreads(); }
    const int gw = C.vcu * 8 + C.wave, NGW = C.G * 8, lane = C.lane;
    float* X = C.a->out; bf16* XBp = (bf16*)(C.a->ws + WS_XB); bf16* Hb = (bf16*)(C.a->ws + WS_H); const bf16* Yb = (const bf16*)(C.a->ws + WS_QKV); const float* MOD = (const float*)(C.a->ws + WS_MOD);
    int pass = 0;
    for (int rg = gw; rg < NTOK / NR; rg += NGW, ++pass) {
        const int t0 = rg * NR, b = t0 >> 12;
        f32x4 v[NR][4];
#pragma unroll
        for (int r = 0; r < NR; ++r)
#pragma unroll
            for (int j = 0; j < 4; ++j) {
                if (XIN_F32) v[r][j] = *(const f32x4*)(xin + (size_t)(t0 + r) * DM + 4 * lane + 256 * j);
                else { const u32x2 xr = *(const u32x2*)(XBp + (size_t)(t0 + r) * DM + 4 * lane + 256 * j); v[r][j] = (f32x4){bflo(xr.x), bfhi(xr.x), bflo(xr.y), bfhi(xr.y)}; } }
        if (COMBINE) {
            const float* g2p = MOD + ((size_t)((FINAL ? 3 : l - 1) * 8 + b)) * 6144 + 5 * 1024;
            int y0[NR][4], y1[NR][4]; f32x4 g2[4];
#pragma unroll
            for (int j = 0; j < 4; ++j) { g2[j] = *(const f32x4*)(g2p + 4 * lane + 256 * j);
#pragma unroll
                for (int r = 0; r < NR; ++r) { y0[r][j] = *(const int*)((const unsigned char*)Yb + (size_t)(2 * (t0 + r)) * DM + 4 * lane + 256 * j);
                    y1[r][j] = *(const int*)((const unsigned char*)Yb + (size_t)(2 * (t0 + r) + 1) * DM + 4 * lane + 256 * j); } }
#pragma unroll
            for (int j = 0; j < 4; ++j)
#pragma unroll
                for (int r = 0; r < NR; ++r) {
                    const f32x2 a0 = __builtin_amdgcn_cvt_pk_f32_fp8(y0[r][j], false), a1 = __builtin_amdgcn_cvt_pk_f32_fp8(y0[r][j], true), b0 = __builtin_amdgcn_cvt_pk_f32_fp8(y1[r][j], false), b1 = __builtin_amdgcn_cvt_pk_f32_fp8(y1[r][j], true);
                    f32x4 ys; ys[0] = (a0[0] + b0[0]) * (1.f / 32.f); ys[1] = (a0[1] + b0[1]) * (1.f / 32.f); ys[2] = (a1[0] + b1[0]) * (1.f / 32.f); ys[3] = (a1[1] + b1[1]) * (1.f / 32.f);
                    v[r][j] = v[r][j] + g2[j] * ys; }
            if (!FINAL) {
#pragma unroll
                for (int j = 0; j < 4; ++j)
#pragma unroll
                    for (int r = 0; r < NR; ++r) { u32x2 xo; xo.x = cvt_pk_bf16(v[r][j][0], v[r][j][1]); xo.y = cvt_pk_bf16(v[r][j][2], v[r][j][3]); *(u32x2*)(XBp + (size_t)(t0 + r) * DM + 4 * lane + 256 * j) = xo; } }
        }
        float ss[NR];
#pragma unroll
        for (int r = 0; r < NR; ++r) { float s_ = 0.f;
#pragma unroll
            for (int j = 0; j < 4; ++j) s_ += (v[r][j][0] * v[r][j][0] + v[r][j][1] * v[r][j][1]) + (v[r][j][2] * v[r][j][2] + v[r][j][3] * v[r][j][3]);
            ss[r] = s_; }
        const float red = reduce4(ss, lane);
        const float rstd_l = 1.0f / sqrtf(red * (1.f / DM) + EPS);
        float rs[NR];
#pragma unroll
        for (int r = 0; r < NR; ++r) rs[r] = __builtin_bit_cast(float, __builtin_amdgcn_readlane(__builtin_bit_cast(int, rstd_l), 16 * r));
        if (FINAL) {
#pragma unroll
            for (int j = 0; j < 4; ++j) { const f32x4 gn = *(const f32x4*)(normw + 4 * lane + 256 * j);
#pragma unroll
                for (int r = 0; r < NR; ++r) v[r][j] = v[r][j] * rs[r] * gn; }
#pragma unroll
            for (int j = 0; j < 4; ++j)
#pragma unroll
                for (int r = 0; r < NR; ++r) *(f32x4*)(X + (size_t)(t0 + r) * DM + 4 * lane + 256 * j) = v[r][j];
            continue;
        }
        u32x2 hp[NR][4];
        const float* mp = MOD + ((size_t)(l * 8 + b)) * 6144 + (size_t)shift_chunk * 1024;
#pragma unroll
        for (int j = 0; j < 4; ++j) { const f32x4 sh = *(const f32x4*)(mp + 4 * lane + 256 * j), scl = *(const f32x4*)(mp + 1024 + 4 * lane + 256 * j);
            const f32x4 gn = *(const f32x4*)(normw + (size_t)l * DM + 4 * lane + 256 * j); const f32x4 cmb = gn * (scl + 1.0f);
#pragma unroll
            for (int r = 0; r < NR; ++r) v[r][j] = v[r][j] * rs[r] * cmb + sh; }
#pragma unroll
        for (int j = 0; j < 4; ++j) {
#pragma unroll
            for (int r = 0; r < NR; ++r) {
                u32x2 o; o.x = cvt_pk_bf16(v[r][j][0], v[r][j][1]); o.y = cvt_pk_bf16(v[r][j][2], v[r][j][3]); hp[r][j] = o;
                if (EXTRA == 2) *(unsigned*)(C.a->ws + WS_H8 + (size_t)(t0 + r) * DM + 4 * lane + 256 * j) = pk4_fp8(v[r][j][0] * F8_ACT_SCALE, v[r][j][1] * F8_ACT_SCALE, v[r][j][2] * F8_ACT_SCALE, v[r][j][3] * F8_ACT_SCALE);
                else *(u32x2*)(Hb + (size_t)(t0 + r) * DM + 4 * lane + 256 * j) = o; } }
        if (EXTRA) {
            LAS float* lgb = lgbase + C.wave * (NR * 48);
            const int l15 = lane & 15, quad = lane >> 4;
            f32x4 lacc[NCB > 0 ? NCB : 1];
#pragma unroll
            for (int cb = 0; cb < NCB; ++cb) lacc[cb] = (f32x4){0.f, 0.f, 0.f, 0.f};
#pragma unroll
            for (int half = 0; half < 2; ++half) {
#pragma unroll
                for (int r = 0; r < NR; ++r)
#pragma unroll
                    for (int jl = 0; jl < 2; ++jl) *(LAS u32x2*)(atile + r * 1040 + (4 * lane + 256 * jl) * 2) = hp[r][2 * half + jl];
                LDS_WAIT();
#pragma unroll 4
                for (int ks = 0; ks < 16; ++ks) { const bf16x8 af = *(const LAS bf16x8*)(atile + (l15 & 3) * 1040 + (8 * quad + 32 * ks) * 2);
#pragma unroll
                    for (int cb = 0; cb < NCB; ++cb) { const bf16x8 bfv = *(const LAS bf16x8*)(wl + (16 * cb + l15) * WPITCH + (512 * half + 8 * quad + 32 * ks) * 2);
                        lacc[cb] = __builtin_amdgcn_mfma_f32_16x16x32_bf16(af, bfv, lacc[cb], 0, 0, 0); } }
                LDS_WAIT();
            }
            if (quad == 0) {
#pragma unroll
                for (int cb = 0; cb < NCB; ++cb)
#pragma unroll
                    for (int jj = 0; jj < 4; ++jj) lgb[jj * 48 + 16 * cb + l15] = lacc[cb][jj]; }
            LDS_WAIT();
            float lg[NX > 0 ? NX : 1];
#pragma unroll
            for (int jj = 0; jj < NX; ++jj) lg[jj] = lgb[(lane >> 4) * 48 + jj];
            const int row = lane >> 4, tok = t0 + row;
            if (EXTRA == 1) {
                if ((lane & 15) == 0) { float* BGp = (float*)(C.a->ws + WS_BG);
#pragma unroll
                    for (int q = 0; q < 4; ++q) *(f32x4*)(BGp + (size_t)tok * 16 + 4 * q) = (f32x4){lg[4 * q], lg[4 * q + 1], lg[4 * q + 2], lg[4 * q + 3]}; }
            } else {
                float gl[4];
#pragma unroll
                for (int q = 0; q < 4; ++q) gl[q] = lg[q] + C.a->in[I_RGB][l * 4 + q];
                int gs = 0; float gm = gl[0];
#pragma unroll
                for (int q = 1; q < 4; ++q) if (gl[q] > gm) { gm = gl[q]; gs = q; }
                float gsum = 0.f;
#pragma unroll
                for (int q = 0; q < 4; ++q) gsum += __expf(gl[q] - gm);
                const float gval = 1.0f / gsum;
                float el[8];
#pragma unroll
                for (int q = 0; q < 8; ++q) { const float e0 = lg[4 + q], e1 = lg[12 + q], e2 = lg[20 + q], e3 = lg[28 + q];
                    el[q] = (gs == 0 ? e0 : (gs == 1 ? e1 : (gs == 2 ? e2 : e3))) + C.a->in[I_REB][l * 32 + gs * 8 + q]; }
                int i0 = 0; float m0 = el[0];
#pragma unroll
                for (int q = 1; q < 8; ++q) if (el[q] > m0) { m0 = el[q]; i0 = q; }
                int i1 = -1; float m1 = -3.0e38f;
#pragma unroll
                for (int q = 0; q < 8; ++q) if (q != i0 && el[q] > m1) { m1 = el[q]; i1 = q; }
                const float w0 = gval / (1.0f + __expf(m1 - m0)), w1 = gval - w0;
                if ((lane & 15) == 0) { const int ei = (pass * 8 + C.wave) * 8 + row * 2;
                    ent_p[ei] = tok * 2; ent_e[ei] = gs * 8 + i0; ent_w[ei] = w0;
                    ent_p[ei + 1] = tok * 2 + 1; ent_e[ei + 1] = gs * 8 + i1; ent_w[ei + 1] = w1; }
            }
        }
    }
    if (EXTRA == 2) {
        __syncthreads();
        const int npass_blk = (NTOK / NR - C.vcu * 8 + NGW - 1) / NGW;
        const int nent = npass_blk * 64;
        int* gcnt = (int*)(C.a->ws + WS_CTL) + CW_CNT + 64 * l;
        int* PL = (int*)(C.a->ws + WS_PLIST); float* WL = (float*)(C.a->ws + WS_WLIST);
        for (int i = C.tid; i < nent; i += 512) { const int p_ = i >> 6, w_ = (i >> 3) & 7; const bool valid = (C.vcu * 8 + w_ + p_ * NGW) < NTOK / NR;
            if (valid) erank[i] = atomicAdd((int*)&lcnt[ent_e[i]], 1); else erank[i] = -1; }
        __syncthreads();
        if (C.tid < 32) lbase[C.tid] = __hip_atomic_fetch_add(gcnt + C.tid, lcnt[C.tid], __ATOMIC_RELAXED, __HIP_MEMORY_SCOPE_AGENT);
        __syncthreads();
        for (int i = C.tid; i < nent; i += 512) { const int rk = erank[i]; if (rk >= 0) { const int e = ent_e[i]; const int pos = lbase[e] + rk;
            PL[(size_t)e * NTOK + pos] = ent_p[i]; WL[(size_t)e * NTOK + pos] = ent_w[i]; } }
    }
    __syncthreads();
}

typedef short v4i16_t __attribute__((ext_vector_type(4)));
__device__ __forceinline__ s16x4 vtr(const LAS unsigned char* p) { return __builtin_bit_cast(s16x4, __builtin_amdgcn_ds_read_tr16_b64_v4i16((LAS v4i16_t*)p)); }
__device__ __forceinline__ float pl32_other(float m, int hi) { float a = m, b = m; swap32(a, b); return hi ? a : b; }
__device__ __forceinline__ float pl32_max(float m) { float a = m, b = m; swap32(a, b); return fmaxf(a, b); }
__device__ __forceinline__ float pl32_sum(float m) { float a = m, b = m; swap32(a, b); return a + b; }
__device__ __forceinline__ int t5_bucket(int rel) { const int n = rel < 0 ? -rel : rel;
    const int bk = n < 8 ? n : (n < 12 ? 8 : (n < 16 ? 9 : (n < 23 ? 10 : (n < 32 ? 11 : (n < 46 ? 12 : (n < 64 ? 13 : (n < 91 ? 14 : 15)))))));
    return bk + (rel > 0 ? 16 : 0); }

__device__ __forceinline__ int kswz(int row, int c) { return row * 128 + ((c ^ ((row >> 1) & 7)) << 4); }

__device__ __forceinline__ void diffattn_unit(const Ctx& C, int l, int b, int h, int qb, float lam, float lam_init) {
    LAS unsigned char* lds = C.lds;
    const int tid = C.tid, lane = C.lane, wave = C.wave, r32 = lane & 31, hi = lane >> 5, qt = wave & 3, m = wave >> 2;
    const int i16 = lane & 15, q4 = i16 >> 2, p4 = i16 & 3, half16 = (lane >> 4) & 1;
    const size_t tokbase = (size_t)b * SEQ; const int q0 = qb * 128, c0 = q0 >> 6, ntile = c0 + 2, cw = c0 + (qt >> 1);
    LAS float* lut = (LAS float*)(lds + 131072);
    const float rb15 = C.a->in[I_RELB][15 * 4 + h], rbt = C.a->in[I_RELB][t5_bucket((tid < 255 ? tid : 254) - 191) * 4 + h];
    const float b15 = rb15 * LOG2E;
    if (tid < 255) lut[tid] = rbt * LOG2E - b15;
    const bf16* qp = ((bf16*)(C.a->ws + WS_QKV)) + (tokbase + q0 + 32 * qt + r32) * QKVW + E_AQ + h * 128 + m * 64 + 8 * hi;
    bf16x8 qr[4];
#pragma unroll
    for (int d0 = 0; d0 < 4; ++d0) qr[d0] = *(const bf16x8*)(qp + 16 * d0);
    unsigned koff[2], voff[2];
#pragma unroll
    for (int i = 0; i < 2; ++i) { const int p = wave * 128 + i * 64 + lane;
        { const int mm = p >> 9, pp = p & 511, row = pp >> 3, pc = pp & 7, c = pc ^ ((row >> 1) & 7); koff[i] = (unsigned)((row * QKVW + E_AK + h * 128 + mm * 64 + c * 8) * 2); }
        { const int blk = p >> 8, row = (p >> 2) & 63, c4 = p & 3; voff[i] = (unsigned)((row * QKVW + E_AV + h * 128 + blk * 32 + c4 * 8) * 2); } }
    const unsigned ldsb = (unsigned)__builtin_amdgcn_readfirstlane((int)(unsigned)(uintptr_t)lds) + (unsigned)wave * 2048u;
    const char* tilebase = (const char*)(C.a->ws + WS_QKV) + tokbase * (size_t)(QKVW * 2);
#define DA_DMA(j, bi) do { const char* tb_ = tilebase + (size_t)(j) * (64 * QKVW * 2); const unsigned db_ = ldsb + (unsigned)(bi) * 32768u; \
        pg8::glds_s(tb_, koff[0], db_); pg8::glds_s(tb_, koff[1], db_ + 1024u); pg8::glds_s(tb_, voff[0], db_ + 16384u); pg8::glds_s(tb_, voff[1], db_ + 16384u + 1024u); } while (0)
    f32x16 o[4];
#pragma unroll
    for (int k = 0; k < 4; ++k)
#pragma unroll
        for (int i = 0; i < 16; ++i) o[k][i] = 0.f;
    float lsum = 0.f;
    f32x16 negm;
#pragma unroll
    for (int i = 0; i < 16; ++i) negm[i] = b15;
    __syncthreads();
    DA_DMA(0, 0); DA_DMA(1, 1);
    asm volatile("s_waitcnt vmcnt(4)" ::: "memory");
    __builtin_amdgcn_s_barrier(); asm volatile("" ::: "memory");
#define DA_LDV(vb_, s) do { _Pragma("unroll") for (int k = 0; k < 4; ++k) { va[s][k][0] = vtr((vb_) + k * 4096 + (s) * 1024); va[s][k][1] = vtr((vb_) + k * 4096 + (s) * 1024 + 512); } } while (0)
#define DA_PVS(s) do { const bf16x8 pf = __builtin_bit_cast(bf16x8, pwh[s]); _Pragma("unroll") for (int k = 0; k < 4; ++k) { const s16x4 lo = va[s][k][0], hh = va[s][k][1]; \
                const bf16x8 vf = (bf16x8){lo[0], lo[1], lo[2], lo[3], hh[0], hh[1], hh[2], hh[3]}; o[k] = __builtin_amdgcn_mfma_f32_32x32x16_bf16(vf, pf, o[k], 0, 0, 0); } } while (0)
#define DA_PV(vb_) do { s16x4 va[4][4][2]; DA_LDV(vb_, 0); DA_LDV(vb_, 1); __builtin_amdgcn_sched_barrier(0); \
        DA_PVS(0); DA_LDV(vb_, 2); __builtin_amdgcn_sched_barrier(0); DA_PVS(1); DA_LDV(vb_, 3); __builtin_amdgcn_sched_barrier(0); DA_PVS(2); DA_PVS(3); } while (0)
    u32x4 pwh[4]; int pbi = -1;
#pragma unroll
    for (int s = 0; s < 4; ++s) pwh[s] = (u32x4){0u, 0u, 0u, 0u};
    for (int j = 0; j < ntile; ++j) {
        const int bi = j & 3;
        if (j + 2 < ntile) { DA_DMA(j + 2, (j + 2) & 3); }
        if (pbi >= 0) {
            const LAS unsigned char* vp = lds + pbi * 32768 + 16384 + half16 * 32 + p4 * 8 + (4 * hi + q4) * 64;
            DA_PV(vp); pbi = -1; }
        if (j <= cw) {
            const LAS unsigned char* kb = lds + bi * 32768 + m * 8192;
            bf16x8 ka[4][2];
#pragma unroll
            for (int d0 = 0; d0 < 4; ++d0) { const int c = 2 * d0 + hi; ka[d0][0] = *(const LAS bf16x8*)(kb + kswz(r32, c)); ka[d0][1] = *(const LAS bf16x8*)(kb + kswz(32 + r32, c)); }
            __builtin_amdgcn_sched_barrier(0);
            f32x16 s0 = negm, s1 = negm;
#pragma unroll
            for (int d0 = 0; d0 < 4; ++d0) {
                s0 = __builtin_amdgcn_mfma_f32_32x32x16_bf16(ka[d0][0], qr[d0], s0, 0, 0, 0); s1 = __builtin_amdgcn_mfma_f32_32x32x16_bf16(ka[d0][1], qr[d0], s1, 0, 0, 0); }
            if (j + 2 >= cw) { const int base = 64 * j - (q0 + 32 * qt + r32) + 191;
#pragma unroll
                for (int i = 0; i < 16; ++i) { const int kv = crow(i, hi); s0[i] += lut[base + kv]; s1[i] += lut[base + kv + 32]; } }
            float tm = fmaxf(fmaxf(s0[0], s0[1]), s1[0]);
#pragma unroll
            for (int i = 1; i < 16; ++i) tm = fmaxf(fmaxf(tm, s0[i]), s1[i]);
            tm = fmaxf(tm, s0[1]);
            tm = pl32_max(tm);
            if (__any(tm > 8.f) || j == 0) { const float dl = (j == 0) ? tm : fmaxf(tm, 0.f); const float f = ex2(-dl);
                lsum *= f;
#pragma unroll
                for (int k = 0; k < 4; ++k)
#pragma unroll
                    for (int i = 0; i < 16; ++i) o[k][i] *= f;
#pragma unroll
                for (int i = 0; i < 16; ++i) { s0[i] -= dl; s1[i] -= dl; negm[i] -= dl; } }
            float ps = 0.f;
#pragma unroll
            for (int i = 0; i < 16; ++i) { s0[i] = ex2(s0[i]); s1[i] = ex2(s1[i]); ps += s0[i] + s1[i]; }
            lsum += ps;
#pragma unroll
            for (int s = 0; s < 2; ++s) {
                pwh[s].x = cvt_pk_bf16(s0[8 * s + 0], s0[8 * s + 1]); pwh[s].y = cvt_pk_bf16(s0[8 * s + 2], s0[8 * s + 3]); pwh[s].z = cvt_pk_bf16(s0[8 * s + 4], s0[8 * s + 5]); pwh[s].w = cvt_pk_bf16(s0[8 * s + 6], s0[8 * s + 7]);
                pwh[2 + s].x = cvt_pk_bf16(s1[8 * s + 0], s1[8 * s + 1]); pwh[2 + s].y = cvt_pk_bf16(s1[8 * s + 2], s1[8 * s + 3]); pwh[2 + s].z = cvt_pk_bf16(s1[8 * s + 4], s1[8 * s + 5]); pwh[2 + s].w = cvt_pk_bf16(s1[8 * s + 6], s1[8 * s + 7]); }
            if (m == 0) { const LAS unsigned char* vb = lds + bi * 32768 + 16384 + half16 * 32 + p4 * 8 + (4 * hi + q4) * 64; DA_PV(vb); }
            else pbi = bi;
        }
        if (j + 2 < ntile) asm volatile("s_waitcnt vmcnt(4) lgkmcnt(0)" ::: "memory"); else asm volatile("s_waitcnt vmcnt(0) lgkmcnt(0)" ::: "memory");
        __builtin_amdgcn_s_barrier(); asm volatile("" ::: "memory");
    }
    if (pbi >= 0) { const LAS unsigned char* vp = lds + pbi * 32768 + 16384 + half16 * 32 + p4 * 8 + (4 * hi + q4) * 64; DA_PV(vp); }
    __syncthreads();
#undef DA_LDV
#undef DA_PVS
#undef DA_PV
#undef DA_DMA
    const float linv = 1.0f / pl32_sum(lsum);
    LAS float* ox = (LAS float*)lds + qt * 4096;
    if (m == 1) {
#pragma unroll
        for (int k = 0; k < 4; ++k)
#pragma unroll
            for (int i = 0; i < 16; ++i) ox[(k * 16 + i) * 64 + lane] = o[k][i] * linv;
    }
    __syncthreads();
    if (m == 0) {
        float ssq = 0.f;
#pragma unroll
        for (int k = 0; k < 4; ++k)
#pragma unroll
            for (int i = 0; i < 16; ++i) { const float v = o[k][i] * linv - lam * ox[(k * 16 + i) * 64 + lane]; o[k][i] = v; ssq += v * v; }
        ssq = pl32_sum(ssq);
        const float rstd = (1.0f / sqrtf(ssq * (1.f / 128.f) + EPS)) * (1.0f - lam_init) * F8_ACT_SCALE;
        unsigned char* op = (unsigned char*)(C.a->ws + WS_O) + (tokbase + q0 + 32 * qt + r32) * DM + h * 128;
        const float* sg = C.a->in[I_ESUBLN] + (l >> 1) * 128; unsigned pko[4][4];
#pragma unroll
        for (int k = 0; k < 4; ++k)
#pragma unroll
            for (int g = 0; g < 4; ++g) { const int dv = 32 * k + 8 * g + 4 * hi; const f32x4 gg = *(const f32x4*)(sg + dv);
                pko[k][g] = pk4_fp8(o[k][4 * g] * rstd * gg[0], o[k][4 * g + 1] * rstd * gg[1], o[k][4 * g + 2] * rstd * gg[2], o[k][4 * g + 3] * rstd * gg[3]); }
#pragma unroll
        for (int k = 0; k < 4; ++k)
#pragma unroll
            for (int g = 0; g < 4; ++g) { const int dv = 32 * k + 8 * g + 4 * hi; *(unsigned*)(op + dv) = pko[k][g]; }
    }
    __syncthreads();
}

__device__ __forceinline__ void gla_local_unit(const Ctx& C, int l, int b, int h, int oct) {
    LAS unsigned char* lds = C.lds;
    constexpr int PT = 144;
    constexpr int SET = 46080;
    LAS unsigned char* PP = lds + 2 * SET;
    LAS unsigned char* OUT = PP + 9216;
    LAS float* GT = (LAS float*)(OUT + 18432);
    LAS float* AD = GT + 512;
    LAS float* BGL = AD + 128 + 512;
    const int tid = C.tid, lane = C.lane, wave = C.wave, l15 = lane & 15, quad = lane >> 4;
    const int i = l >> 1; const size_t tokbase = (size_t)b * SEQ; const int cfirst = oct * 8;
    const int d = tid & 63; const int tg = wave;
    const bf16* QKV = (const bf16*)(C.a->ws + WS_QKV); const float* BGg = (const float*)(C.a->ws + WS_BG);
    const size_t item0 = ((size_t)(b * 4 + h)) * 64;
    float w2[16];
#pragma unroll
    for (int r = 0; r < 16; ++r) w2[r] = C.a->in[I_EGK2][((size_t)i * 16 + r) * 256 + h * 64 + d];
    const float bgk = C.a->in[I_EBGK][i * 256 + h * 64 + d];
    const int e0 = 16 * wave;
    const int ot = tid >> 3, oj = tid & 7;
    unsigned short qraw[8], kraw[8]; u32x4 vraw[2]; f32x4 bgreg = (f32x4){0.f, 0.f, 0.f, 0.f};
    float cs[8];
#define GLA_LOAD_QKV(c_) do { const size_t tk0_ = tokbase + 64 * (size_t)(c_); \
        _Pragma("unroll") for (int t = 0; t < 8; ++t) { const size_t tk = tk0_ + 8 * tg + t; qraw[t] = QKV[tk * QKVW + E_BQ + h * 64 + d]; kraw[t] = QKV[tk * QKVW + E_BK + h * 64 + d]; } \
        _Pragma("unroll") for (int ii = 0; ii < 2; ++ii) { const int id = tid + 512 * ii, s_ = id >> 4, c8 = id & 15; vraw[ii] = *(const u32x4*)(QKV + (tk0_ + s_) * QKVW + E_BV + h * 128 + 8 * c8); } } while (0)
#define GLA_LOAD_BG(c_) do { if (tid < 256) bgreg = *(const f32x4*)(BGg + (tokbase + 64 * (size_t)(c_) + (tid >> 2)) * 16 + (tid & 3) * 4); } while (0)
#define GLA_STORE_BG(slot) do { if (tid < 256) *(LAS f32x4*)(BGL + (slot) * 1024 + (tid >> 2) * 16 + (tid & 3) * 4) = bgreg; } while (0)
#define GLA_PREP1(slot) do { float run = 0.f; \
        _Pragma("unroll") for (int t = 0; t < 8; ++t) { const LAS float* bgp = BGL + (slot) * 1024 + (8 * tg + t) * 16; float z = bgk; \
            _Pragma("unroll") for (int q_ = 0; q_ < 4; ++q_) { const f32x4 bv = *(const LAS f32x4*)(bgp + 4 * q_); z += bv[0] * w2[4 * q_] + bv[1] * w2[4 * q_ + 1] + bv[2] * w2[4 * q_ + 2] + bv[3] * w2[4 * q_ + 3]; } \
            const float ls = fminf(z, 0.f) - __logf(1.f + __expf(-fabsf(z))); run += ls * (1.f / 16.f); cs[t] = run; } \
        GT[tg * 64 + d] = run; } while (0)
#define GLA_PREP2(setp, adslot) do { LAS unsigned char* QD_ = (setp); LAS unsigned char* KI_ = (setp) + 9216; LAS unsigned char* KDT_ = (setp) + 18432; LAS unsigned char* VT_ = (setp) + 27648; \
        float pre = 0.f, tot = 0.f; \
        _Pragma("unroll") for (int g = 0; g < 8; ++g) { const float x = GT[g * 64 + d]; tot += x; if (g < tg) pre += x; } \
        float kd[8]; const float etot = __expf(tot); \
        _Pragma("unroll") for (int t = 0; t < 8; ++t) { const float bb = pre + cs[t]; const float qv = bf2f(qraw[t]), kv = bf2f(kraw[t]); \
            const float eb = __expf(bb), ib = __builtin_amdgcn_rcpf(eb); \
            *(LAS unsigned short*)(QD_ + (8 * tg + t) * PT + d * 2) = (unsigned short)cvt1_bf16(qv * eb); \
            *(LAS unsigned short*)(KI_ + (8 * tg + t) * PT + d * 2) = (unsigned short)cvt1_bf16(kv * ib); \
            kd[t] = kv * (etot * ib); } \
        u32x4 kdw; kdw.x = cvt_pk_bf16(kd[0], kd[1]); kdw.y = cvt_pk_bf16(kd[2], kd[3]); kdw.z = cvt_pk_bf16(kd[4], kd[5]); kdw.w = cvt_pk_bf16(kd[6], kd[7]); \
        *(LAS u32x4*)(KDT_ + d * PT + 16 * tg) = kdw; \
        if (tg == 0) AD[(adslot) * 64 + d] = etot; \
        _Pragma("unroll") for (int ii = 0; ii < 2; ++ii) { const int id = tid + 512 * ii, s_ = id >> 4, c8 = id & 15; \
            _Pragma("unroll") for (int jj = 0; jj < 8; ++jj) *(LAS unsigned short*)(VT_ + (8 * c8 + jj) * PT + s_ * 2) = (unsigned short)((vraw[ii][jj >> 1] >> ((jj & 1) * 16)) & 0xffffu); } } while (0)
    f32x4 agg[4];
#pragma unroll
    for (int db = 0; db < 4; ++db) agg[db] = (f32x4){0.f, 0.f, 0.f, 0.f};
    float aprod = 1.f;
    const int clast = cfirst + 7;
    GLA_LOAD_BG(cfirst); GLA_STORE_BG(0); GLA_LOAD_BG(cfirst + 1); GLA_STORE_BG(1);
    GLA_LOAD_QKV(cfirst);
    __syncthreads();
    GLA_PREP1(0);
    __syncthreads();
    GLA_PREP2(lds, 0);
    GLA_LOAD_QKV(cfirst + 1); GLA_LOAD_BG(cfirst + 2);
    __syncthreads();
    for (int cc = 0; cc < 8; ++cc) {
        const int c = cfirst + cc; const size_t item = item0 + c;
        const int cb = cc & 1, nb = cb ^ 1;
        LAS unsigned char* QD = lds + cb * SET; LAS unsigned char* KI = QD + 9216; LAS unsigned char* KDT = QD + 18432; LAS unsigned char* VT = QD + 27648;
        GLA_STORE_BG(cb);
        if (cc + 1 < 8) GLA_PREP1(nb);
        { const int tb = wave >> 1;
#pragma unroll
          for (int sq = 0; sq < 2; ++sq) { const int sb = 2 * (wave & 1) + sq; f32x4 sc = (f32x4){0.f, 0.f, 0.f, 0.f};
              if (sb <= tb) {
#pragma unroll
                  for (int ks = 0; ks < 2; ++ks) { const bf16x8 a = *(const LAS bf16x8*)(QD + (16 * tb + l15) * PT + (8 * quad + 32 * ks) * 2), bb = *(const LAS bf16x8*)(KI + (16 * sb + l15) * PT + (8 * quad + 32 * ks) * 2);
                      sc = __builtin_amdgcn_mfma_f32_16x16x32_bf16(a, bb, sc, 0, 0, 0); } }
#pragma unroll
              for (int jj = 0; jj < 4; ++jj) { const int t = 16 * tb + 4 * quad + jj, s_ = 16 * sb + l15; const float v = (s_ <= t) ? sc[jj] : 0.f;
                  *(LAS unsigned short*)(PP + t * PT + s_ * 2) = (unsigned short)cvt1_bf16(v); } } }
        { const u32x4 qv = *(const LAS u32x4*)(QD + ot * PT + oj * 16); *(u32x4*)((bf16*)(C.a->ws + WS_GQD) + item * 4096 + ot * 64 + oj * 8) = qv;
          if (tid < 64) { const float ad_ = AD[cb * 64 + tid]; ((float*)(C.a->ws + WS_GAD))[item * 64 + tid] = ad_; aprod *= ad_; } }
        LBAR();
        if (cc + 1 < 8) GLA_PREP2(lds + nb * SET, nb);
        bf16x8 vfrag[2], pq_[4][2], kq_[4][2];
#pragma unroll
        for (int ks = 0; ks < 2; ++ks) { vfrag[ks] = *(const LAS bf16x8*)(VT + (e0 + l15) * PT + (8 * quad + 32 * ks) * 2);
#pragma unroll
            for (int tb = 0; tb < 4; ++tb) { pq_[tb][ks] = *(const LAS bf16x8*)(PP + (16 * tb + l15) * PT + (8 * quad + 32 * ks) * 2); kq_[tb][ks] = *(const LAS bf16x8*)(KDT + (16 * tb + l15) * PT + (8 * quad + 32 * ks) * 2); } }
        __builtin_amdgcn_sched_barrier(0);
#pragma unroll
        for (int tb = 0; tb < 4; ++tb) { f32x4 oa = (f32x4){0.f, 0.f, 0.f, 0.f};
#pragma unroll
            for (int ks = 0; ks < 2; ++ks) oa = __builtin_amdgcn_mfma_f32_16x16x32_bf16(pq_[tb][ks], vfrag[ks], oa, 0, 0, 0);
#pragma unroll
            for (int jj = 0; jj < 4; ++jj) *(LAS unsigned short*)(OUT + (16 * tb + 4 * quad + jj) * 272 + (e0 + l15) * 2) = (unsigned short)cvt1_bf16(oa[jj]); }
        { float* kvp = (float*)(C.a->ws + WS_GKV) + item * 8192;
#pragma unroll
          for (int db = 0; db < 4; ++db) { f32x4 sa = (f32x4){0.f, 0.f, 0.f, 0.f};
#pragma unroll
            for (int ks = 0; ks < 2; ++ks) sa = __builtin_amdgcn_mfma_f32_16x16x32_bf16(vfrag[ks], kq_[db][ks], sa, 0, 0, 0);
#pragma unroll
            for (int jj = 0; jj < 4; ++jj) kvp[(e0 + 4 * quad + jj) * 64 + 16 * db + l15] = sa[jj];
            agg[db] = agg[db] * AD[cb * 64 + 16 * db + l15] + sa; } }
        { const int c2 = c + 2 <= clast ? c + 2 : clast, c3 = c + 3 <= clast ? c + 3 : clast; GLA_LOAD_QKV(c2); GLA_LOAD_BG(c3); }
        LBAR();
        { const u32x4 o0 = *(const LAS u32x4*)(OUT + ot * 272 + oj * 32), o1 = *(const LAS u32x4*)(OUT + ot * 272 + oj * 32 + 16);
          bf16* gp = (bf16*)(C.a->ws + WS_GIN) + item * 8192 + ot * 128 + oj * 16; *(u32x4*)gp = o0; *(u32x4*)(gp + 8) = o1; }
    }
    { float* ga = (float*)(C.a->ws + WS_GKA) + ((size_t)(b * 4 + h) * 8 + oct) * 8256;
#pragma unroll
      for (int db = 0; db < 4; ++db)
#pragma unroll
          for (int jj = 0; jj < 4; ++jj) ga[(e0 + 4 * quad + jj) * 64 + 16 * db + l15] = agg[db][jj];
      if (tid < 64) ga[8192 + tid] = aprod; }
    __syncthreads();
#undef GLA_LOAD_QKV
#undef GLA_LOAD_BG
#undef GLA_STORE_BG
#undef GLA_PREP1
#undef GLA_PREP2
}

__device__ __forceinline__ void gla_scan_unit(const Ctx& C, int l, int b, int h, int oct) {
    LAS unsigned char* lds = C.lds;
    constexpr int PT = 144;
    LAS unsigned char* QD = lds;
    LAS unsigned char* ST = lds + 2 * 9216;
    LAS unsigned char* OUT = ST + 18432;
    const int tid = C.tid, lane = C.lane, wave = C.wave, l15 = lane & 15, quad = lane >> 4;
    const int i = l >> 1; const size_t tokbase = (size_t)b * SEQ; const int cfirst = oct * 8;
    const bf16* QKV = (const bf16*)(C.a->ws + WS_QKV); bf16* Og = (bf16*)(C.a->ws + WS_O);
    const float* GKV = (const float*)(C.a->ws + WS_GKV); const float* GAD = (const float*)(C.a->ws + WS_GAD); const bf16* GQD = (const bf16*)(C.a->ws + WS_GQD); const bf16* GIN = (const bf16*)(C.a->ws + WS_GIN);
    const size_t item0 = ((size_t)(b * 4 + h)) * 64;
    const int e0 = 16 * wave;
    const int ot = tid >> 3, oj = tid & 7;
    const int se = tid >> 2, sd = (tid & 3) * 16;
    const unsigned tdst_ = (unsigned)__builtin_amdgcn_readfirstlane((int)(unsigned)(uintptr_t)(C.lds + 131072 + wave * 1024));
    float gg[16];
#pragma unroll
    for (int k = 0; k < 16; ++k) gg[k] = C.a->in[I_EGLAN][i * 128 + 16 * oj + k];
    f32x4 S[4];
#pragma unroll
    for (int k = 0; k < 4; ++k) S[k] = (f32x4){0.f, 0.f, 0.f, 0.f};
    for (int oo = 0; oo < oct; ++oo) { const float* ga = (const float*)(C.a->ws + WS_GKA) + ((size_t)(b * 4 + h) * 8 + oo) * 8256;
#pragma unroll
        for (int k = 0; k < 4; ++k) { const f32x4 kv = *(const f32x4*)(ga + se * 64 + sd + 4 * k), av = *(const f32x4*)(ga + 8192 + sd + 4 * k); S[k] = S[k] * av + kv; } }
    for (int cc = 0; cc < 8; ++cc) {
        const int c = cfirst + cc; const size_t item = item0 + c; const size_t tok0 = tokbase + 64 * c; const int cb = cc & 1;
        const u32x4 qv = *(const u32x4*)(GQD + item * 4096 + ot * 64 + oj * 8);
        f32x4 kv[4], av[4];
#pragma unroll
        for (int k = 0; k < 4; ++k) { kv[k] = *(const f32x4*)(GKV + item * 8192 + se * 64 + sd + 4 * k); av[k] = *(const f32x4*)(GAD + item * 64 + sd + 4 * k); }
        const u32x4 in0 = *(const u32x4*)(GIN + item * 8192 + ot * 128 + oj * 16), in1 = *(const u32x4*)(GIN + item * 8192 + ot * 128 + oj * 16 + 8);
        const u32x4 rg0 = *(const u32x4*)(QKV + (tok0 + ot) * QKVW + E_BR + h * 128 + 16 * oj), rg1 = *(const u32x4*)(QKV + (tok0 + ot) * QKVW + E_BR + h * 128 + 16 * oj + 8);
        if (cc + 1 < 8) { const size_t n1 = item + 1;
            const unsigned t_ = (unsigned)tid;
            const unsigned o1 = t_ < 256u ? (unsigned)(WS_GKV + n1 * 32768 + t_ * 128u) : t_ < 384u ? (unsigned)(WS_GIN + n1 * 16384 + (t_ - 256u) * 128u)
                              : t_ < 448u ? (unsigned)(WS_GQD + n1 * 8192 + (t_ - 384u) * 128u) : (unsigned)(WS_QKV + ((tok0 + 64 + (t_ - 448u)) * QKVW + E_BR + h * 128) * 2);
            pg8::glds_s((const char*)C.a->ws, o1, tdst_);
            if (wave < 2) { const unsigned o2 = t_ < 64u ? (unsigned)(WS_QKV + ((tok0 + 64 + t_) * QKVW + E_BR + h * 128 + 64) * 2) : (unsigned)(WS_GAD + n1 * 256);
                pg8::glds_s((const char*)C.a->ws, o2, tdst_); } }
        { u32x4 w0, w1; w0.x = cvt_pk_bf16(S[0][0], S[0][1]); w0.y = cvt_pk_bf16(S[0][2], S[0][3]); w0.z = cvt_pk_bf16(S[1][0], S[1][1]); w0.w = cvt_pk_bf16(S[1][2], S[1][3]);
          w1.x = cvt_pk_bf16(S[2][0], S[2][1]); w1.y = cvt_pk_bf16(S[2][2], S[2][3]); w1.z = cvt_pk_bf16(S[3][0], S[3][1]); w1.w = cvt_pk_bf16(S[3][2], S[3][3]);
          *(LAS u32x4*)(ST + se * PT + sd * 2) = w0; *(LAS u32x4*)(ST + se * PT + sd * 2 + 16) = w1; }
        *(LAS u32x4*)(QD + cb * 9216 + ot * PT + oj * 16) = qv;
        LBAR();
        { bf16x8 sq_[2], aq_[4][2];
#pragma unroll
          for (int ks = 0; ks < 2; ++ks) { sq_[ks] = *(const LAS bf16x8*)(ST + (e0 + l15) * PT + (8 * quad + 32 * ks) * 2);
#pragma unroll
              for (int tb = 0; tb < 4; ++tb) aq_[tb][ks] = *(const LAS bf16x8*)(QD + cb * 9216 + (16 * tb + l15) * PT + (8 * quad + 32 * ks) * 2); }
          __builtin_amdgcn_sched_barrier(0);
#pragma unroll
          for (int tb = 0; tb < 4; ++tb) { f32x4 oa = (f32x4){0.f, 0.f, 0.f, 0.f};
#pragma unroll
            for (int ks = 0; ks < 2; ++ks) oa = __builtin_amdgcn_mfma_f32_16x16x32_bf16(aq_[tb][ks], sq_[ks], oa, 0, 0, 0);
#pragma unroll
            for (int jj = 0; jj < 4; ++jj) *(LAS unsigned short*)(OUT + (16 * tb + 4 * quad + jj) * 272 + (e0 + l15) * 2) = (unsigned short)cvt1_bf16(oa[jj]); } }
#pragma unroll
        for (int k = 0; k < 4; ++k) S[k] = S[k] * av[k] + kv[k];
        LBAR();
        { const u32x4 o0 = *(const LAS u32x4*)(OUT + ot * 272 + oj * 32), o1 = *(const LAS u32x4*)(OUT + ot * 272 + oj * 32 + 16);
          float ov[16];
#pragma unroll
          for (int k = 0; k < 4; ++k) { ov[2 * k] = bflo(o0[k]) + bflo(in0[k]); ov[2 * k + 1] = bfhi(o0[k]) + bfhi(in0[k]); ov[8 + 2 * k] = bflo(o1[k]) + bflo(in1[k]); ov[8 + 2 * k + 1] = bfhi(o1[k]) + bfhi(in1[k]); }
          float q = 0.f;
#pragma unroll
          for (int k = 0; k < 16; ++k) q += ov[k] * ov[k];
          q = sum8_dpp(q);
          const float rstd = 1.0f / sqrtf(q * (1.f / 128.f) + EPS);
          u32x4 w0, w1;
#pragma unroll
          for (int k = 0; k < 4; ++k) {
              { const float ra = bflo(rg0[k]), rb = bfhi(rg0[k]); const float sa = ra * __builtin_amdgcn_rcpf(1.f + __expf(-ra)), sb2 = rb * __builtin_amdgcn_rcpf(1.f + __expf(-rb));
                w0[k] = cvt_pk_bf16(ov[2 * k] * rstd * gg[2 * k] * sa, ov[2 * k + 1] * rstd * gg[2 * k + 1] * sb2); ov[2 * k] *= rstd * gg[2 * k] * sa * F8_ACT_SCALE; ov[2 * k + 1] *= rstd * gg[2 * k + 1] * sb2 * F8_ACT_SCALE; }
              { const float ra = bflo(rg1[k]), rb = bfhi(rg1[k]); const float sa = ra * __builtin_amdgcn_rcpf(1.f + __expf(-ra)), sb2 = rb * __builtin_amdgcn_rcpf(1.f + __expf(-rb));
                w1[k] = cvt_pk_bf16(ov[8 + 2 * k] * rstd * gg[8 + 2 * k] * sa, ov[8 + 2 * k + 1] * rstd * gg[8 + 2 * k + 1] * sb2); ov[8 + 2 * k] *= rstd * gg[8 + 2 * k] * sa * F8_ACT_SCALE; ov[8 + 2 * k + 1] *= rstd * gg[8 + 2 * k + 1] * sb2 * F8_ACT_SCALE; } }
          (void)w0; (void)w1;
          u32x4 w8; w8.x = pk4_fp8(ov[0], ov[1], ov[2], ov[3]); w8.y = pk4_fp8(ov[4], ov[5], ov[6], ov[7]); w8.z = pk4_fp8(ov[8], ov[9], ov[10], ov[11]); w8.w = pk4_fp8(ov[12], ov[13], ov[14], ov[15]);
          *(u32x4*)((unsigned char*)Og + (tok0 + ot) * DM + 512 + h * 128 + 16 * oj) = w8; }
    }
    __syncthreads();
}

__device__ __forceinline__ void stickbreak_wave_unit(const Ctx& C, int b, int h, int qt, int nb_, int nh_, int nqt_) {
    LAS unsigned char* kl = C.lds + 65536 + C.wave * 8192;
    LAS unsigned char* vl = C.lds + C.wave * 8192;
    const int lane = C.lane, r32 = lane & 31, hi = lane >> 5;
    const int i16 = lane & 15, q4 = i16 >> 2, p4 = i16 & 3, half16 = (lane >> 4) & 1;
    const size_t tokbase = (size_t)b * SEQ; const int q0 = qt * 32;
    const bf16* qp = ((bf16*)(C.a->ws + WS_QKV)) + (tokbase + q0 + r32) * QKVW + O_Q + h * 64 + 8 * hi;
    bf16x8 qr[4];
#pragma unroll
    for (int d0 = 0; d0 < 4; ++d0) qr[d0] = *(const bf16x8*)(qp + 16 * d0);
    f32x16 o[2];
#pragma unroll
    for (int k = 0; k < 2; ++k)
#pragma unroll
        for (int i = 0; i < 16; ++i) o[k][i] = 0.f;
    float R = 0.f;
    const int jd = q0 >> 6, qloc = (q0 & 63) + r32;
    u32x4 kr[8];
    const unsigned vdst = (unsigned)__builtin_amdgcn_readfirstlane((int)(unsigned)(uintptr_t)vl);
    const unsigned tdst = (unsigned)__builtin_amdgcn_readfirstlane((int)(unsigned)(uintptr_t)(C.lds + 131072 + C.wave * 1024));
    const char* qkvb = (const char*)(C.a->ws + WS_QKV);
    unsigned nt1 = 0u, nt2 = 0u, nt3 = 0u;
    if (nb_ >= 0) { const unsigned tb2 = (unsigned)nb_ * SEQ, q02 = (unsigned)nqt_ * 32u, k02 = tb2 + ((q02 >> 6) << 6), l31 = (unsigned)(lane & 31);
        const unsigned oq = ((tb2 + q02 + l31) * QKVW + O_Q + nh_ * 64) * 2u, ok0 = ((k02 + l31) * QKVW + O_K + nh_ * 64) * 2u, ok1 = ((k02 + 32u + l31) * QKVW + O_K + nh_ * 64) * 2u,
                       ov0 = ((k02 + l31) * QKVW + O_V + nh_ * 64) * 2u, ov1 = ((k02 + 32u + l31) * QKVW + O_V + nh_ * 64) * 2u;
        nt1 = hi ? ok0 : oq; nt2 = hi ? ov0 : ok1; nt3 = ov1; }
    const unsigned vtch = (unsigned)((((unsigned)tokbase + (unsigned)lane) * QKVW + O_V + h * 64) * 2);
#define SB_LOAD(jj) do { _Pragma("unroll") for (int i = 0; i < 8; ++i) { const int id = lane + 64 * i, row = id >> 3, c = id & 7; \
        kr[i] = *(const u32x4*)(((const bf16*)(C.a->ws + WS_QKV)) + (tokbase + 64 * (jj) + row) * QKVW + O_K + h * 64 + c * 8); } } while (0)
    SB_LOAD(jd);
    for (int j = jd; j >= 0; --j) {
        if (j < jd - 1) { SB_LOAD(j); }
#pragma unroll
        for (int i = 0; i < 8; ++i) { const int id = lane + 64 * i, row = id >> 3, c = id & 7; *(LAS u32x4*)(kl + kswz(row, c)) = kr[i]; }
        { const char* vbase = (const char*)(C.a->ws + WS_QKV) + (tokbase + 64 * (size_t)j) * (size_t)(QKVW * 2);
#pragma unroll
          for (int i = 0; i < 8; ++i) { const int p = i * 64 + lane; const unsigned vo = (unsigned)((((p >> 2) & 63) * QKVW + O_V + h * 64 + (p >> 8) * 32 + (p & 3) * 8) * 2);
              pg8::glds_s(vbase, vo, vdst + (unsigned)(i * 1024)); } }
        if (j > 0 && j == jd) { SB_LOAD(j - 1); }
        if (j > 0 && j == jd) pg8::glds_s(qkvb, vtch + (unsigned)(j - 1) * (unsigned)(64 * QKVW * 2), tdst);
        if (j == jd && nb_ >= 0) { pg8::glds_s(qkvb, nt1, tdst); pg8::glds_s(qkvb, nt2, tdst); pg8::glds_s(qkvb, nt3, tdst); }
        LDS_WAIT();
        f32x16 s0, s1;
#pragma unroll
        for (int i = 0; i < 16; ++i) { s0[i] = 0.f; s1[i] = 0.f; }
#pragma unroll
        for (int d0 = 0; d0 < 4; ++d0) { const int c = 2 * d0 + hi;
            const bf16x8 a0 = *(const LAS bf16x8*)(kl + kswz(r32, c)), a1 = *(const LAS bf16x8*)(kl + kswz(32 + r32, c));
            s0 = __builtin_amdgcn_mfma_f32_32x32x16_bf16(a0, qr[d0], s0, 0, 0, 0); s1 = __builtin_amdgcn_mfma_f32_32x32x16_bf16(a1, qr[d0], s1, 0, 0, 0); }
        const bool diag = (j == jd);
        const float eR = ex2(R);
#pragma unroll
        for (int i = 0; i < 16; ++i) { const int kv = crow(i, hi);
            { const float r = __builtin_amdgcn_rcpf(1.f + ex2(fminf(s0[i], 100.f))); s0[i] = (!diag || (kv < qloc)) ? r : 1.f; }
            { const float r = __builtin_amdgcn_rcpf(1.f + ex2(fminf(s1[i], 100.f))); s1[i] = (!diag || (kv + 32 < qloc)) ? r : 1.f; } }
        float own[8], oth[8];
#pragma unroll
        for (int g = 0; g < 4; ++g) { own[g] = (s0[4 * g] * s0[4 * g + 1]) * (s0[4 * g + 2] * s0[4 * g + 3]); own[4 + g] = (s1[4 * g] * s1[4 * g + 1]) * (s1[4 * g + 2] * s1[4 * g + 3]); }
#pragma unroll
        for (int g = 0; g < 8; ++g) oth[g] = pl32_other(own[g], hi);
        float T[8]; { float so = 1.f, sp_ = 1.f;
#pragma unroll
            for (int g = 7; g >= 0; --g) { T[g] = so * sp_ * (hi ? 1.f : oth[g]); so *= own[g]; sp_ *= oth[g]; }
            const float tot = so * sp_;
#pragma unroll
            for (int g = 0; g < 4; ++g) {
                { const float p4 = eR * T[g], p3 = p4 * s0[4 * g + 3], p2 = p3 * s0[4 * g + 2], p1 = p2 * s0[4 * g + 1], p0 = p1 * s0[4 * g];
                  s0[4 * g + 3] = p4 - p3; s0[4 * g + 2] = p3 - p2; s0[4 * g + 1] = p2 - p1; s0[4 * g] = p1 - p0; }
                { const float p4 = eR * T[4 + g], p3 = p4 * s1[4 * g + 3], p2 = p3 * s1[4 * g + 2], p1 = p2 * s1[4 * g + 1], p0 = p1 * s1[4 * g];
                  s1[4 * g + 3] = p4 - p3; s1[4 * g + 2] = p3 - p2; s1[4 * g + 1] = p2 - p1; s1[4 * g] = p1 - p0; } }
            R += lg2(tot); }
        if (j == jd) { if (nb_ >= 0) { if (j > 0) asm volatile("s_waitcnt vmcnt(12)" ::: "memory"); else asm volatile("s_waitcnt vmcnt(3)" ::: "memory"); }
                       else { if (j > 0) asm volatile("s_waitcnt vmcnt(9)" ::: "memory"); else asm volatile("s_waitcnt vmcnt(0)" ::: "memory"); } }
        else asm volatile("s_waitcnt vmcnt(0)" ::: "memory");
        const LAS unsigned char* vb = vl + half16 * 32 + p4 * 8 + (4 * hi + q4) * 64;
#pragma unroll
        for (int s = 0; s < 4; ++s) {
            u32x4 pw;
            if (s < 2) { pw.x = cvt_pk_bf16(s0[8 * s + 0], s0[8 * s + 1]); pw.y = cvt_pk_bf16(s0[8 * s + 2], s0[8 * s + 3]); pw.z = cvt_pk_bf16(s0[8 * s + 4], s0[8 * s + 5]); pw.w = cvt_pk_bf16(s0[8 * s + 6], s0[8 * s + 7]); }
            else { const int t = s - 2; pw.x = cvt_pk_bf16(s1[8 * t + 0], s1[8 * t + 1]); pw.y = cvt_pk_bf16(s1[8 * t + 2], s1[8 * t + 3]); pw.z = cvt_pk_bf16(s1[8 * t + 4], s1[8 * t + 5]); pw.w = cvt_pk_bf16(s1[8 * t + 6], s1[8 * t + 7]); }
            const bf16x8 pf = __builtin_bit_cast(bf16x8, pw);
#pragma unroll
            for (int k = 0; k < 2; ++k) { const s16x4 lo = vtr(vb + k * 4096 + s * 1024), hh = vtr(vb + k * 4096 + s * 1024 + 512);
                const bf16x8 vf = (bf16x8){lo[0], lo[1], lo[2], lo[3], hh[0], hh[1], hh[2], hh[3]};
                o[k] = __builtin_amdgcn_mfma_f32_32x32x16_bf16(vf, pf, o[k], 0, 0, 0); }
        }
        LDS_WAIT();
        if (__all(R < -40.f)) break;
    }
#undef SB_LOAD
#pragma unroll
    for (int k = 0; k < 2; ++k)
#pragma unroll
        for (int g = 0; g < 4; ++g) { const int dv = 32 * k + 8 * g + 4 * hi;
            *(LAS unsigned*)(kl + r32 * 64 + dv) = pk4_fp8(o[k][4 * g] * F8_ACT_SCALE, o[k][4 * g + 1] * F8_ACT_SCALE, o[k][4 * g + 2] * F8_ACT_SCALE, o[k][4 * g + 3] * F8_ACT_SCALE); }
    LDS_WAIT();
    { const int orow = lane >> 2, opc = lane & 3;
      const u32x4 w0 = *(const LAS u32x4*)(kl + orow * 64 + opc * 16), w1 = *(const LAS u32x4*)(kl + (16 + orow) * 64 + opc * 16);
      unsigned char* ob = (unsigned char*)(C.a->ws + WS_O) + (tokbase + q0 + orow) * DM + h * 64 + opc * 16;
      *(u32x4*)ob = w0; *(u32x4*)(ob + (size_t)16 * DM) = w1; }
    LDS_WAIT();
}


constexpr int PH_PER_LAYER = 8, N_PHASES = 1 + DEPTH * PH_PER_LAYER + 1;

__global__ void __launch_bounds__(512, 2) fwd(Args args) {
    extern __shared__ __attribute__((aligned(16))) unsigned char lds_raw[];
    Ctx C;
    C.lds = (LAS unsigned char*)lds_raw;
    C.tid = threadIdx.x; C.lane = C.tid & 63; C.wave = __builtin_amdgcn_readfirstlane(C.tid >> 6);
    C.G = gridDim.x; { const int bx = blockIdx.x; C.vcu = (C.G % 8 == 0) ? (bx % 8) * (C.G / 8) + bx / 8 : bx; }
    C.a = &args;
    LAS unsigned* lctl = (LAS unsigned*)(C.lds + LCTL_OFF);
    for (int u = C.tid; u < 1024; u += 512) lctl[u] = 0u;
    __syncthreads();
    const int lo = args.ph_lo, hi = args.ph_hi;
    XcdBarrier bar; bar.bar = ((unsigned*)(C.a->ws + WS_CTL)) + CW_BAR; bar.x = 0; bar.st = nullptr;
    if (hi - lo > 1) bar = xcd_barrier_post(((unsigned*)(C.a->ws + WS_CTL)) + CW_BAR, (volatile LAS unsigned*)lctl);
#ifndef PH_MASK
#define PH_MASK 0xffff
#endif
#define PHM(kind) ((PH_MASK >> (kind)) & 1)
#define IN(k) (lo <= (k) && (k) < hi)
#define INL(p) (PHM((p) + 1) && IN(pb + (p)))
#define SEAM(k) do { if (IN(k) && IN((k) + 1)) xcd_barrier(bar); } while (0)

    if (PHM(0) && IN(0)) { p0_prologue(C); __syncthreads(); SEAM(0); }

    for (int l = 0; l < DEPTH; ++l) {
        const int pb = 1 + PH_PER_LAYER * l;
        const bool odd = (l & 1) != 0;
        if (INL(0)) {
            const Ctx P = launder(C);
            if (l == 0) norm_phase<false, 1, false, true>(P, l, P.a->in[I_X], P.a->in[I_NMIX], 0, ((bf16*)(P.a->ws + WS_WBG)));
            else if (odd) norm_phase<true, 0, false, false>(P, l, nullptr, P.a->in[I_NMIX], 0, nullptr);
            else norm_phase<true, 1, false, false>(P, l, nullptr, P.a->in[I_NMIX], 0, ((bf16*)(P.a->ws + WS_WBG)) + (size_t)(l >> 1) * 16 * 1024);
            SEAM(pb + 0);
        }
        if (INL(1)) {
            const Ctx P = launder(C); const int bx = (P.vcu % (P.G / 8)) * 8 + P.vcu / (P.G / 8);
            pg8::Gemm g{((bf16*)(P.a->ws + WS_H)), ((bf16*)(P.a->ws + WS_WIN)) + (size_t)l * 3072 * 1024, 1024}; pg8::StaticOrder S; S.init(NTOK, QKVW, P.G, bx);
            pg8::EpiQKV E{((bf16*)(P.a->ws + WS_QKV)), QKVW, C2, odd ? 4 : 2, 0.125f, odd ? -1 : 6};
            pg8::gemm_phase<pg8::EpiQKV, pg8::StaticOrder, false, true>(P.lds, P.tid, g, S, E);
            SEAM(pb + 1);
        }
        if (INL(2) || INL(3)) {
            if (!odd) {
                LAS float* lamp = (LAS float*)(lctl + 64);
                LAS int* itemp = (LAS int*)(lctl + 65);
                if (C.wave == 0) { const float* lp = C.a->in[I_ELAM] + (size_t)(l >> 1) * 256; const float a = wave_sum(lp[C.lane] * lp[64 + C.lane]), bq = wave_sum(lp[128 + C.lane] * lp[192 + C.lane]);
                    if (C.lane == 0) *lamp = __expf(a) - __expf(bq); }
                const float lam_init = 0.8f - 0.6f * __expf(-0.3f * (float)l);
                const int myx = (int)(xb_xcc_id() & 7u);
#pragma unroll 1
                for (int pass_ = 0; pass_ < 2; ++pass_) {
                    if (!(pass_ == 0 ? INL(2) : INL(3))) continue;
                    const int nqb = pass_ == 0 ? 8 : 24, qb_hi = pass_ == 0 ? 31 : 23, nitem = 32 + 4 * nqb;
#pragma unroll 1
                    for (int kx = 0; kx < 8; ++kx) {
                        const int xq = (myx + kx) & 7;
                        unsigned* qctr = ((unsigned*)(C.a->ws + WS_CTL)) + CW_QUEUE + 1024 + (((l >> 1) * 2 + pass_) * 8 + xq) * 16;
                        __syncthreads();
                        if (C.tid == 0) *itemp = (int)__hip_atomic_fetch_add(qctr, 1u, __ATOMIC_RELAXED, __HIP_MEMORY_SCOPE_AGENT);
                        __syncthreads();
                        int item = __builtin_amdgcn_readfirstlane(*itemp);
                        while (item < nitem) {
                            unsigned nx_ = 0u; if (C.tid == 0) nx_ = __hip_atomic_fetch_add(qctr, 1u, __ATOMIC_RELAXED, __HIP_MEMORY_SCOPE_AGENT);
                            const float lam = *lamp + lam_init;
                            const Ctx P = launder(C);
                            if (item < 32) { const int oct = 7 - (item >> 2), bh = 4 * xq + (item & 3);
                                if (pass_ == 0) gla_local_unit(P, l, bh >> 2, bh & 3, oct); else gla_scan_unit(P, l, bh >> 2, bh & 3, oct); }
                            else { const int k = item - 32, bh = 4 * xq + (k & 3), qb = qb_hi - (k >> 2); diffattn_unit(P, l, bh >> 2, bh & 3, qb, lam, lam_init); }
                            if (C.tid == 0) *itemp = (int)nx_;
                            __syncthreads();
                            item = __builtin_amdgcn_readfirstlane(*itemp);
                        }
                    }
                    if (pass_ == 0) { SEAM(pb + 2); } else { SEAM(pb + 3); }
                }
            } else if (INL(3)) {
                const Ctx P = launder(C);
                const int gw = P.vcu * 8 + P.wave, NGW = P.G * 8;
                for (int u = gw; u < NBATCH * 16 * 128; u += NGW) { const int hs = u & 1, qt = (u >> 1) & 127, hp = (u >> 8) & 7, b = u >> 11;
                    const int u2 = u + NGW; const bool hn = u2 < NBATCH * 16 * 128;
                    stickbreak_wave_unit(P, b, 2 * hp + hs, qt, hn ? (u2 >> 11) : -1, 2 * ((u2 >> 8) & 7) + (u2 & 1), (u2 >> 1) & 127); }
                __syncthreads();
                SEAM(pb + 3);
            }
        }
        if (INL(4)) {
            const Ctx P = launder(C); const int bx = (P.vcu % (P.G / 8)) * 8 + P.vcu / (P.G / 8);
            pg8::Gemm g{(const bf16*)(P.a->ws + WS_O), (const bf16*)(P.a->ws + WS_WOUT + (size_t)l * 1024 * 1024), 512}; pg8::StaticOrder S; S.init(NTOK, DM, P.G, bx);
            const float* gate1 = ((float*)(P.a->ws + WS_MOD)) + (size_t)l * 8 * 6144 + 2 * 1024;
            if (l == 0) { pg8::EpiResid<true> E{P.a->in[I_X], (bf16*)(P.a->ws + WS_XB), gate1}; pg8::gemm_phase<pg8::EpiResid<true>, pg8::StaticOrder, false, true, true>(P.lds, P.tid, g, S, E); }
            else { pg8::EpiResid<false> E{nullptr, (bf16*)(P.a->ws + WS_XB), gate1}; pg8::gemm_phase<pg8::EpiResid<false>, pg8::StaticOrder, false, true, true>(P.lds, P.tid, g, S, E); }
            SEAM(pb + 4);
        }
        if (INL(5)) {
            const Ctx P = launder(C);
            norm_phase<false, 2, false, false>(P, l, nullptr, P.a->in[I_NFFN], 3, ((bf16*)(P.a->ws + WS_WR)) + (size_t)l * 36 * 1024);
            SEAM(pb + 5);
        }
        if (INL(6)) {
            const Ctx P = launder(C); const int bx = (P.vcu % (P.G / 8)) * 8 + P.vcu / (P.G / 8);
            LAS int* tb = (LAS int*)(P.lds + LCTL_OFF + 64); LAS int* cl = (LAS int*)(P.lds + LCTL_OFF + 512);
            const int* cnt = (const int*)(((unsigned*)(P.a->ws + WS_CTL)) + CW_CNT + 64 * l);
            __syncthreads();
            if (P.tid < 32) {
                const int cv = (int)__hip_atomic_load(cnt + P.tid, __ATOMIC_RELAXED, __HIP_MEMORY_SCOPE_AGENT); cl[P.tid] = cv; int t = (cv + 255) >> 8;
#pragma unroll
                for (int d = 1; d < 32; d <<= 1) { const int v = __shfl_up(t, d); if (P.tid >= d) t += v; }
                tb[P.tid + 1] = t; if (P.tid == 0) tb[0] = 0; }
            __syncthreads();
            const int T = __builtin_amdgcn_readfirstlane(tb[32]);
            pg8::GroupedOrder S{tb, T, P.G, bx, ((int*)(P.a->ws + WS_PLIST)), cl};
            pg8::Gemm g{(const bf16*)(P.a->ws + WS_H8), (const bf16*)(P.a->ws + WS_WGU + (size_t)l * 32 * 1024 * 1024), 512};
            pg8::EpiSwiGLU8 E{(unsigned char*)(P.a->ws + WS_O), ((float*)(P.a->ws + WS_WLIST))};
            pg8::gemm_phase<pg8::EpiSwiGLU8, pg8::GroupedOrder, true, true, true>(P.lds, P.tid, g, S, E);
            SEAM(pb + 6);
        }
        if (INL(7)) {
            const Ctx P = launder(C); const int bx = (P.vcu % (P.G / 8)) * 8 + P.vcu / (P.G / 8);
            LAS int* tb = (LAS int*)(P.lds + LCTL_OFF + 64); LAS int* cl = (LAS int*)(P.lds + LCTL_OFF + 512);
            if (!INL(6)) {
            const int* cnt = (const int*)(((unsigned*)(P.a->ws + WS_CTL)) + CW_CNT + 64 * l);
            __syncthreads();
            if (P.tid < 32) {
                const int cv = (int)__hip_atomic_load(cnt + P.tid, __ATOMIC_RELAXED, __HIP_MEMORY_SCOPE_AGENT); cl[P.tid] = cv; int t = (cv + 255) >> 8;
#pragma unroll
                for (int d = 1; d < 32; d <<= 1) { const int v = __shfl_up(t, d); if (P.tid >= d) t += v; }
                tb[P.tid + 1] = t; if (P.tid == 0) tb[0] = 0; }
            __syncthreads();
            }
            const int T = __builtin_amdgcn_readfirstlane(tb[32]);
            pg8::GroupedOrder S{tb, T, P.G, bx, ((int*)(P.a->ws + WS_PLIST)), cl};
            pg8::Gemm g{(const bf16*)(P.a->ws + WS_O), (const bf16*)(P.a->ws + WS_WD + (size_t)l * 32 * 1024 * 512), 256};
            pg8::EpiScatterY E{((bf16*)(P.a->ws + WS_QKV)), ((int*)(P.a->ws + WS_PLIST))};
            pg8::gemm_phase<pg8::EpiScatterY, pg8::GroupedOrder, false, true, true>(P.lds, P.tid, g, S, E);
            SEAM(pb + 7);
        }
    }
    if (PHM(9) && IN(N_PHASES - 1)) { const Ctx P = launder(C); norm_phase<true, 0, true, false>(P, DEPTH, nullptr, P.a->in[I_NFIN], 0, nullptr); }
#undef IN
#undef INL
#undef SEAM
}

extern "C" void kernel_launch(void* const* d_in, const int* in_sizes, int n_in, void* d_out, int out_size, void* d_ws, size_t ws_size, hipStream_t stream) {
    static int grid = 0;
    if (grid == 0) {
        if (n_in != 24 || in_sizes[0] != NTOK * DM || out_size != NTOK * DM || ws_size < WS_END) { fprintf(stderr, "kernel_launch: unexpected shapes (n_in %d, in0 %d, out %d, ws %zu)\n", n_in, n_in > 0 ? in_sizes[0] : -1, out_size, ws_size); grid = -1; return; }
        int dev = 0, cus = 0, per_cu = 0;
        if (hipGetDevice(&dev) != hipSuccess || hipDeviceGetAttribute(&cus, hipDeviceAttributeMultiprocessorCount, dev) != hipSuccess) { grid = -1; return; }
        if (hipFuncSetAttribute((const void*)fwd, hipFuncAttributeMaxDynamicSharedMemorySize, LDS_BYTES) != hipSuccess) { fprintf(stderr, "kernel_launch: hipFuncSetAttribute failed\n"); grid = -1; return; }
        if (hipOccupancyMaxActiveBlocksPerMultiprocessor(&per_cu, (const void*)fwd, 512, LDS_BYTES) != hipSuccess || per_cu < 1) fprintf(stderr, "kernel_launch: occupancy query reports %d\n", per_cu);
        (void)hipGetLastError();
        grid = cus;
        if (grid != 256) { fprintf(stderr, "kernel_launch: built for a 256-CU device (one workgroup per CU), found %d CUs\n", cus); grid = -1; return; }
    }
    if (grid < 0) return;
    if (hipMemsetAsync((char*)d_ws + WS_CTL, 0, CTL_ZERO_BYTES, stream) != hipSuccess) return;
    Args a{};
    for (int i = 0; i < 24; ++i) a.in[i] = (const float*)d_in[i];
    a.out = (float*)d_out; a.ws = (unsigned char*)d_ws;
    a.ph_lo = 0; a.ph_hi = N_PHASES;
    hipLaunchKernelGGL(fwd, dim3(grid), dim3(512), LDS_BYTES, stream, a);
}
```

```cpp
#include <hip/hip_runtime.h>
#include <cstdio>
#include <cstdint>

#define GAS __attribute__((address_space(1)))
#define LAS __attribute__((address_space(3)))
typedef unsigned short bf16;
typedef short bf16x8 __attribute__((ext_vector_type(8)));
typedef short s16x4 __attribute__((ext_vector_type(4)));
typedef float f32x4 __attribute__((ext_vector_type(4)));
typedef float f32x2 __attribute__((ext_vector_type(2)));
typedef float f32x16 __attribute__((ext_vector_type(16)));
typedef unsigned u32x4 __attribute__((ext_vector_type(4)));
typedef unsigned u32x2 __attribute__((ext_vector_type(2)));

constexpr int NTOK = 32768, DM = 1024, SEQ = 4096, NBATCH = 8, DEPTH = 4;
constexpr int QKVW = 3072;
constexpr int NEXP = 32;
constexpr float EPS = 1e-6f;
constexpr float LOG2E = 1.4426950408889634f;
constexpr float C2 = 0.125f * 1.4426950408889634f;
constexpr int E_AQ = 0, E_AK = 512, E_AV = 1024, E_BQ = 1536, E_BK = 1792, E_BV = 2048, E_BR = 2560;
constexpr int O_Q = 0, O_K = 1024, O_V = 2048;

constexpr size_t MiB = 1u << 20;
constexpr size_t WS_CTL = 0, CTL_ZERO_BYTES = 1 * MiB;
constexpr size_t WS_MOD = 2 * MiB;
constexpr size_t WS_WR = 3 * MiB;
constexpr size_t WS_WBG = 3 * MiB + 512 * 1024;
constexpr size_t WS_PLIST = 4 * MiB;
constexpr size_t WS_WLIST = 8 * MiB;
constexpr size_t WS_BG = 12 * MiB;
constexpr size_t WS_WIN = 16 * MiB;
constexpr size_t WS_WOUT = 40 * MiB;
constexpr size_t WS_WGU = 48 * MiB;
constexpr size_t WS_WD = 304 * MiB;
constexpr size_t WS_H = 432 * MiB;
constexpr size_t WS_QKV = 498 * MiB;
constexpr size_t WS_O = 690 * MiB;
constexpr size_t WS_GQD = 768 * MiB;
constexpr size_t WS_GIN = 784 * MiB;
constexpr size_t WS_GKV = 816 * MiB;
constexpr size_t WS_GAD = 880 * MiB;
constexpr size_t WS_GKA = 880 * MiB + 512 * 1024;
constexpr size_t WS_XB = 889 * MiB;
constexpr size_t WS_H8 = 953 * MiB;
constexpr size_t WS_END = 987 * MiB;
constexpr int CW_BAR = 4096;
constexpr int CW_CNT = 16384;
constexpr int CW_DBG = 24576;
constexpr int CW_QUEUE = 20480;
constexpr int RING_BYTES = 147456;
constexpr int LCTL_OFF = RING_BYTES;
constexpr int LDS_BYTES = RING_BYTES + 4096;

__device__ __forceinline__ unsigned f2bf(float f) { unsigned u = __builtin_bit_cast(unsigned, f); return (u + 0x7fffu + ((u >> 16) & 1u)) >> 16; }
__device__ __forceinline__ unsigned pk2(float lo, float hi) { return f2bf(lo) | (f2bf(hi) << 16); }
typedef __bf16 bf16x2_t __attribute__((ext_vector_type(2)));
__device__ __forceinline__ unsigned cvt_pk_bf16(float lo, float hi) { f32x2 v = {lo, hi}; bf16x2_t b = __builtin_convertvector(v, bf16x2_t); return __builtin_bit_cast(unsigned, b); }
__device__ __forceinline__ unsigned cvt1_bf16(float x) { return cvt_pk_bf16(x, 0.f); }
typedef int v4i32 __attribute__((ext_vector_type(4)));
typedef int v8i32 __attribute__((ext_vector_type(8)));
__device__ __forceinline__ unsigned pk4_fp8(float a, float b, float c, float d) {
    a = __builtin_fminf(__builtin_fmaxf(a, -448.f), 448.f); b = __builtin_fminf(__builtin_fmaxf(b, -448.f), 448.f); c = __builtin_fminf(__builtin_fmaxf(c, -448.f), 448.f); d = __builtin_fminf(__builtin_fmaxf(d, -448.f), 448.f);
    int pk = 0; pk = __builtin_amdgcn_cvt_pk_fp8_f32(a, b, pk, false); pk = __builtin_amdgcn_cvt_pk_fp8_f32(c, d, pk, true); return (unsigned)pk; }
constexpr float F8_ACT_SCALE = 16.f, F8_W_SCALE = 64.f;
constexpr int F8_SC_ACT = 0x7b7b7b7b, F8_SC_W = 0x79797979;
__device__ __forceinline__ float bf2f(unsigned short x) { return __builtin_bit_cast(float, (unsigned)x << 16); }
__device__ __forceinline__ float bflo(unsigned x) { return __builtin_bit_cast(float, x << 16); }
__device__ __forceinline__ float bfhi(unsigned x) { return __builtin_bit_cast(float, x & 0xffff0000u); }
__device__ __forceinline__ int crow(int r, int hi) { return (r & 3) + 8 * (r >> 2) + 4 * hi; }
__device__ __forceinline__ float ex2(float x) { return __builtin_amdgcn_exp2f(x); }
__device__ __forceinline__ float lg2(float x) { return __builtin_amdgcn_logf(x); }
__device__ __forceinline__ void swap32(float& a, float& b) { asm volatile("s_nop 1\n\tv_permlane32_swap_b32 %0, %1\n\ts_nop 1" : "+v"(a), "+v"(b)); }
__device__ __forceinline__ void swap16(float& a, float& b) { asm volatile("s_nop 1\n\tv_permlane16_swap_b32 %0, %1\n\ts_nop 1" : "+v"(a), "+v"(b)); }
#define LDS_WAIT() asm volatile("s_waitcnt lgkmcnt(0)" ::: "memory")
#define LBAR() do { asm volatile("s_waitcnt lgkmcnt(0)" ::: "memory"); __builtin_amdgcn_s_barrier(); asm volatile("" ::: "memory"); } while (0)

namespace pg8 {
typedef unsigned short bf16_t;
constexpr int BM = 256, BK = 64, HALF = 128, HTB = HALF * BK * 2, STAGE_BYTES = 8 * HTB, NXCD = 8, WGM = 8;
__host__ __device__ __forceinline__ int lds_byte(int r, int c) { const int st = (r >> 4) * 2 + (c >> 5), rr = r & 15, cc = c & 31, ob = rr * 64 + cc * 2; return st * 1024 + (ob ^ (((ob >> 9) & 1) << 5)); }
__host__ __device__ __forceinline__ void stage_rc(int b, int& R, int& C) { const int st = b / 1024, sb = b % 1024, swz = sb ^ (((sb >> 9) & 1) << 5); R = (st >> 1) * 16 + swz / 64; C = (st & 1) * 32 + (swz % 64) / 2; }
__host__ __device__ __forceinline__ int perm32(int rho) { const int n = rho >> 4, i = rho & 15; return 8 * (i >> 2) + 4 * n + (i & 3); }

struct Unit { int pm, pn, e, t0, ne; };
struct Gemm { const bf16_t* A; const bf16_t* Bt; int K; };

struct StaticOrder {
    int nM, nN, nwg, G, c;
    __device__ void init(int M, int N, int G_, int c_) { nM = M / BM; nN = N / BM; nwg = nM * nN; G = G_; c = c_; }
    __device__ bool next(int i, Unit& u) const {
        const long L = (long)i * G + c; if (L >= nwg) return false;
        int wgid = (int)L; { const int q = nwg / NXCD, r = nwg % NXCD, xcd = wgid % NXCD, off = wgid / NXCD; wgid = (xcd < r ? xcd * (q + 1) : r * (q + 1) + (xcd - r) * q) + off; }
        const int nig = WGM * nN, gid = wgid / nig, fm = gid * WGM, gsz = (nM - fm) < WGM ? (nM - fm) : WGM;
        u.pm = fm + ((wgid % nig) % gsz); u.pn = (wgid % nig) / gsz; u.e = 0; u.t0 = 0; u.ne = 0; return true;
    }
    __device__ __forceinline__ int arow(const Unit&, int) const { return 0; }
};

struct GroupedOrder {
    const LAS int* tb; int T, G, c; const int* plist; const LAS int* cl;
    __device__ __forceinline__ bool next(int i, Unit& u) const {
        const int nun = T * 4; const long L = (long)i * G + c; if (L >= nun) return false;
        int w = (int)L; { const int q = nun / NXCD, r = nun % NXCD, xcd = w % NXCD, off = w / NXCD; w = (xcd < r ? xcd * (q + 1) : r * (q + 1) + (xcd - r) * q) + off; }
        const int ti = w >> 2, pnl = w & 3;
        int e = 0;
#pragma unroll
        for (int step = 16; step >= 1; step >>= 1) { const int v = __builtin_amdgcn_readfirstlane(tb[e + step]); if (v <= ti) e += step; }
        u.pm = ti; u.pn = e * 4 + pnl; u.e = e; u.t0 = ti - __builtin_amdgcn_readfirstlane(tb[e]); u.ne = __builtin_amdgcn_readfirstlane(cl[e]); return true;
    }
    __device__ __forceinline__ int arow(const Unit& u, int r) const {
        const int pos = u.t0 * 256 + r; const int pr = plist[(size_t)u.e * NTOK + pos];
        return pos < u.ne ? (pr >> 1) : NTOK;
    }
};

struct EpiQKV {
    static constexpr bool PERM = true;
    bf16_t* O; int ldc; float s_lo; int n_lo; float s_one; int i_one;
    __device__ __forceinline__ void operator()(const f32x4 (&acc)[2][2][4][2], const Unit& u, int wr, int wc, int fr, int fq) const {
        const int row0 = u.pm * BM + wr * 64 + fr; const int col0 = u.pn * BM + wc * 32 + 8 * fq;
        const float sc = (u.pn < n_lo) ? s_lo : ((u.pn == i_one) ? s_one : 1.f);
#pragma unroll
        for (int ai = 0; ai < 2; ++ai)
#pragma unroll
            for (int m = 0; m < 4; ++m) { bf16_t* rowp = O + (size_t)(row0 + ai * HALF + m * 16) * ldc + col0;
#pragma unroll
                for (int bj = 0; bj < 2; ++bj) { f32x4 v0 = acc[ai][bj][m][0] * sc, v1 = acc[ai][bj][m][1] * sc;
                    u32x4 w; w.x = cvt_pk_bf16(v0[0], v0[1]); w.y = cvt_pk_bf16(v0[2], v0[3]); w.z = cvt_pk_bf16(v1[0], v1[1]); w.w = cvt_pk_bf16(v1[2], v1[3]);
                    *(u32x4*)(rowp + bj * HALF) = w; } }
    }
};
template <bool BASE_F32> struct EpiResid {
    static constexpr bool PERM = true;
    const float* base32; bf16_t* xb; const float* gate;
    __device__ __forceinline__ void operator()(const f32x4 (&acc)[2][2][4][2], const Unit& u, int wr, int wc, int fr_, int fq_) const {
        int fr = fr_, fq = fq_; asm volatile("" : "+v"(fr), "+v"(fq));
        const int b = (u.pm * BM) >> 12; const float* gp = gate + (size_t)b * 6144;
        const int col0 = u.pn * BM + wc * 32 + 8 * fq;
        if constexpr (!BASE_F32) {
            const unsigned ob0 = (unsigned)(((u.pm * BM + wr * 64 + fr) * DM + col0) * 2);
#pragma unroll
            for (int bj = 0; bj < 2; ++bj) { const f32x4 g0 = *(const f32x4*)(gp + col0 + bj * HALF), g1 = *(const f32x4*)(gp + col0 + bj * HALF + 4);
                u32x4 xr[2][4];
#pragma unroll
                for (int ai = 0; ai < 2; ++ai)
#pragma unroll
                    for (int m = 0; m < 4; ++m) { const unsigned ob = ob0 + (unsigned)(((ai * HALF + m * 16) * DM + bj * HALF) * 2); xr[ai][m] = *(const u32x4*)((const char*)xb + ob); }
#pragma unroll
                for (int ai = 0; ai < 2; ++ai)
#pragma unroll
                    for (int m = 0; m < 4; ++m) { const unsigned ob = ob0 + (unsigned)(((ai * HALF + m * 16) * DM + bj * HALF) * 2); const u32x4 r = xr[ai][m];
                        const f32x4 x0 = (f32x4){bflo(r.x), bfhi(r.x), bflo(r.y), bfhi(r.y)}, x1 = (f32x4){bflo(r.z), bfhi(r.z), bflo(r.w), bfhi(r.w)};
                        const f32x4 y0 = x0 + g0 * acc[ai][bj][m][0], y1 = x1 + g1 * acc[ai][bj][m][1];
                        u32x4 w; w.x = cvt_pk_bf16(y0[0], y0[1]); w.y = cvt_pk_bf16(y0[2], y0[3]); w.z = cvt_pk_bf16(y1[0], y1[1]); w.w = cvt_pk_bf16(y1[2], y1[3]);
                        *(u32x4*)((char*)xb + ob) = w; } }
            return;
        }
#pragma unroll
        for (int bj = 0; bj < 2; ++bj) { const f32x4 g0 = *(const f32x4*)(gp + col0 + bj * HALF), g1 = *(const f32x4*)(gp + col0 + bj * HALF + 4);
#pragma unroll
            for (int ai = 0; ai < 2; ++ai) {
                f32x4 x0[4], x1[4];
#pragma unroll
                for (int m = 0; m < 4; ++m) { const size_t off = (size_t)(u.pm * BM + ai * HALF + wr * 64 + m * 16 + fr) * DM + col0 + bj * HALF;
                    if (BASE_F32) { x0[m] = *(const f32x4*)(base32 + off); x1[m] = *(const f32x4*)(base32 + off + 4); }
                    else { const u32x4 xr = *(const u32x4*)(xb + off); x0[m] = (f32x4){bflo(xr.x), bfhi(xr.x), bflo(xr.y), bfhi(xr.y)}; x1[m] = (f32x4){bflo(xr.z), bfhi(xr.z), bflo(xr.w), bfhi(xr.w)}; } }
#pragma unroll
                for (int m = 0; m < 4; ++m) { const size_t off = (size_t)(u.pm * BM + ai * HALF + wr * 64 + m * 16 + fr) * DM + col0 + bj * HALF;
                    const f32x4 y0 = x0[m] + g0 * acc[ai][bj][m][0], y1 = x1[m] + g1 * acc[ai][bj][m][1];
                    u32x4 w; w.x = cvt_pk_bf16(y0[0], y0[1]); w.y = cvt_pk_bf16(y0[2], y0[3]); w.z = cvt_pk_bf16(y1[0], y1[1]); w.w = cvt_pk_bf16(y1[2], y1[3]);
                    *(u32x4*)(xb + off) = w; } } }
    }
};
struct EpiSwiGLU {
    static constexpr bool PERM = true;
    bf16_t* ACT; const float* wlist; const int* cnt;
    __device__ __forceinline__ void operator()(const f32x4 (&acc)[2][2][4][2], const Unit& u, int wr, int wc, int fr, int fq) const {
        const int n_e = cnt[u.e]; const int col0 = (u.pn & 3) * 128 + wc * 32 + 8 * fq;
#pragma unroll
        for (int ai = 0; ai < 2; ++ai)
#pragma unroll
            for (int m = 0; m < 4; ++m) { const int rloc = ai * HALF + wr * 64 + m * 16 + fr; const int pos = u.t0 * 256 + rloc;
                const float w = pos < n_e ? wlist[(size_t)u.e * NTOK + pos] : 0.f;
                float r[8];
#pragma unroll
                for (int n = 0; n < 2; ++n)
#pragma unroll
                    for (int i = 0; i < 4; ++i) { const float g = acc[ai][0][m][n][i], uu = acc[ai][1][m][n][i];
                        r[n * 4 + i] = g * __builtin_amdgcn_rcpf(1.f + __expf(-g)) * uu * w; }
                u32x4 o; o.x = cvt_pk_bf16(r[0], r[1]); o.y = cvt_pk_bf16(r[2], r[3]); o.z = cvt_pk_bf16(r[4], r[5]); o.w = cvt_pk_bf16(r[6], r[7]);
                *(u32x4*)(ACT + (size_t)(u.pm * BM + rloc) * 512 + col0) = o; }
    }
};
struct EpiSwiGLU8 {
    static constexpr bool PERM = true;
    unsigned char* ACT8; const float* wlist;
    __device__ __forceinline__ void operator()(const f32x4 (&acc)[2][2][4][2], const Unit& u, int wr, int wc, int fr_, int fq_) const {
        int fr = fr_, fq = fq_; asm volatile("" : "+v"(fr), "+v"(fq));
        const int n_e = u.ne; const int col0 = (u.pn & 3) * 128 + wc * 32 + 8 * fq;
        float w8[8];
#pragma unroll
        for (int q = 0; q < 8; ++q) { const int pos = u.t0 * 256 + (q >> 2) * HALF + wr * 64 + (q & 3) * 16 + fr; w8[q] = wlist[(size_t)u.e * NTOK + pos]; }
#pragma unroll
        for (int ai = 0; ai < 2; ++ai)
#pragma unroll
            for (int m = 0; m < 4; ++m) { const int rloc = ai * HALF + wr * 64 + m * 16 + fr; const int pos = u.t0 * 256 + rloc;
                const float w = pos < n_e ? w8[ai * 4 + m] * F8_ACT_SCALE : 0.f;
                float r[8];
#pragma unroll
                for (int n = 0; n < 2; ++n)
#pragma unroll
                    for (int i = 0; i < 4; ++i) { const float g = acc[ai][0][m][n][i], uu = acc[ai][1][m][n][i];
                        r[n * 4 + i] = g * __builtin_amdgcn_rcpf(1.f + __expf(-g)) * uu * w; }
                u32x2 o; o.x = pk4_fp8(r[0], r[1], r[2], r[3]); o.y = pk4_fp8(r[4], r[5], r[6], r[7]);
                *(u32x2*)(ACT8 + (size_t)(u.pm * BM + rloc) * 512 + col0) = o; }
    }
};
struct EpiScatterY {
    static constexpr bool PERM = true;
    bf16_t* Y; const int* plist;
    __device__ __forceinline__ void operator()(const f32x4 (&acc)[2][2][4][2], const Unit& u, int wr, int wc, int fr_, int fq_) const {
        int fr = fr_, fq = fq_; asm volatile("" : "+v"(fr), "+v"(fq));
        const int n_e = u.ne; const int col0 = (u.pn & 3) * 256 + wc * 32 + 8 * fq;
        int yr[8];
#pragma unroll
        for (int q = 0; q < 8; ++q) { const int pos = u.t0 * 256 + (q >> 2) * HALF + wr * 64 + (q & 3) * 16 + fr; yr[q] = plist[(size_t)u.e * NTOK + pos]; }
#pragma unroll
        for (int ai = 0; ai < 2; ++ai)
#pragma unroll
            for (int m = 0; m < 4; ++m) { const int rloc = ai * HALF + wr * 64 + m * 16 + fr; const int pos = u.t0 * 256 + rloc;
                const int yrow = pos < n_e ? yr[ai * 4 + m] : 2 * NTOK;
                unsigned char* rowp = (unsigned char*)Y + (size_t)yrow * DM + col0;
#pragma unroll
                for (int bj = 0; bj < 2; ++bj) { const f32x4 v0 = acc[ai][bj][m][0] * 32.f, v1 = acc[ai][bj][m][1] * 32.f;
                    u32x2 w; w.x = pk4_fp8(v0[0], v0[1], v0[2], v0[3]); w.y = pk4_fp8(v1[0], v1[1], v1[2], v1[3]);
                    *(u32x2*)(rowp + bj * HALF) = w; } }
    }
};

__device__ __forceinline__ void glds_s(const char* sbase_, unsigned voff, unsigned lds_dst) {
    const unsigned long long pb_ = (unsigned long long)sbase_;
    const char* sbase = (const char*)(((unsigned long long)(unsigned)__builtin_amdgcn_readfirstlane((int)(pb_ >> 32)) << 32) | (unsigned long long)(unsigned)__builtin_amdgcn_readfirstlane((int)(unsigned)pb_));
    unsigned keep;
    asm volatile("s_mov_b32 %0, m0\n\ts_mov_b32 m0, %3\n\ts_nop 0\n\tglobal_load_lds_dwordx4 %1, %2\n\ts_mov_b32 m0, %0"
                 : "=&s"(keep) : "v"(voff), "s"(sbase), "s"(lds_dst) : "memory");
}
template <class Epi, class Sched, bool GATHER, bool ALIGN_EPI, bool F8 = false>
__device__ __forceinline__ void gemm_phase(LAS unsigned char* lds, const int tid, const Gemm g, const Sched& S, const Epi& E) {
    const int wid = __builtin_amdgcn_readfirstlane(tid >> 6), lane = tid & 63, wr = wid >> 2, wc = wid & 3, fr = lane & 15, fq = lane >> 4;
    int K_ = g.K; asm volatile("" : "+s"(K_));
    const int K = K_, nt = K / BK;
    unsigned voffB[2]; int sR[2], sC[2];
#pragma unroll
    for (int i = 0; i < 2; ++i) { int R, C; stage_rc(tid * 16 + i * 8192, R, C); const int Rb = Epi::PERM ? ((R & ~31) + perm32(R & 31)) : R;
        voffB[i] = (unsigned)(Rb * K + C) * 2u; sR[i] = R; sC[i] = C; }
    const size_t kstep = (size_t)(BK * 2);
    const size_t hstep = (size_t)HALF * K * 2;
    const size_t tstep = 2 * hstep;
    const unsigned ldsw = (unsigned)wid * 1024u;
    const unsigned ldsbase = (unsigned)__builtin_amdgcn_readfirstlane((int)(unsigned)(uintptr_t)lds);
    const int aoff = lds_byte(wr * 64 + fr, fq * 8), boff = lds_byte(wc * 32 + fr, fq * 8);
    constexpr int KOFF = 1024;
#define PG8_SA(b, h) (((b) * 2 + (h)) * HTB)
#define PG8_SB(b, h) ((4 + (b) * 2 + (h)) * HTB)
#define PG8_STAGE_B(bufoff, gbase) do { _Pragma("unroll") for (int _i = 0; _i < 2; ++_i) glds_s((const char*)(gbase), voffB[_i], ldsbase + (unsigned)(bufoff) + ldsw + (unsigned)(_i * 8192)); } while (0)
#define PG8_STAGE_A(bufoff, gbase, o) do { _Pragma("unroll") for (int _i = 0; _i < 2; ++_i) glds_s((const char*)(gbase), (o)[_i], ldsbase + (unsigned)(bufoff) + ldsw + (unsigned)(_i * 8192)); } while (0)
#define PG8_LD8(p) __builtin_shufflevector(*(const LAS v4i32*)(p), *(const LAS v4i32*)((p) + KOFF), 0, 1, 2, 3, 4, 5, 6, 7)
#define PG8_LDA8(dst, b, h) do { _Pragma("unroll") for (int m = 0; m < 4; ++m) dst[m] = PG8_LD8(lds + PG8_SA(b, h) + aoff + m * 2048); } while (0)
#define PG8_LDB8(dst, b, h) do { _Pragma("unroll") for (int n = 0; n < 2; ++n) dst[n] = PG8_LD8(lds + PG8_SB(b, h) + boff + n * 2048); } while (0)
#define PG8_MMA8(ai, bj, A8, B8) do { __builtin_amdgcn_s_setprio(1); _Pragma("unroll") for (int m = 0; m < 4; ++m) _Pragma("unroll") for (int n = 0; n < 2; ++n) \
        asm volatile("v_mfma_scale_f32_16x16x128_f8f6f4 %0, %1, %2, %0, %3, %4 op_sel_hi:[0,0,0]" : "+v"(acc[ai][bj][m][n]) : "v"(B8[n]), "v"(A8[m]), "v"(sc_w), "v"(sc_a)); \
        __builtin_amdgcn_s_setprio(0); } while (0)
#define PG8_LDA(dst, b, h) do { _Pragma("unroll") for (int m = 0; m < 4; ++m) _Pragma("unroll") for (int k = 0; k < 2; ++k) dst[m][k] = *(const LAS bf16x8*)(lds + PG8_SA(b, h) + aoff + m * 2048 + k * KOFF); } while (0)
#define PG8_LDB(dst, b, h) do { _Pragma("unroll") for (int n = 0; n < 2; ++n) _Pragma("unroll") for (int k = 0; k < 2; ++k) dst[n][k] = *(const LAS bf16x8*)(lds + PG8_SB(b, h) + boff + n * 2048 + k * KOFF); } while (0)
#define PG8_MMA(ai, bj, At, Bt) do { __builtin_amdgcn_s_setprio(1); _Pragma("unroll") for (int m = 0; m < 4; ++m) _Pragma("unroll") for (int n = 0; n < 2; ++n) _Pragma("unroll") for (int k = 0; k < 2; ++k) \
        acc[ai][bj][m][n] = __builtin_amdgcn_mfma_f32_16x16x32_bf16(Bt[n][k], At[m][k], acc[ai][bj][m][n], 0, 0, 0); __builtin_amdgcn_s_setprio(0); } while (0)
#define PG8_WAIT_V(n) asm volatile("s_waitcnt vmcnt(" #n ")" ::: "memory")
#define PG8_WAIT_L(n) asm volatile("s_waitcnt lgkmcnt(" #n ")" ::: "memory")
#define PG8_BAR __builtin_amdgcn_s_barrier()
#define PG8_SCHED __builtin_amdgcn_sched_barrier(0)
#define PG8_SETOFF(o, u) do { _Pragma("unroll") for (int _h = 0; _h < 2; ++_h) _Pragma("unroll") for (int _i = 0; _i < 2; ++_i) \
        (o)[_h][_i] = GATHER ? ((unsigned)S.arow(u, _h * HALF + sR[_i]) * (unsigned)(K * 2) + (unsigned)(sC[_i] * 2)) : (unsigned)(((_h * HALF + sR[_i]) * K + sC[_i]) * 2); } while (0)
    Unit cur, nxt; int ui = 0;
    if (!S.next(0, cur)) return;
    unsigned offA[2][2], noffA[2][2];
    PG8_SETOFF(offA, cur);
    f32x4 acc[2][2][4][2];
#pragma unroll
    for (int a = 0; a < 2; ++a)
#pragma unroll
        for (int b = 0; b < 2; ++b)
#pragma unroll
            for (int m = 0; m < 4; ++m)
#pragma unroll
                for (int n = 0; n < 2; ++n) acc[a][b][m][n] = (f32x4){0.f, 0.f, 0.f, 0.f};
    bf16x8 At[4][2], B0[2][2], B1[2][2];
    v8i32 At8[4], B08[2], B18[2];
    int sc_w = F8_SC_W, sc_a = F8_SC_ACT; asm volatile("" : "+v"(sc_w), "+v"(sc_a));
    const char* cA = GATHER ? (const char*)g.A : (const char*)g.A + (size_t)cur.pm * tstep; const char* cB = (const char*)g.Bt + (size_t)cur.pn * tstep;
    PG8_STAGE_B(PG8_SB(0, 0), cB); PG8_STAGE_B(PG8_SB(0, 1), cB + hstep); PG8_STAGE_A(PG8_SA(0, 0), cA, offA[0]); PG8_STAGE_A(PG8_SA(0, 1), cA, offA[1]);
    if (wr == 1) PG8_BAR;
    PG8_WAIT_V(2); PG8_BAR;
    PG8_STAGE_B(PG8_SB(1, 0), cB + kstep); PG8_STAGE_A(PG8_SA(1, 0), cA + kstep, offA[0]); PG8_STAGE_B(PG8_SB(1, 1), cB + hstep + kstep);
    PG8_WAIT_V(6); PG8_BAR;
    for (;;) {
        const bool has_next = S.next(ui + 1, nxt);
        if (GATHER) { if (has_next) { PG8_SETOFF(noffA, nxt); } else {
#pragma unroll
            for (int h = 0; h < 2; ++h)
#pragma unroll
                for (int i = 0; i < 2; ++i) noffA[h][i] = offA[h][i]; } }
        const char* nA = GATHER ? cA : (has_next ? (const char*)g.A + (size_t)nxt.pm * tstep : cA); const char* nB = has_next ? (const char*)g.Bt + (size_t)nxt.pn * tstep : cB;
        for (int t = 0; t < nt; t += 2) {
            const bool last = (t == nt - 2);
            const char* a1 = cA + (size_t)(t + 1) * kstep;
            const char* a2 = last ? nA : cA + (size_t)(t + 2) * kstep; const char* b2 = last ? nB : cB + (size_t)(t + 2) * kstep;
            const char* a3 = a2 + kstep; const char* b3 = b2 + kstep;
            unsigned o2[2][2];
#pragma unroll
            for (int h = 0; h < 2; ++h)
#pragma unroll
                for (int i = 0; i < 2; ++i) o2[h][i] = (GATHER && last) ? noffA[h][i] : offA[h][i];
            if constexpr (F8) {
            PG8_LDB8(B08, 0, 0); PG8_LDB8(B18, 0, 1); PG8_SCHED; PG8_LDA8(At8, 0, 0); PG8_STAGE_A(PG8_SA(1, 1), a1, offA[1]);
            PG8_WAIT_V(8); PG8_WAIT_L(0); PG8_BAR; PG8_MMA8(0, 0, At8, B08); PG8_MMA8(0, 1, At8, B18); PG8_BAR; PG8_SCHED;
            PG8_LDA8(At8, 0, 1); PG8_STAGE_B(PG8_SB(0, 0), b2); PG8_STAGE_B(PG8_SB(0, 1), b2 + hstep); PG8_STAGE_A(PG8_SA(0, 0), a2, o2[0]);
            PG8_WAIT_V(8); PG8_WAIT_L(0); PG8_BAR; PG8_MMA8(1, 0, At8, B08); PG8_MMA8(1, 1, At8, B18); PG8_BAR; PG8_SCHED;
            PG8_LDB8(B08, 1, 0); PG8_LDB8(B18, 1, 1); PG8_SCHED; PG8_LDA8(At8, 1, 0); PG8_STAGE_A(PG8_SA(0, 1), a2, o2[1]);
            PG8_WAIT_V(8); PG8_WAIT_L(0); PG8_BAR; PG8_MMA8(0, 0, At8, B08); PG8_MMA8(0, 1, At8, B18); PG8_BAR; PG8_SCHED;
            PG8_LDA8(At8, 1, 1); PG8_STAGE_B(PG8_SB(1, 0), b3); PG8_STAGE_B(PG8_SB(1, 1), b3 + hstep); PG8_STAGE_A(PG8_SA(1, 0), a3, o2[0]);
            PG8_WAIT_V(8); PG8_WAIT_L(0); PG8_BAR; PG8_MMA8(1, 0, At8, B08); PG8_MMA8(1, 1, At8, B18); PG8_BAR; PG8_SCHED;
            } else {
            PG8_LDB(B0, 0, 0); PG8_LDB(B1, 0, 1); PG8_SCHED; PG8_LDA(At, 0, 0); PG8_STAGE_A(PG8_SA(1, 1), a1, offA[1]);
            PG8_WAIT_V(8); PG8_WAIT_L(0); PG8_BAR; PG8_MMA(0, 0, At, B0); PG8_MMA(0, 1, At, B1); PG8_BAR; PG8_SCHED;
            PG8_LDA(At, 0, 1); PG8_STAGE_B(PG8_SB(0, 0), b2); PG8_STAGE_B(PG8_SB(0, 1), b2 + hstep); PG8_STAGE_A(PG8_SA(0, 0), a2, o2[0]);
            PG8_WAIT_V(8); PG8_WAIT_L(0); PG8_BAR; PG8_MMA(1, 0, At, B0); PG8_MMA(1, 1, At, B1); PG8_BAR; PG8_SCHED;
            PG8_LDB(B0, 1, 0); PG8_LDB(B1, 1, 1); PG8_SCHED; PG8_LDA(At, 1, 0); PG8_STAGE_A(PG8_SA(0, 1), a2, o2[1]);
            PG8_WAIT_V(8); PG8_WAIT_L(0); PG8_BAR; PG8_MMA(0, 0, At, B0); PG8_MMA(0, 1, At, B1); PG8_BAR; PG8_SCHED;
            PG8_LDA(At, 1, 1); PG8_STAGE_B(PG8_SB(1, 0), b3); PG8_STAGE_B(PG8_SB(1, 1), b3 + hstep); PG8_STAGE_A(PG8_SA(1, 0), a3, o2[0]);
            PG8_WAIT_V(8); PG8_WAIT_L(0); PG8_BAR; PG8_MMA(1, 0, At, B0); PG8_MMA(1, 1, At, B1); PG8_BAR; PG8_SCHED;
            }
        }
        if constexpr (ALIGN_EPI) { if (wr == 0) PG8_BAR; }
        if constexpr (F8) asm volatile("s_nop 15\n\ts_nop 15" ::: "memory");
        E(acc, cur, wr, wc, fr, fq);
        if (!has_next) break;
#pragma unroll
        for (int a = 0; a < 2; ++a)
#pragma unroll
            for (int b = 0; b < 2; ++b)
#pragma unroll
                for (int m = 0; m < 4; ++m)
#pragma unroll
                    for (int n = 0; n < 2; ++n) { f32x2 z0, z1; asm volatile("v_mov_b64 %0, 0\n\tv_mov_b64 %1, 0" : "=v"(z0), "=v"(z1)); acc[a][b][m][n] = (f32x4){z0[0], z0[1], z1[0], z1[1]}; }
        cur = nxt; cA = nA; cB = nB; ++ui;
#pragma unroll
        for (int h = 0; h < 2; ++h)
#pragma unroll
            for (int i = 0; i < 2; ++i) offA[h][i] = noffA[h][i];
        if constexpr (ALIGN_EPI) { if (wr == 1) PG8_BAR; }
    }
    PG8_WAIT_V(0);
    if constexpr (!ALIGN_EPI) { if (wr == 0) PG8_BAR; }
    PG8_BAR;
#undef PG8_SA
#undef PG8_SB
#undef PG8_STAGE_A
#undef PG8_STAGE_B
#undef PG8_LDA
#undef PG8_LDA8
#undef PG8_LD8
#undef PG8_LDB8
#undef PG8_MMA8
#undef PG8_LDB
#undef PG8_MMA
#undef PG8_WAIT_V
#undef PG8_WAIT_L
#undef PG8_BAR
#undef PG8_SCHED
#undef PG8_SETOFF
}
}

#define XB_TMO      128
#define XB_XCNT(j)  (256  + 64 * (j))
#define XB_XSUB(j)  (1280 + 64 * (j))
#define XB_XGEN(j)  (2304 + 64 * (j))
#define XB_TOP      3328
#define XB_TOPGEN   3392
#define XCD_BAR_WORDS 3456
#define XB_SPIN_CAP (1u << 18)
__device__ __forceinline__ unsigned xb_ld(unsigned* p)              { return __hip_atomic_load(p, __ATOMIC_RELAXED, __HIP_MEMORY_SCOPE_AGENT); }
__device__ __forceinline__ unsigned xb_add(unsigned* p, unsigned v) { return __hip_atomic_fetch_add(p, v, __ATOMIC_RELAXED, __HIP_MEMORY_SCOPE_AGENT); }
__device__ __forceinline__ unsigned xb_xcc_id() { return (unsigned)__builtin_amdgcn_s_getreg((3 << 11) | 20) & 0xFu; }
#define XB_SPIN(cond, bar) do { unsigned _sp = 0; while (cond) { __builtin_amdgcn_s_sleep(1); \
    if ((++_sp & 255u) == 0u) { if (xb_ld(&(bar)[XB_TMO])) break; if (_sp > XB_SPIN_CAP) { atomicAdd(&(bar)[XB_TMO], 1u); break; } } } } while (0)
struct XcdBarrier { unsigned* bar; unsigned x; volatile LAS unsigned* st; };
__device__ __forceinline__ XcdBarrier xcd_barrier_post(unsigned* bar, volatile LAS unsigned* st) {
    XcdBarrier b; b.bar = bar; b.x = xb_xcc_id(); b.st = st;
    if (threadIdx.x == 0) (void)xb_add(&bar[XB_XCNT(b.x)], 1u);
    return b;
}
__device__ __forceinline__ void xcd_barrier_complete(unsigned* bar, unsigned x, unsigned& nloc, unsigned& nx) {
    const unsigned G = gridDim.x * gridDim.y * gridDim.z;
    unsigned sum, cnt, mine, sp = 0u;
    for (;;) {
        sum = 0u; cnt = 0u; mine = 0u;
#pragma unroll 1
        for (unsigned j = 0; j < 16; ++j) { const unsigned c = xb_ld(&bar[XB_XCNT(j)]); sum += c; cnt += (c > 0u) ? 1u : 0u; mine = (j == x) ? c : mine; }
        if (sum == G) break;
        __builtin_amdgcn_s_sleep(1);
        if ((++sp & 255u) == 0u) { if (xb_ld(&bar[XB_TMO])) break; if (sp > XB_SPIN_CAP) { atomicAdd(&bar[XB_TMO], 1u); break; } }
    }
    nloc = mine > 0u ? mine : 1u; nx = cnt > 0u ? cnt : 1u;
}
__device__ __forceinline__ void xcd_barrier(const XcdBarrier& b) {
    asm volatile("s_waitcnt vmcnt(0)" ::: "memory");
    __syncthreads();
    if (threadIdx.x == 0) {
        unsigned* bar = b.bar;
        __builtin_amdgcn_s_waitcnt(0);
        unsigned nloc = b.st[0], nx = b.st[1];
        if (nloc == 0u) { xcd_barrier_complete(bar, b.x, nloc, nx); b.st[0] = nloc; b.st[1] = nx; }
        const unsigned old = xb_add(&bar[XB_XSUB(b.x)], 1u);
        const unsigned gen = old / nloc;
        if (old + 1u == (gen + 1u) * nloc) {
            __builtin_amdgcn_fence(__ATOMIC_RELEASE, "agent");
            asm volatile("s_waitcnt vmcnt(0)" ::: "memory");
            const unsigned og = xb_add(&bar[XB_TOP], 1u);
            const unsigned tg = og / nx;
            if (og + 1u == (tg + 1u) * nx) xb_add(&bar[XB_TOPGEN], 1u);
            else XB_SPIN(xb_ld(&bar[XB_TOPGEN]) == tg, bar);
            __builtin_amdgcn_fence(__ATOMIC_ACQUIRE, "agent");
            xb_add(&bar[XB_XGEN(b.x)], 1u);
            asm volatile("s_waitcnt vmcnt(0)" ::: "memory");
        } else {
            XB_SPIN(xb_ld(&bar[XB_XGEN(b.x)]) == gen, bar);
            __builtin_amdgcn_fence(__ATOMIC_ACQUIRE, "agent");
            asm volatile("s_waitcnt vmcnt(0)" ::: "memory");
        }
    }
    __syncthreads();
}

struct Args {
    const float* in[24]; float* out; unsigned char* ws; int ph_lo, ph_hi;
};
struct Ctx {
    LAS unsigned char* lds;
    int tid, lane, wave, vcu, G;
    const Args* a;
};
__device__ __forceinline__ Ctx launder(const Ctx& C) {
    Ctx P = C; int t = C.tid; asm volatile("" : "+v"(t)); P.tid = t; P.lane = t & 63; P.wave = __builtin_amdgcn_readfirstlane(t >> 6);
    int v = C.vcu, g = C.G; asm volatile("" : "+s"(v), "+s"(g)); P.vcu = v; P.G = g;
    unsigned lo = (unsigned)(uintptr_t)C.lds; asm volatile("" : "+s"(lo)); P.lds = (LAS unsigned char*)(uintptr_t)lo;
    return P;
}
enum { I_X = 0, I_C, I_WADA, I_BADA, I_NMIX, I_NFFN, I_NFIN, I_RELB, I_EWIN, I_ELAM, I_ESUBLN, I_EGK2, I_EBGK, I_EGLAN, I_EWOUT, I_OWIN, I_OWOUT,
       I_RGW, I_RGB, I_REW, I_REB, I_WG, I_WU, I_WDN };

__device__ __forceinline__ float wave_sum(float v) {
#pragma unroll
    for (int o = 1; o < 64; o <<= 1) v += __shfl_xor(v, o);
    return v;
}
template <int CTRL> __device__ __forceinline__ float dpp_mov(float v) { return __builtin_bit_cast(float, __builtin_amdgcn_update_dpp(0, __builtin_bit_cast(int, v), CTRL, 0xf, 0xf, true)); }
__device__ __forceinline__ float sum8_dpp(float v) { v += dpp_mov<0xB1>(v); v += dpp_mov<0x4E>(v); v += dpp_mov<0x141>(v); return v; }
__device__ __forceinline__ float sum16_dpp(float v) { v = sum8_dpp(v); v += dpp_mov<0x140>(v); return v; }

__device__ __forceinline__ float reduce4(const float (&v)[4], int) {
    float a0 = v[0], a2 = v[2], a1 = v[1], a3 = v[3];
    swap32(a0, a2); swap32(a1, a3);
    float A0 = a0 + a2, A1 = a1 + a3;
    swap16(A0, A1);
    const float c = A0 + A1;
    return sum16_dpp(c);
}

__device__ __forceinline__ void transpose_item(const float* W, int ldw, int K, bf16* WT, size_t drow0, LAS float* scr, int k0, int n0, int lane) {
#pragma unroll 8
    for (int i = 0; i < 32; ++i) { const int kk = 2 * i + (lane >> 5); scr[kk * 33 + (lane & 31)] = W[(size_t)(k0 + kk) * ldw + n0 + (lane & 31)]; }
    LDS_WAIT(); asm volatile("" ::: "memory");
    const int c = lane & 7;
#pragma unroll
    for (int j = 0; j < 4; ++j) { const int n = (lane >> 3) + 8 * j; const LAS float* s = scr + (8 * c) * 33 + n;
        u32x4 o; o.x = pk2(s[0 * 33], s[1 * 33]); o.y = pk2(s[2 * 33], s[3 * 33]); o.z = pk2(s[4 * 33], s[5 * 33]); o.w = pk2(s[6 * 33], s[7 * 33]);
        *(u32x4*)(WT + (drow0 + n) * K + k0 + 8 * c) = o; }
    LDS_WAIT(); asm volatile("" ::: "memory");
}
__device__ __forceinline__ void transpose_item8w(const float* W, int ldw, int K, unsigned char* WT8, size_t drow0, LAS float* scr, int k0, int n0, int lane) {
#pragma unroll 16
    for (int i = 0; i < 64; ++i) { const int kk = 2 * i + (lane >> 5); scr[kk * 33 + (lane & 31)] = __builtin_nontemporal_load(W + (size_t)(k0 + kk) * ldw + n0 + (lane & 31)); }
    LDS_WAIT(); asm volatile("" ::: "memory");
    const int n = lane & 31, kh = lane >> 5;
    unsigned char* op = WT8 + (drow0 + n) * K + k0 + 64 * kh;
#pragma unroll
    for (int q = 0; q < 4; ++q) { u32x4 o;
#pragma unroll
        for (int w = 0; w < 4; ++w) { const LAS float* p = scr + (64 * kh + 16 * q + 4 * w) * 33 + n; o[w] = pk4_fp8(p[0] * F8_W_SCALE, p[33] * F8_W_SCALE, p[66] * F8_W_SCALE, p[99] * F8_W_SCALE); }
        *(u32x4*)(op + 16 * q) = o; }
    LDS_WAIT(); asm volatile("" ::: "memory");
}
__device__ __forceinline__ void transpose_item8(const float* W, int ldw, int K, unsigned char* WT8, size_t drow0, LAS float* scr, int k0, int n0, int lane) {
#pragma unroll 8
    for (int i = 0; i < 32; ++i) { const int kk = 2 * i + (lane >> 5); scr[kk * 33 + (lane & 31)] = W[(size_t)(k0 + kk) * ldw + n0 + (lane & 31)]; }
    LDS_WAIT(); asm volatile("" ::: "memory");
    const int c = lane & 7;
#pragma unroll
    for (int j = 0; j < 4; ++j) { const int n = (lane >> 3) + 8 * j; const LAS float* s = scr + (8 * c) * 33 + n;
        u32x2 o; o.x = pk4_fp8(s[0 * 33] * F8_W_SCALE, s[1 * 33] * F8_W_SCALE, s[2 * 33] * F8_W_SCALE, s[3 * 33] * F8_W_SCALE); o.y = pk4_fp8(s[4 * 33] * F8_W_SCALE, s[5 * 33] * F8_W_SCALE, s[6 * 33] * F8_W_SCALE, s[7 * 33] * F8_W_SCALE);
        *(u32x2*)(WT8 + (drow0 + n) * K + k0 + 8 * c) = o; }
    LDS_WAIT(); asm volatile("" ::: "memory");
}
__device__ __forceinline__ void p0_prologue(const Ctx& C) {
    LAS float* sc = (LAS float*)(C.lds);
    LAS float* part = (LAS float*)(C.lds + 32768);
    for (int i = C.tid; i < 8192; i += 512) { const float cv = C.a->in[I_C][i]; sc[i] = cv / (1.f + __expf(-cv)); }
    __syncthreads();
    for (int it = blockIdx.x; it < 384; it += C.G) {
        const int l = it / 96, e0 = (it % 96) * 64;
        float acc[8];
#pragma unroll
        for (int b = 0; b < 8; ++b) acc[b] = 0.f;
        const float* wp = C.a->in[I_WADA] + ((size_t)l * 1024 + C.wave * 128) * 6144 + e0 + C.lane;
#pragma unroll 16
        for (int dd = 0; dd < 128; ++dd) { const float w = __builtin_nontemporal_load(wp + (size_t)dd * 6144);
#pragma unroll
            for (int b = 0; b < 8; ++b) acc[b] += sc[b * 1024 + C.wave * 128 + dd] * w; }
#pragma unroll
        for (int b = 0; b < 8; ++b) part[(C.wave * 8 + b) * 64 + C.lane] = acc[b];
        __syncthreads();
        { const int b = C.tid >> 6, col = C.tid & 63; float s = C.a->in[I_BADA][l * 6144 + e0 + col];
#pragma unroll
          for (int w = 0; w < 8; ++w) s += part[(w * 8 + b) * 64 + col];
          ((float*)(C.a->ws + WS_MOD))[((size_t)l * 8 + b) * 6144 + e0 + col] = s; }
        __syncthreads();
    }
    const int gt = blockIdx.x * 512 + C.tid, NGT = C.G * 512;
    for (int i = gt; i < 4 * 36 * 1024; i += NGT) { const int l = i / (36 * 1024), jj = (i >> 10) % 36, d = i & 1023;
        const float v = jj < 4 ? C.a->in[I_RGW][((size_t)l * 1024 + d) * 4 + jj] : C.a->in[I_REW][((size_t)l * 1024 + d) * 32 + (jj - 4)];
        ((bf16*)(C.a->ws + WS_WR))[i] = (bf16)f2bf(v); }
    for (int i = gt; i < 2 * 16 * 1024; i += NGT) { const int ii = i >> 14, r = (i >> 10) & 15, d = i & 1023;
        ((bf16*)(C.a->ws + WS_WBG))[i] = (bf16)f2bf(C.a->in[I_EWIN][((size_t)ii * 1024 + d) * 3088 + 3072 + r]); }
    for (int i = gt; i < 256; i += NGT) ((unsigned*)(C.a->ws + WS_H8 + (size_t)NTOK * DM))[i] = 0u;
    LAS float* scr = (LAS float*)(C.lds + C.wave * 16896);
    const int gw = C.vcu * 8 + C.wave, NGW = C.G * 8;
    constexpr int I_IN = 16 * 96, I_OUT = 16 * 16, I_E = 128;
    constexpr int NITEMS = 4 * I_IN + 4 * I_OUT + 3 * 128 * I_E;
    for (int it = gw; it < NITEMS; it += NGW) {
        int r = it;
        if (r < 4 * I_IN) { const int l = r / I_IN, q = r % I_IN, kb = q / 96, nb = q % 96; const int i = l >> 1;
            const float* W = (l & 1) ? C.a->in[I_OWIN] + (size_t)i * 1024 * 3072 : C.a->in[I_EWIN] + (size_t)i * 1024 * 3088;
            transpose_item(W, (l & 1) ? 3072 : 3088, 1024, ((bf16*)(C.a->ws + WS_WIN)) + (size_t)l * 3072 * 1024, (size_t)nb * 32, scr, kb * 64, nb * 32, C.lane); continue; }
        r -= 4 * I_IN;
        if (r < 4 * I_OUT) { const int l = r / I_OUT, q = r % I_OUT, kb = q / 32, nb = q % 32; const int i = l >> 1;
            const float* W = ((l & 1) ? C.a->in[I_OWOUT] : C.a->in[I_EWOUT]) + (size_t)i * 1024 * 1024;
            transpose_item8w(W, 1024, 1024, (unsigned char*)(C.a->ws + WS_WOUT) + (size_t)l * 1024 * 1024, (size_t)nb * 32, scr, kb * 128, nb * 32, C.lane); continue; }
        r -= 4 * I_OUT;
        const int job = r / I_E, q = r % I_E, typ = job / 128, le = job % 128;
        if (typ < 2) { const int kb = q / 16, nb = q % 16, n0 = nb * 32;
            const float* W = C.a->in[typ == 0 ? I_WG : I_WU] + (size_t)le * 1024 * 512;
            const size_t drow0 = (size_t)(n0 >> 7) * 256 + (n0 & 127) + (typ ? 128 : 0);
            transpose_item8w(W, 512, 1024, ((unsigned char*)(C.a->ws + WS_WGU)) + (size_t)le * 1024 * 1024, drow0, scr, kb * 128, n0, C.lane);
        } else { const int kb = q / 32, nb = q % 32;
            const float* W = C.a->in[I_WDN] + (size_t)le * 512 * 1024;
            transpose_item8w(W, 1024, 512, ((unsigned char*)(C.a->ws + WS_WD)) + (size_t)le * 1024 * 512, (size_t)nb * 32, scr, kb * 128, nb * 32, C.lane); }
    }
}

template <bool COMBINE, int EXTRA, bool FINAL, bool XIN_F32>
__device__ __forceinline__ void norm_phase(const Ctx& C, int l, const float* xin, const float* normw, int shift_chunk, const bf16* WX) {
    constexpr int NX = EXTRA == 1 ? 16 : (EXTRA == 2 ? 36 : 0);
    constexpr int NR = 4;
    constexpr int NCB = (NX + 15) / 16;
    constexpr int WPITCH = 2064;
    LAS unsigned char* wl = C.lds;
    LAS unsigned char* atile = C.lds + 99072 + C.wave * 4160;
    LAS float* lgbase = (LAS float*)(C.lds + 99072 + 8 * 4160);
    LAS int* ent_p = (LAS int*)(C.lds + 99072 + 8 * 4160 + 8 * 768);
    LAS int* ent_e = ent_p + 256;
    LAS float* ent_w = (LAS float*)(ent_e + 256);
    LAS int* lcnt = (LAS int*)(ent_w + 256);
    LAS int* lbase = lcnt + 32;
    LAS int* erank = lbase + 32;
    if (EXTRA) { for (int i = C.tid; i < NCB * 16 * 128; i += 512) { const int row = i >> 7, c16 = i & 127;
            *(LAS u32x4*)(wl + row * WPITCH + c16 * 16) = row < NX ? ((const u32x4*)WX)[i] : (u32x4){0u, 0u, 0u, 0u}; }
        if (EXTRA == 2) { if (C.tid < 32) lcnt[C.tid] = 0; }
        __syncthreads(); }
    const int gw = C.vcu * 8 + C.wave, NGW = C.G * 8, lane = C.lane;
    float* X = C.a->out; bf16* XBp = (bf16*)(C.a->ws + WS_XB); bf16* Hb = (bf16*)(C.a->ws + WS_H); const bf16* Yb = (const bf16*)(C.a->ws + WS_QKV); const float* MOD = (const float*)(C.a->ws + WS_MOD);
    int pass = 0;
    for (int rg = gw; rg < NTOK / NR; rg += NGW, ++pass) {
        const int t0 = rg * NR, b = t0 >> 12;
        f32x4 v[NR][4];
#pragma unroll
        for (int r = 0; r < NR; ++r)
#pragma unroll
            for (int j = 0; j < 4; ++j) {
                if (XIN_F32) v[r][j] = *(const f32x4*)(xin + (size_t)(t0 + r) * DM + 4 * lane + 256 * j);
                else { const u32x2 xr = *(const u32x2*)(XBp + (size_t)(t0 + r) * DM + 4 * lane + 256 * j); v[r][j] = (f32x4){bflo(xr.x), bfhi(xr.x), bflo(xr.y), bfhi(xr.y)}; } }
        if (COMBINE) {
            const float* g2p = MOD + ((size_t)((FINAL ? 3 : l - 1) * 8 + b)) * 6144 + 5 * 1024;
            int y0[NR][4], y1[NR][4]; f32x4 g2[4];
#pragma unroll
            for (int j = 0; j < 4; ++j) { g2[j] = *(const f32x4*)(g2p + 4 * lane + 256 * j);
#pragma unroll
                for (int r = 0; r < NR; ++r) { y0[r][j] = *(const int*)((const unsigned char*)Yb + (size_t)(2 * (t0 + r)) * DM + 4 * lane + 256 * j);
                    y1[r][j] = *(const int*)((const unsigned char*)Yb + (size_t)(2 * (t0 + r) + 1) * DM + 4 * lane + 256 * j); } }
#pragma unroll
            for (int j = 0; j < 4; ++j)
#pragma unroll
                for (int r = 0; r < NR; ++r) {
                    const f32x2 a0 = __builtin_amdgcn_cvt_pk_f32_fp8(y0[r][j], false), a1 = __builtin_amdgcn_cvt_pk_f32_fp8(y0[r][j], true), b0 = __builtin_amdgcn_cvt_pk_f32_fp8(y1[r][j], false), b1 = __builtin_amdgcn_cvt_pk_f32_fp8(y1[r][j], true);
                    f32x4 ys; ys[0] = (a0[0] + b0[0]) * (1.f / 32.f); ys[1] = (a0[1] + b0[1]) * (1.f / 32.f); ys[2] = (a1[0] + b1[0]) * (1.f / 32.f); ys[3] = (a1[1] + b1[1]) * (1.f / 32.f);
                    v[r][j] = v[r][j] + g2[j] * ys; }
            if (!FINAL) {
#pragma unroll
                for (int j = 0; j < 4; ++j)
#pragma unroll
                    for (int r = 0; r < NR; ++r) { u32x2 xo; xo.x = cvt_pk_bf16(v[r][j][0], v[r][j][1]); xo.y = cvt_pk_bf16(v[r][j][2], v[r][j][3]); *(u32x2*)(XBp + (size_t)(t0 + r) * DM + 4 * lane + 256 * j) = xo; } }
        }
        float ss[NR];
#pragma unroll
        for (int r = 0; r < NR; ++r) { float s_ = 0.f;
#pragma unroll
            for (int j = 0; j < 4; ++j) s_ += (v[r][j][0] * v[r][j][0] + v[r][j][1] * v[r][j][1]) + (v[r][j][2] * v[r][j][2] + v[r][j][3] * v[r][j][3]);
            ss[r] = s_; }
        const float red = reduce4(ss, lane);
        const float rstd_l = 1.0f / sqrtf(red * (1.f / DM) + EPS);
        float rs[NR];
#pragma unroll
        for (int r = 0; r < NR; ++r) rs[r] = __builtin_bit_cast(float, __builtin_amdgcn_readlane(__builtin_bit_cast(int, rstd_l), 16 * r));
        if (FINAL) {
#pragma unroll
            for (int j = 0; j < 4; ++j) { const f32x4 gn = *(const f32x4*)(normw + 4 * lane + 256 * j);
#pragma unroll
                for (int r = 0; r < NR; ++r) v[r][j] = v[r][j] * rs[r] * gn; }
#pragma unroll
            for (int j = 0; j < 4; ++j)
#pragma unroll
                for (int r = 0; r < NR; ++r) *(f32x4*)(X + (size_t)(t0 + r) * DM + 4 * lane + 256 * j) = v[r][j];
            continue;
        }
        u32x2 hp[NR][4];
        const float* mp = MOD + ((size_t)(l * 8 + b)) * 6144 + (size_t)shift_chunk * 1024;
#pragma unroll
        for (int j = 0; j < 4; ++j) { const f32x4 sh = *(const f32x4*)(mp + 4 * lane + 256 * j), scl = *(const f32x4*)(mp + 1024 + 4 * lane + 256 * j);
            const f32x4 gn = *(const f32x4*)(normw + (size_t)l * DM + 4 * lane + 256 * j); const f32x4 cmb = gn * (scl + 1.0f);
#pragma unroll
            for (int r = 0; r < NR; ++r) v[r][j] = v[r][j] * rs[r] * cmb + sh; }
#pragma unroll
        for (int j = 0; j < 4; ++j) {
#pragma unroll
            for (int r = 0; r < NR; ++r) {
                u32x2 o; o.x = cvt_pk_bf16(v[r][j][0], v[r][j][1]); o.y = cvt_pk_bf16(v[r][j][2], v[r][j][3]); hp[r][j] = o;
                if (EXTRA == 2) *(unsigned*)(C.a->ws + WS_H8 + (size_t)(t0 + r) * DM + 4 * lane + 256 * j) = pk4_fp8(v[r][j][0] * F8_ACT_SCALE, v[r][j][1] * F8_ACT_SCALE, v[r][j][2] * F8_ACT_SCALE, v[r][j][3] * F8_ACT_SCALE);
                else *(u32x2*)(Hb + (size_t)(t0 + r) * DM + 4 * lane + 256 * j) = o; } }
        if (EXTRA) {
            LAS float* lgb = lgbase + C.wave * (NR * 48);
            const int l15 = lane & 15, quad = lane >> 4;
            f32x4 lacc[NCB > 0 ? NCB : 1];
#pragma unroll
            for (int cb = 0; cb < NCB; ++cb) lacc[cb] = (f32x4){0.f, 0.f, 0.f, 0.f};
#pragma unroll
            for (int half = 0; half < 2; ++half) {
#pragma unroll
                for (int r = 0; r < NR; ++r)
#pragma unroll
                    for (int jl = 0; jl < 2; ++jl) *(LAS u32x2*)(atile + r * 1040 + (4 * lane + 256 * jl) * 2) = hp[r][2 * half + jl];
                LDS_WAIT();
#pragma unroll 4
                for (int ks = 0; ks < 16; ++ks) { const bf16x8 af = *(const LAS bf16x8*)(atile + (l15 & 3) * 1040 + (8 * quad + 32 * ks) * 2);
#pragma unroll
                    for (int cb = 0; cb < NCB; ++cb) { const bf16x8 bfv = *(const LAS bf16x8*)(wl + (16 * cb + l15) * WPITCH + (512 * half + 8 * quad + 32 * ks) * 2);
                        lacc[cb] = __builtin_amdgcn_mfma_f32_16x16x32_bf16(af, bfv, lacc[cb], 0, 0, 0); } }
                LDS_WAIT();
            }
            if (quad == 0) {
#pragma unroll
                for (int cb = 0; cb < NCB; ++cb)
#pragma unroll
                    for (int jj = 0; jj < 4; ++jj) lgb[jj * 48 + 16 * cb + l15] = lacc[cb][jj]; }
            LDS_WAIT();
            float lg[NX > 0 ? NX : 1];
#pragma unroll
            for (int jj = 0; jj < NX; ++jj) lg[jj] = lgb[(lane >> 4) * 48 + jj];
            const int row = lane >> 4, tok = t0 + row;
            if (EXTRA == 1) {
                if ((lane & 15) == 0) { float* BGp = (float*)(C.a->ws + WS_BG);
#pragma unroll
                    for (int q = 0; q < 4; ++q) *(f32x4*)(BGp + (size_t)tok * 16 + 4 * q) = (f32x4){lg[4 * q], lg[4 * q + 1], lg[4 * q + 2], lg[4 * q + 3]}; }
            } else {
                float gl[4];
#pragma unroll
                for (int q = 0; q < 4; ++q) gl[q] = lg[q] + C.a->in[I_RGB][l * 4 + q];
                int gs = 0; float gm = gl[0];
#pragma unroll
                for (int q = 1; q < 4; ++q) if (gl[q] > gm) { gm = gl[q]; gs = q; }
                float gsum = 0.f;
#pragma unroll
                for (int q = 0; q < 4; ++q) gsum += __expf(gl[q] - gm);
                const float gval = 1.0f / gsum;
                float el[8];
#pragma unroll
                for (int q = 0; q < 8; ++q) { const float e0 = lg[4 + q], e1 = lg[12 + q], e2 = lg[20 + q], e3 = lg[28 + q];
                    el[q] = (gs == 0 ? e0 : (gs == 1 ? e1 : (gs == 2 ? e2 : e3))) + C.a->in[I_REB][l * 32 + gs * 8 + q]; }
                int i0 = 0; float m0 = el[0];
#pragma unroll
                for (int q = 1; q < 8; ++q) if (el[q] > m0) { m0 = el[q]; i0 = q; }
                int i1 = -1; float m1 = -3.0e38f;
#pragma unroll
                for (int q = 0; q < 8; ++q) if (q != i0 && el[q] > m1) { m1 = el[q]; i1 = q; }
                const float w0 = gval / (1.0f + __expf(m1 - m0)), w1 = gval - w0;
                if ((lane & 15) == 0) { const int ei = (pass * 8 + C.wave) * 8 + row * 2;
                    ent_p[ei] = tok * 2; ent_e[ei] = gs * 8 + i0; ent_w[ei] = w0;
                    ent_p[ei + 1] = tok * 2 + 1; ent_e[ei + 1] = gs * 8 + i1; ent_w[ei + 1] = w1; }
            }
        }
    }
    if (EXTRA == 2) {
        __syncthreads();
        const int npass_blk = (NTOK / NR - C.vcu * 8 + NGW - 1) / NGW;
        const int nent = npass_blk * 64;
        int* gcnt = (int*)(C.a->ws + WS_CTL) + CW_CNT + 64 * l;
        int* PL = (int*)(C.a->ws + WS_PLIST); float* WL = (float*)(C.a->ws + WS_WLIST);
        for (int i = C.tid; i < nent; i += 512) { const int p_ = i >> 6, w_ = (i >> 3) & 7; const bool valid = (C.vcu * 8 + w_ + p_ * NGW) < NTOK / NR;
            if (valid) erank[i] = atomicAdd((int*)&lcnt[ent_e[i]], 1); else erank[i] = -1; }
        __syncthreads();
        if (C.tid < 32) lbase[C.tid] = __hip_atomic_fetch_add(gcnt + C.tid, lcnt[C.tid], __ATOMIC_RELAXED, __HIP_MEMORY_SCOPE_AGENT);
        __syncthreads();
        for (int i = C.tid; i < nent; i += 512) { const int rk = erank[i]; if (rk >= 0) { const int e = ent_e[i]; const int pos = lbase[e] + rk;
            PL[(size_t)e * NTOK + pos] = ent_p[i]; WL[(size_t)e * NTOK + pos] = ent_w[i]; } }
    }
    __syncthreads();
}

typedef short v4i16_t __attribute__((ext_vector_type(4)));
__device__ __forceinline__ s16x4 vtr(const LAS unsigned char* p) { return __builtin_bit_cast(s16x4, __builtin_amdgcn_ds_read_tr16_b64_v4i16((LAS v4i16_t*)p)); }
__device__ __forceinline__ float pl32_other(float m, int hi) { float a = m, b = m; swap32(a, b); return hi ? a : b; }
__device__ __forceinline__ float pl32_max(float m) { float a = m, b = m; swap32(a, b); return fmaxf(a, b); }
__device__ __forceinline__ float pl32_sum(float m) { float a = m, b = m; swap32(a, b); return a + b; }
__device__ __forceinline__ int t5_bucket(int rel) { const int n = rel < 0 ? -rel : rel;
    const int bk = n < 8 ? n : (n < 12 ? 8 : (n < 16 ? 9 : (n < 23 ? 10 : (n < 32 ? 11 : (n < 46 ? 12 : (n < 64 ? 13 : (n < 91 ? 14 : 15)))))));
    return bk + (rel > 0 ? 16 : 0); }

__device__ __forceinline__ int kswz(int row, int c) { return row * 128 + ((c ^ ((row >> 1) & 7)) << 4); }

__device__ __forceinline__ void diffattn_unit(const Ctx& C, int l, int b, int h, int qb, float lam, float lam_init) {
    LAS unsigned char* lds = C.lds;
    const int tid = C.tid, lane = C.lane, wave = C.wave, r32 = lane & 31, hi = lane >> 5, qt = wave & 3, m = wave >> 2;
    const int i16 = lane & 15, q4 = i16 >> 2, p4 = i16 & 3, half16 = (lane >> 4) & 1;
    const size_t tokbase = (size_t)b * SEQ; const int q0 = qb * 128, c0 = q0 >> 6, ntile = c0 + 2, cw = c0 + (qt >> 1);
    LAS float* lut = (LAS float*)(lds + 131072);
    const float rb15 = C.a->in[I_RELB][15 * 4 + h], rbt = C.a->in[I_RELB][t5_bucket((tid < 255 ? tid : 254) - 191) * 4 + h];
    const float b15 = rb15 * LOG2E;
    if (tid < 255) lut[tid] = rbt * LOG2E - b15;
    const bf16* qp = ((bf16*)(C.a->ws + WS_QKV)) + (tokbase + q0 + 32 * qt + r32) * QKVW + E_AQ + h * 128 + m * 64 + 8 * hi;
    bf16x8 qr[4];
#pragma unroll
    for (int d0 = 0; d0 < 4; ++d0) qr[d0] = *(const bf16x8*)(qp + 16 * d0);
    unsigned koff[2], voff[2];
#pragma unroll
    for (int i = 0; i < 2; ++i) { const int p = wave * 128 + i * 64 + lane;
        { const int mm = p >> 9, pp = p & 511, row = pp >> 3, pc = pp & 7, c = pc ^ ((row >> 1) & 7); koff[i] = (unsigned)((row * QKVW + E_AK + h * 128 + mm * 64 + c * 8) * 2); }
        { const int blk = p >> 8, row = (p >> 2) & 63, c4 = p & 3; voff[i] = (unsigned)((row * QKVW + E_AV + h * 128 + blk * 32 + c4 * 8) * 2); } }
    const unsigned ldsb = (unsigned)__builtin_amdgcn_readfirstlane((int)(unsigned)(uintptr_t)lds) + (unsigned)wave * 2048u;
    const char* tilebase = (const char*)(C.a->ws + WS_QKV) + tokbase * (size_t)(QKVW * 2);
#define DA_DMA(j, bi) do { const char* tb_ = tilebase + (size_t)(j) * (64 * QKVW * 2); const unsigned db_ = ldsb + (unsigned)(bi) * 32768u; \
        pg8::glds_s(tb_, koff[0], db_); pg8::glds_s(tb_, koff[1], db_ + 1024u); pg8::glds_s(tb_, voff[0], db_ + 16384u); pg8::glds_s(tb_, voff[1], db_ + 16384u + 1024u); } while (0)
    f32x16 o[4];
#pragma unroll
    for (int k = 0; k < 4; ++k)
#pragma unroll
        for (int i = 0; i < 16; ++i) o[k][i] = 0.f;
    float lsum = 0.f;
    f32x16 negm;
#pragma unroll
    for (int i = 0; i < 16; ++i) negm[i] = b15;
    __syncthreads();
    DA_DMA(0, 0); DA_DMA(1, 1);
    asm volatile("s_waitcnt vmcnt(4)" ::: "memory");
    __builtin_amdgcn_s_barrier(); asm volatile("" ::: "memory");
#define DA_LDV(vb_, s) do { _Pragma("unroll") for (int k = 0; k < 4; ++k) { va[s][k][0] = vtr((vb_) + k * 4096 + (s) * 1024); va[s][k][1] = vtr((vb_) + k * 4096 + (s) * 1024 + 512); } } while (0)
#define DA_PVS(s) do { const bf16x8 pf = __builtin_bit_cast(bf16x8, pwh[s]); _Pragma("unroll") for (int k = 0; k < 4; ++k) { const s16x4 lo = va[s][k][0], hh = va[s][k][1]; \
                const bf16x8 vf = (bf16x8){lo[0], lo[1], lo[2], lo[3], hh[0], hh[1], hh[2], hh[3]}; o[k] = __builtin_amdgcn_mfma_f32_32x32x16_bf16(vf, pf, o[k], 0, 0, 0); } } while (0)
#define DA_PV(vb_) do { s16x4 va[4][4][2]; DA_LDV(vb_, 0); DA_LDV(vb_, 1); __builtin_amdgcn_sched_barrier(0); \
        DA_PVS(0); DA_LDV(vb_, 2); __builtin_amdgcn_sched_barrier(0); DA_PVS(1); DA_LDV(vb_, 3); __builtin_amdgcn_sched_barrier(0); DA_PVS(2); DA_PVS(3); } while (0)
    u32x4 pwh[4]; int pbi = -1;
#pragma unroll
    for (int s = 0; s < 4; ++s) pwh[s] = (u32x4){0u, 0u, 0u, 0u};
    for (int j = 0; j < ntile; ++j) {
        const int bi = j & 3;
        if (j + 2 < ntile) { DA_DMA(j + 2, (j + 2) & 3); }
        if (pbi >= 0) {
            const LAS unsigned char* vp = lds + pbi * 32768 + 16384 + half16 * 32 + p4 * 8 + (4 * hi + q4) * 64;
            DA_PV(vp); pbi = -1; }
        if (j <= cw) {
            const LAS unsigned char* kb = lds + bi * 32768 + m * 8192;
            bf16x8 ka[4][2];
#pragma unroll
            for (int d0 = 0; d0 < 4; ++d0) { const int c = 2 * d0 + hi; ka[d0][0] = *(const LAS bf16x8*)(kb + kswz(r32, c)); ka[d0][1] = *(const LAS bf16x8*)(kb + kswz(32 + r32, c)); }
            __builtin_amdgcn_sched_barrier(0);
            f32x16 s0 = negm, s1 = negm;
#pragma unroll
            for (int d0 = 0; d0 < 4; ++d0) {
                s0 = __builtin_amdgcn_mfma_f32_32x32x16_bf16(ka[d0][0], qr[d0], s0, 0, 0, 0); s1 = __builtin_amdgcn_mfma_f32_32x32x16_bf16(ka[d0][1], qr[d0], s1, 0, 0, 0); }
            if (j + 2 >= cw) { const int base = 64 * j - (q0 + 32 * qt + r32) + 191;
#pragma unroll
                for (int i = 0; i < 16; ++i) { const int kv = crow(i, hi); s0[i] += lut[base + kv]; s1[i] += lut[base + kv + 32]; } }
            float tm = fmaxf(fmaxf(s0[0], s0[1]), s1[0]);
#pragma unroll
            for (int i = 1; i < 16; ++i) tm = fmaxf(fmaxf(tm, s0[i]), s1[i]);
            tm = fmaxf(tm, s0[1]);
            tm = pl32_max(tm);
            if (__any(tm > 8.f) || j == 0) { const float dl = (j == 0) ? tm : fmaxf(tm, 0.f); const float f = ex2(-dl);
                lsum *= f;
#pragma unroll
                for (int k = 0; k < 4; ++k)
#pragma unroll
                    for (int i = 0; i < 16; ++i) o[k][i] *= f;
#pragma unroll
                for (int i = 0; i < 16; ++i) { s0[i] -= dl; s1[i] -= dl; negm[i] -= dl; } }
            float ps = 0.f;
#pragma unroll
            for (int i = 0; i < 16; ++i) { s0[i] = ex2(s0[i]); s1[i] = ex2(s1[i]); ps += s0[i] + s1[i]; }
            lsum += ps;
#pragma unroll
            for (int s = 0; s < 2; ++s) {
                pwh[s].x = cvt_pk_bf16(s0[8 * s + 0], s0[8 * s + 1]); pwh[s].y = cvt_pk_bf16(s0[8 * s + 2], s0[8 * s + 3]); pwh[s].z = cvt_pk_bf16(s0[8 * s + 4], s0[8 * s + 5]); pwh[s].w = cvt_pk_bf16(s0[8 * s + 6], s0[8 * s + 7]);
                pwh[2 + s].x = cvt_pk_bf16(s1[8 * s + 0], s1[8 * s + 1]); pwh[2 + s].y = cvt_pk_bf16(s1[8 * s + 2], s1[8 * s + 3]); pwh[2 + s].z = cvt_pk_bf16(s1[8 * s + 4], s1[8 * s + 5]); pwh[2 + s].w = cvt_pk_bf16(s1[8 * s + 6], s1[8 * s + 7]); }
            if (m == 0) { const LAS unsigned char* vb = lds + bi * 32768 + 16384 + half16 * 32 + p4 * 8 + (4 * hi + q4) * 64; DA_PV(vb); }
            else pbi = bi;
        }
        if (j + 2 < ntile) asm volatile("s_waitcnt vmcnt(4) lgkmcnt(0)" ::: "memory"); else asm volatile("s_waitcnt vmcnt(0) lgkmcnt(0)" ::: "memory");
        __builtin_amdgcn_s_barrier(); asm volatile("" ::: "memory");
    }
    if (pbi >= 0) { const LAS unsigned char* vp = lds + pbi * 32768 + 16384 + half16 * 32 + p4 * 8 + (4 * hi + q4) * 64; DA_PV(vp); }
    __syncthreads();
#undef DA_LDV
#undef DA_PVS
#undef DA_PV
#undef DA_DMA
    const float linv = 1.0f / pl32_sum(lsum);
    LAS float* ox = (LAS float*)lds + qt * 4096;
    if (m == 1) {
#pragma unroll
        for (int k = 0; k < 4; ++k)
#pragma unroll
            for (int i = 0; i < 16; ++i) ox[(k * 16 + i) * 64 + lane] = o[k][i] * linv;
    }
    __syncthreads();
    if (m == 0) {
        float ssq = 0.f;
#pragma unroll
        for (int k = 0; k < 4; ++k)
#pragma unroll
            for (int i = 0; i < 16; ++i) { const float v = o[k][i] * linv - lam * ox[(k * 16 + i) * 64 + lane]; o[k][i] = v; ssq += v * v; }
        ssq = pl32_sum(ssq);
        const float rstd = (1.0f / sqrtf(ssq * (1.f / 128.f) + EPS)) * (1.0f - lam_init) * F8_ACT_SCALE;
        unsigned char* op = (unsigned char*)(C.a->ws + WS_O) + (tokbase + q0 + 32 * qt + r32) * DM + h * 128;
        const float* sg = C.a->in[I_ESUBLN] + (l >> 1) * 128; unsigned pko[4][4];
#pragma unroll
        for (int k = 0; k < 4; ++k)
#pragma unroll
            for (int g = 0; g < 4; ++g) { const int dv = 32 * k + 8 * g + 4 * hi; const f32x4 gg = *(const f32x4*)(sg + dv);
                pko[k][g] = pk4_fp8(o[k][4 * g] * rstd * gg[0], o[k][4 * g + 1] * rstd * gg[1], o[k][4 * g + 2] * rstd * gg[2], o[k][4 * g + 3] * rstd * gg[3]); }
#pragma unroll
        for (int k = 0; k < 4; ++k)
#pragma unroll
            for (int g = 0; g < 4; ++g) { const int dv = 32 * k + 8 * g + 4 * hi; *(unsigned*)(op + dv) = pko[k][g]; }
    }
    __syncthreads();
}

__device__ __forceinline__ void gla_local_unit(const Ctx& C, int l, int b, int h, int oct) {
    LAS unsigned char* lds = C.lds;
    constexpr int PT = 144;
    constexpr int SET = 46080;
    LAS unsigned char* PP = lds + 2 * SET;
    LAS unsigned char* OUT = PP + 9216;
    LAS float* GT = (LAS float*)(OUT + 18432);
    LAS float* AD = GT + 512;
    LAS float* BGL = AD + 128 + 512;
    const int tid = C.tid, lane = C.lane, wave = C.wave, l15 = lane & 15, quad = lane >> 4;
    const int i = l >> 1; const size_t tokbase = (size_t)b * SEQ; const int cfirst = oct * 8;
    const int d = tid & 63; const int tg = wave;
    const bf16* QKV = (const bf16*)(C.a->ws + WS_QKV); const float* BGg = (const float*)(C.a->ws + WS_BG);
    const size_t item0 = ((size_t)(b * 4 + h)) * 64;
    float w2[16];
#pragma unroll
    for (int r = 0; r < 16; ++r) w2[r] = C.a->in[I_EGK2][((size_t)i * 16 + r) * 256 + h * 64 + d];
    const float bgk = C.a->in[I_EBGK][i * 256 + h * 64 + d];
    const int e0 = 16 * wave;
    const int ot = tid >> 3, oj = tid & 7;
    unsigned short qraw[8], kraw[8]; u32x4 vraw[2]; f32x4 bgreg = (f32x4){0.f, 0.f, 0.f, 0.f};
    float cs[8];
#define GLA_LOAD_QKV(c_) do { const size_t tk0_ = tokbase + 64 * (size_t)(c_); \
        _Pragma("unroll") for (int t = 0; t < 8; ++t) { const size_t tk = tk0_ + 8 * tg + t; qraw[t] = QKV[tk * QKVW + E_BQ + h * 64 + d]; kraw[t] = QKV[tk * QKVW + E_BK + h * 64 + d]; } \
        _Pragma("unroll") for (int ii = 0; ii < 2; ++ii) { const int id = tid + 512 * ii, s_ = id >> 4, c8 = id & 15; vraw[ii] = *(const u32x4*)(QKV + (tk0_ + s_) * QKVW + E_BV + h * 128 + 8 * c8); } } while (0)
#define GLA_LOAD_BG(c_) do { if (tid < 256) bgreg = *(const f32x4*)(BGg + (tokbase + 64 * (size_t)(c_) + (tid >> 2)) * 16 + (tid & 3) * 4); } while (0)
#define GLA_STORE_BG(slot) do { if (tid < 256) *(LAS f32x4*)(BGL + (slot) * 1024 + (tid >> 2) * 16 + (tid & 3) * 4) = bgreg; } while (0)
#define GLA_PREP1(slot) do { float run = 0.f; \
        _Pragma("unroll") for (int t = 0; t < 8; ++t) { const LAS float* bgp = BGL + (slot) * 1024 + (8 * tg + t) * 16; float z = bgk; \
            _Pragma("unroll") for (int q_ = 0; q_ < 4; ++q_) { const f32x4 bv = *(const LAS f32x4*)(bgp + 4 * q_); z += bv[0] * w2[4 * q_] + bv[1] * w2[4 * q_ + 1] + bv[2] * w2[4 * q_ + 2] + bv[3] * w2[4 * q_ + 3]; } \
            const float ls = fminf(z, 0.f) - __logf(1.f + __expf(-fabsf(z))); run += ls * (1.f / 16.f); cs[t] = run; } \
        GT[tg * 64 + d] = run; } while (0)
#define GLA_PREP2(setp, adslot) do { LAS unsigned char* QD_ = (setp); LAS unsigned char* KI_ = (setp) + 9216; LAS unsigned char* KDT_ = (setp) + 18432; LAS unsigned char* VT_ = (setp) + 27648; \
        float pre = 0.f, tot = 0.f; \
        _Pragma("unroll") for (int g = 0; g < 8; ++g) { const float x = GT[g * 64 + d]; tot += x; if (g < tg) pre += x; } \
        float kd[8]; const float etot = __expf(tot); \
        _Pragma("unroll") for (int t = 0; t < 8; ++t) { const float bb = pre + cs[t]; const float qv = bf2f(qraw[t]), kv = bf2f(kraw[t]); \
            const float eb = __expf(bb), ib = __builtin_amdgcn_rcpf(eb); \
            *(LAS unsigned short*)(QD_ + (8 * tg + t) * PT + d * 2) = (unsigned short)cvt1_bf16(qv * eb); \
            *(LAS unsigned short*)(KI_ + (8 * tg + t) * PT + d * 2) = (unsigned short)cvt1_bf16(kv * ib); \
            kd[t] = kv * (etot * ib); } \
        u32x4 kdw; kdw.x = cvt_pk_bf16(kd[0], kd[1]); kdw.y = cvt_pk_bf16(kd[2], kd[3]); kdw.z = cvt_pk_bf16(kd[4], kd[5]); kdw.w = cvt_pk_bf16(kd[6], kd[7]); \
        *(LAS u32x4*)(KDT_ + d * PT + 16 * tg) = kdw; \
        if (tg == 0) AD[(adslot) * 64 + d] = etot; \
        _Pragma("unroll") for (int ii = 0; ii < 2; ++ii) { const int id = tid + 512 * ii, s_ = id >> 4, c8 = id & 15; \
            _Pragma("unroll") for (int jj = 0; jj < 8; ++jj) *(LAS unsigned short*)(VT_ + (8 * c8 + jj) * PT + s_ * 2) = (unsigned short)((vraw[ii][jj >> 1] >> ((jj & 1) * 16)) & 0xffffu); } } while (0)
    f32x4 agg[4];
#pragma unroll
    for (int db = 0; db < 4; ++db) agg[db] = (f32x4){0.f, 0.f, 0.f, 0.f};
    float aprod = 1.f;
    const int clast = cfirst + 7;
    GLA_LOAD_BG(cfirst); GLA_STORE_BG(0); GLA_LOAD_BG(cfirst + 1); GLA_STORE_BG(1);
    GLA_LOAD_QKV(cfirst);
    __syncthreads();
    GLA_PREP1(0);
    __syncthreads();
    GLA_PREP2(lds, 0);
    GLA_LOAD_QKV(cfirst + 1); GLA_LOAD_BG(cfirst + 2);
    __syncthreads();
    for (int cc = 0; cc < 8; ++cc) {
        const int c = cfirst + cc; const size_t item = item0 + c;
        const int cb = cc & 1, nb = cb ^ 1;
        LAS unsigned char* QD = lds + cb * SET; LAS unsigned char* KI = QD + 9216; LAS unsigned char* KDT = QD + 18432; LAS unsigned char* VT = QD + 27648;
        GLA_STORE_BG(cb);
        if (cc + 1 < 8) GLA_PREP1(nb);
        { const int tb = wave >> 1;
#pragma unroll
          for (int sq = 0; sq < 2; ++sq) { const int sb = 2 * (wave & 1) + sq; f32x4 sc = (f32x4){0.f, 0.f, 0.f, 0.f};
              if (sb <= tb) {
#pragma unroll
                  for (int ks = 0; ks < 2; ++ks) { const bf16x8 a = *(const LAS bf16x8*)(QD + (16 * tb + l15) * PT + (8 * quad + 32 * ks) * 2), bb = *(const LAS bf16x8*)(KI + (16 * sb + l15) * PT + (8 * quad + 32 * ks) * 2);
                      sc = __builtin_amdgcn_mfma_f32_16x16x32_bf16(a, bb, sc, 0, 0, 0); } }
#pragma unroll
              for (int jj = 0; jj < 4; ++jj) { const int t = 16 * tb + 4 * quad + jj, s_ = 16 * sb + l15; const float v = (s_ <= t) ? sc[jj] : 0.f;
                  *(LAS unsigned short*)(PP + t * PT + s_ * 2) = (unsigned short)cvt1_bf16(v); } } }
        { const u32x4 qv = *(const LAS u32x4*)(QD + ot * PT + oj * 16); *(u32x4*)((bf16*)(C.a->ws + WS_GQD) + item * 4096 + ot * 64 + oj * 8) = qv;
          if (tid < 64) { const float ad_ = AD[cb * 64 + tid]; ((float*)(C.a->ws + WS_GAD))[item * 64 + tid] = ad_; aprod *= ad_; } }
        LBAR();
        if (cc + 1 < 8) GLA_PREP2(lds + nb * SET, nb);
        bf16x8 vfrag[2], pq_[4][2], kq_[4][2];
#pragma unroll
        for (int ks = 0; ks < 2; ++ks) { vfrag[ks] = *(const LAS bf16x8*)(VT + (e0 + l15) * PT + (8 * quad + 32 * ks) * 2);
#pragma unroll
            for (int tb = 0; tb < 4; ++tb) { pq_[tb][ks] = *(const LAS bf16x8*)(PP + (16 * tb + l15) * PT + (8 * quad + 32 * ks) * 2); kq_[tb][ks] = *(const LAS bf16x8*)(KDT + (16 * tb + l15) * PT + (8 * quad + 32 * ks) * 2); } }
        __builtin_amdgcn_sched_barrier(0);
#pragma unroll
        for (int tb = 0; tb < 4; ++tb) { f32x4 oa = (f32x4){0.f, 0.f, 0.f, 0.f};
#pragma unroll
            for (int ks = 0; ks < 2; ++ks) oa = __builtin_amdgcn_mfma_f32_16x16x32_bf16(pq_[tb][ks], vfrag[ks], oa, 0, 0, 0);
#pragma unroll
            for (int jj = 0; jj < 4; ++jj) *(LAS unsigned short*)(OUT + (16 * tb + 4 * quad + jj) * 272 + (e0 + l15) * 2) = (unsigned short)cvt1_bf16(oa[jj]); }
        { float* kvp = (float*)(C.a->ws + WS_GKV) + item * 8192;
#pragma unroll
          for (int db = 0; db < 4; ++db) { f32x4 sa = (f32x4){0.f, 0.f, 0.f, 0.f};
#pragma unroll
            for (int ks = 0; ks < 2; ++ks) sa = __builtin_amdgcn_mfma_f32_16x16x32_bf16(vfrag[ks], kq_[db][ks], sa, 0, 0, 0);
#pragma unroll
            for (int jj = 0; jj < 4; ++jj) kvp[(e0 + 4 * quad + jj) * 64 + 16 * db + l15] = sa[jj];
            agg[db] = agg[db] * AD[cb * 64 + 16 * db + l15] + sa; } }
        { const int c2 = c + 2 <= clast ? c + 2 : clast, c3 = c + 3 <= clast ? c + 3 : clast; GLA_LOAD_QKV(c2); GLA_LOAD_BG(c3); }
        LBAR();
        { const u32x4 o0 = *(const LAS u32x4*)(OUT + ot * 272 + oj * 32), o1 = *(const LAS u32x4*)(OUT + ot * 272 + oj * 32 + 16);
          bf16* gp = (bf16*)(C.a->ws + WS_GIN) + item * 8192 + ot * 128 + oj * 16; *(u32x4*)gp = o0; *(u32x4*)(gp + 8) = o1; }
    }
    { float* ga = (float*)(C.a->ws + WS_GKA) + ((size_t)(b * 4 + h) * 8 + oct) * 8256;
#pragma unroll
      for (int db = 0; db < 4; ++db)
#pragma unroll
          for (int jj = 0; jj < 4; ++jj) ga[(e0 + 4 * quad + jj) * 64 + 16 * db + l15] = agg[db][jj];
      if (tid < 64) ga[8192 + tid] = aprod; }
    __syncthreads();
#undef GLA_LOAD_QKV
#undef GLA_LOAD_BG
#undef GLA_STORE_BG
#undef GLA_PREP1
#undef GLA_PREP2
}

__device__ __forceinline__ void gla_scan_unit(const Ctx& C, int l, int b, int h, int oct) {
    LAS unsigned char* lds = C.lds;
    constexpr int PT = 144;
    LAS unsigned char* QD = lds;
    LAS unsigned char* ST = lds + 2 * 9216;
    LAS unsigned char* OUT = ST + 18432;
    const int tid = C.tid, lane = C.lane, wave = C.wave, l15 = lane & 15, quad = lane >> 4;
    const int i = l >> 1; const size_t tokbase = (size_t)b * SEQ; const int cfirst = oct * 8;
    const bf16* QKV = (const bf16*)(C.a->ws + WS_QKV); bf16* Og = (bf16*)(C.a->ws + WS_O);
    const float* GKV = (const float*)(C.a->ws + WS_GKV); const float* GAD = (const float*)(C.a->ws + WS_GAD); const bf16* GQD = (const bf16*)(C.a->ws + WS_GQD); const bf16* GIN = (const bf16*)(C.a->ws + WS_GIN);
    const size_t item0 = ((size_t)(b * 4 + h)) * 64;
    const int e0 = 16 * wave;
    const int ot = tid >> 3, oj = tid & 7;
    const int se = tid >> 2, sd = (tid & 3) * 16;
    float gg[16];
#pragma unroll
    for (int k = 0; k < 16; ++k) gg[k] = C.a->in[I_EGLAN][i * 128 + 16 * oj + k];
    f32x4 S[4];
#pragma unroll
    for (int k = 0; k < 4; ++k) S[k] = (f32x4){0.f, 0.f, 0.f, 0.f};
    for (int oo = 0; oo < oct; ++oo) { const float* ga = (const float*)(C.a->ws + WS_GKA) + ((size_t)(b * 4 + h) * 8 + oo) * 8256;
#pragma unroll
        for (int k = 0; k < 4; ++k) { const f32x4 kv = *(const f32x4*)(ga + se * 64 + sd + 4 * k), av = *(const f32x4*)(ga + 8192 + sd + 4 * k); S[k] = S[k] * av + kv; } }
    for (int cc = 0; cc < 8; ++cc) {
        const int c = cfirst + cc; const size_t item = item0 + c; const size_t tok0 = tokbase + 64 * c; const int cb = cc & 1;
        const u32x4 qv = *(const u32x4*)(GQD + item * 4096 + ot * 64 + oj * 8);
        f32x4 kv[4], av[4];
#pragma unroll
        for (int k = 0; k < 4; ++k) { kv[k] = *(const f32x4*)(GKV + item * 8192 + se * 64 + sd + 4 * k); av[k] = *(const f32x4*)(GAD + item * 64 + sd + 4 * k); }
        const u32x4 in0 = *(const u32x4*)(GIN + item * 8192 + ot * 128 + oj * 16), in1 = *(const u32x4*)(GIN + item * 8192 + ot * 128 + oj * 16 + 8);
        const u32x4 rg0 = *(const u32x4*)(QKV + (tok0 + ot) * QKVW + E_BR + h * 128 + 16 * oj), rg1 = *(const u32x4*)(QKV + (tok0 + ot) * QKVW + E_BR + h * 128 + 16 * oj + 8);
        { u32x4 w0, w1; w0.x = cvt_pk_bf16(S[0][0], S[0][1]); w0.y = cvt_pk_bf16(S[0][2], S[0][3]); w0.z = cvt_pk_bf16(S[1][0], S[1][1]); w0.w = cvt_pk_bf16(S[1][2], S[1][3]);
          w1.x = cvt_pk_bf16(S[2][0], S[2][1]); w1.y = cvt_pk_bf16(S[2][2], S[2][3]); w1.z = cvt_pk_bf16(S[3][0], S[3][1]); w1.w = cvt_pk_bf16(S[3][2], S[3][3]);
          *(LAS u32x4*)(ST + se * PT + sd * 2) = w0; *(LAS u32x4*)(ST + se * PT + sd * 2 + 16) = w1; }
        *(LAS u32x4*)(QD + cb * 9216 + ot * PT + oj * 16) = qv;
        LBAR();
        { bf16x8 sq_[2], aq_[4][2];
#pragma unroll
          for (int ks = 0; ks < 2; ++ks) { sq_[ks] = *(const LAS bf16x8*)(ST + (e0 + l15) * PT + (8 * quad + 32 * ks) * 2);
#pragma unroll
              for (int tb = 0; tb < 4; ++tb) aq_[tb][ks] = *(const LAS bf16x8*)(QD + cb * 9216 + (16 * tb + l15) * PT + (8 * quad + 32 * ks) * 2); }
          __builtin_amdgcn_sched_barrier(0);
#pragma unroll
          for (int tb = 0; tb < 4; ++tb) { f32x4 oa = (f32x4){0.f, 0.f, 0.f, 0.f};
#pragma unroll
            for (int ks = 0; ks < 2; ++ks) oa = __builtin_amdgcn_mfma_f32_16x16x32_bf16(aq_[tb][ks], sq_[ks], oa, 0, 0, 0);
#pragma unroll
            for (int jj = 0; jj < 4; ++jj) *(LAS unsigned short*)(OUT + (16 * tb + 4 * quad + jj) * 272 + (e0 + l15) * 2) = (unsigned short)cvt1_bf16(oa[jj]); } }
#pragma unroll
        for (int k = 0; k < 4; ++k) S[k] = S[k] * av[k] + kv[k];
        LBAR();
        { const u32x4 o0 = *(const LAS u32x4*)(OUT + ot * 272 + oj * 32), o1 = *(const LAS u32x4*)(OUT + ot * 272 + oj * 32 + 16);
          float ov[16];
#pragma unroll
          for (int k = 0; k < 4; ++k) { ov[2 * k] = bflo(o0[k]) + bflo(in0[k]); ov[2 * k + 1] = bfhi(o0[k]) + bfhi(in0[k]); ov[8 + 2 * k] = bflo(o1[k]) + bflo(in1[k]); ov[8 + 2 * k + 1] = bfhi(o1[k]) + bfhi(in1[k]); }
          float q = 0.f;
#pragma unroll
          for (int k = 0; k < 16; ++k) q += ov[k] * ov[k];
          q = sum8_dpp(q);
          const float rstd = 1.0f / sqrtf(q * (1.f / 128.f) + EPS);
          u32x4 w0, w1;
#pragma unroll
          for (int k = 0; k < 4; ++k) {
              { const float ra = bflo(rg0[k]), rb = bfhi(rg0[k]); const float sa = ra * __builtin_amdgcn_rcpf(1.f + __expf(-ra)), sb2 = rb * __builtin_amdgcn_rcpf(1.f + __expf(-rb));
                w0[k] = cvt_pk_bf16(ov[2 * k] * rstd * gg[2 * k] * sa, ov[2 * k + 1] * rstd * gg[2 * k + 1] * sb2); ov[2 * k] *= rstd * gg[2 * k] * sa * F8_ACT_SCALE; ov[2 * k + 1] *= rstd * gg[2 * k + 1] * sb2 * F8_ACT_SCALE; }
              { const float ra = bflo(rg1[k]), rb = bfhi(rg1[k]); const float sa = ra * __builtin_amdgcn_rcpf(1.f + __expf(-ra)), sb2 = rb * __builtin_amdgcn_rcpf(1.f + __expf(-rb));
                w1[k] = cvt_pk_bf16(ov[8 + 2 * k] * rstd * gg[8 + 2 * k] * sa, ov[8 + 2 * k + 1] * rstd * gg[8 + 2 * k + 1] * sb2); ov[8 + 2 * k] *= rstd * gg[8 + 2 * k] * sa * F8_ACT_SCALE; ov[8 + 2 * k + 1] *= rstd * gg[8 + 2 * k + 1] * sb2 * F8_ACT_SCALE; } }
          (void)w0; (void)w1;
          u32x4 w8; w8.x = pk4_fp8(ov[0], ov[1], ov[2], ov[3]); w8.y = pk4_fp8(ov[4], ov[5], ov[6], ov[7]); w8.z = pk4_fp8(ov[8], ov[9], ov[10], ov[11]); w8.w = pk4_fp8(ov[12], ov[13], ov[14], ov[15]);
          *(u32x4*)((unsigned char*)Og + (tok0 + ot) * DM + 512 + h * 128 + 16 * oj) = w8; }
    }
    __syncthreads();
}

__device__ __forceinline__ void stickbreak_wave_unit(const Ctx& C, int b, int h, int qt, int nb_, int nh_, int nqt_) {
    LAS unsigned char* kl = C.lds + 65536 + C.wave * 8192;
    LAS unsigned char* vl = C.lds + C.wave * 8192;
    const int lane = C.lane, r32 = lane & 31, hi = lane >> 5;
    const int i16 = lane & 15, q4 = i16 >> 2, p4 = i16 & 3, half16 = (lane >> 4) & 1;
    const size_t tokbase = (size_t)b * SEQ; const int q0 = qt * 32;
    const bf16* qp = ((bf16*)(C.a->ws + WS_QKV)) + (tokbase + q0 + r32) * QKVW + O_Q + h * 64 + 8 * hi;
    bf16x8 qr[4];
#pragma unroll
    for (int d0 = 0; d0 < 4; ++d0) qr[d0] = *(const bf16x8*)(qp + 16 * d0);
    f32x16 o[2];
#pragma unroll
    for (int k = 0; k < 2; ++k)
#pragma unroll
        for (int i = 0; i < 16; ++i) o[k][i] = 0.f;
    float R = 0.f;
    const int jd = q0 >> 6, qloc = (q0 & 63) + r32;
    u32x4 kr[8];
    const unsigned vdst = (unsigned)__builtin_amdgcn_readfirstlane((int)(unsigned)(uintptr_t)vl);
    const unsigned tdst = (unsigned)__builtin_amdgcn_readfirstlane((int)(unsigned)(uintptr_t)(C.lds + 131072 + C.wave * 1024));
    const char* qkvb = (const char*)(C.a->ws + WS_QKV);
    unsigned nt1 = 0u, nt2 = 0u, nt3 = 0u;
    if (nb_ >= 0) { const unsigned tb2 = (unsigned)nb_ * SEQ, q02 = (unsigned)nqt_ * 32u, k02 = tb2 + ((q02 >> 6) << 6), l31 = (unsigned)(lane & 31);
        const unsigned oq = ((tb2 + q02 + l31) * QKVW + O_Q + nh_ * 64) * 2u, ok0 = ((k02 + l31) * QKVW + O_K + nh_ * 64) * 2u, ok1 = ((k02 + 32u + l31) * QKVW + O_K + nh_ * 64) * 2u,
                       ov0 = ((k02 + l31) * QKVW + O_V + nh_ * 64) * 2u, ov1 = ((k02 + 32u + l31) * QKVW + O_V + nh_ * 64) * 2u;
        nt1 = hi ? ok0 : oq; nt2 = hi ? ov0 : ok1; nt3 = ov1; }
    const unsigned vtch = (unsigned)((((unsigned)tokbase + (unsigned)lane) * QKVW + O_V + h * 64) * 2);
#define SB_LOAD(jj) do { _Pragma("unroll") for (int i = 0; i < 8; ++i) { const int id = lane + 64 * i, row = id >> 3, c = id & 7; \
        kr[i] = *(const u32x4*)(((const bf16*)(C.a->ws + WS_QKV)) + (tokbase + 64 * (jj) + row) * QKVW + O_K + h * 64 + c * 8); } } while (0)
    SB_LOAD(jd);
    for (int j = jd; j >= 0; --j) {
        if (j < jd - 1) { SB_LOAD(j); }
#pragma unroll
        for (int i = 0; i < 8; ++i) { const int id = lane + 64 * i, row = id >> 3, c = id & 7; *(LAS u32x4*)(kl + kswz(row, c)) = kr[i]; }
        { const char* vbase = (const char*)(C.a->ws + WS_QKV) + (tokbase + 64 * (size_t)j) * (size_t)(QKVW * 2);
#pragma unroll
          for (int i = 0; i < 8; ++i) { const int p = i * 64 + lane; const unsigned vo = (unsigned)((((p >> 2) & 63) * QKVW + O_V + h * 64 + (p >> 8) * 32 + (p & 3) * 8) * 2);
              pg8::glds_s(vbase, vo, vdst + (unsigned)(i * 1024)); } }
        if (j > 0 && j == jd) { SB_LOAD(j - 1); }
        if (j > 0 && j == jd) pg8::glds_s(qkvb, vtch + (unsigned)(j - 1) * (unsigned)(64 * QKVW * 2), tdst);
        if (j == jd && nb_ >= 0) { pg8::glds_s(qkvb, nt1, tdst); pg8::glds_s(qkvb, nt2, tdst); pg8::glds_s(qkvb, nt3, tdst); }
        LDS_WAIT();
        f32x16 s0, s1;
#pragma unroll
        for (int i = 0; i < 16; ++i) { s0[i] = 0.f; s1[i] = 0.f; }
#pragma unroll
        for (int d0 = 0; d0 < 4; ++d0) { const int c = 2 * d0 + hi;
            const bf16x8 a0 = *(const LAS bf16x8*)(kl + kswz(r32, c)), a1 = *(const LAS bf16x8*)(kl + kswz(32 + r32, c));
            s0 = __builtin_amdgcn_mfma_f32_32x32x16_bf16(a0, qr[d0], s0, 0, 0, 0); s1 = __builtin_amdgcn_mfma_f32_32x32x16_bf16(a1, qr[d0], s1, 0, 0, 0); }
        const bool diag = (j == jd);
        const float eR = ex2(R);
#pragma unroll
        for (int i = 0; i < 16; ++i) { const int kv = crow(i, hi);
            { const float r = __builtin_amdgcn_rcpf(1.f + ex2(fminf(s0[i], 100.f))); s0[i] = (!diag || (kv < qloc)) ? r : 1.f; }
            { const float r = __builtin_amdgcn_rcpf(1.f + ex2(fminf(s1[i], 100.f))); s1[i] = (!diag || (kv + 32 < qloc)) ? r : 1.f; } }
        float own[8], oth[8];
#pragma unroll
        for (int g = 0; g < 4; ++g) { own[g] = (s0[4 * g] * s0[4 * g + 1]) * (s0[4 * g + 2] * s0[4 * g + 3]); own[4 + g] = (s1[4 * g] * s1[4 * g + 1]) * (s1[4 * g + 2] * s1[4 * g + 3]); }
#pragma unroll
        for (int g = 0; g < 8; ++g) oth[g] = pl32_other(own[g], hi);
        float T[8]; { float so = 1.f, sp_ = 1.f;
#pragma unroll
            for (int g = 7; g >= 0; --g) { T[g] = so * sp_ * (hi ? 1.f : oth[g]); so *= own[g]; sp_ *= oth[g]; }
            const float tot = so * sp_;
#pragma unroll
            for (int g = 0; g < 4; ++g) {
                { const float p4 = eR * T[g], p3 = p4 * s0[4 * g + 3], p2 = p3 * s0[4 * g + 2], p1 = p2 * s0[4 * g + 1], p0 = p1 * s0[4 * g];
                  s0[4 * g + 3] = p4 - p3; s0[4 * g + 2] = p3 - p2; s0[4 * g + 1] = p2 - p1; s0[4 * g] = p1 - p0; }
                { const float p4 = eR * T[4 + g], p3 = p4 * s1[4 * g + 3], p2 = p3 * s1[4 * g + 2], p1 = p2 * s1[4 * g + 1], p0 = p1 * s1[4 * g];
                  s1[4 * g + 3] = p4 - p3; s1[4 * g + 2] = p3 - p2; s1[4 * g + 1] = p2 - p1; s1[4 * g] = p1 - p0; } }
            R += lg2(tot); }
        if (j == jd) { if (nb_ >= 0) { if (j > 0) asm volatile("s_waitcnt vmcnt(12)" ::: "memory"); else asm volatile("s_waitcnt vmcnt(3)" ::: "memory"); }
                       else { if (j > 0) asm volatile("s_waitcnt vmcnt(9)" ::: "memory"); else asm volatile("s_waitcnt vmcnt(0)" ::: "memory"); } }
        else asm volatile("s_waitcnt vmcnt(0)" ::: "memory");
        const LAS unsigned char* vb = vl + half16 * 32 + p4 * 8 + (4 * hi + q4) * 64;
#pragma unroll
        for (int s = 0; s < 4; ++s) {
            u32x4 pw;
            if (s < 2) { pw.x = cvt_pk_bf16(s0[8 * s + 0], s0[8 * s + 1]); pw.y = cvt_pk_bf16(s0[8 * s + 2], s0[8 * s + 3]); pw.z = cvt_pk_bf16(s0[8 * s + 4], s0[8 * s + 5]); pw.w = cvt_pk_bf16(s0[8 * s + 6], s0[8 * s + 7]); }
            else { const int t = s - 2; pw.x = cvt_pk_bf16(s1[8 * t + 0], s1[8 * t + 1]); pw.y = cvt_pk_bf16(s1[8 * t + 2], s1[8 * t + 3]); pw.z = cvt_pk_bf16(s1[8 * t + 4], s1[8 * t + 5]); pw.w = cvt_pk_bf16(s1[8 * t + 6], s1[8 * t + 7]); }
            const bf16x8 pf = __builtin_bit_cast(bf16x8, pw);
#pragma unroll
            for (int k = 0; k < 2; ++k) { const s16x4 lo = vtr(vb + k * 4096 + s * 1024), hh = vtr(vb + k * 4096 + s * 1024 + 512);
                const bf16x8 vf = (bf16x8){lo[0], lo[1], lo[2], lo[3], hh[0], hh[1], hh[2], hh[3]};
                o[k] = __builtin_amdgcn_mfma_f32_32x32x16_bf16(vf, pf, o[k], 0, 0, 0); }
        }
        LDS_WAIT();
        if (__all(R < -40.f)) break;
    }
#undef SB_LOAD
#pragma unroll
    for (int k = 0; k < 2; ++k)
#pragma unroll
        for (int g = 0; g < 4; ++g) { const int dv = 32 * k + 8 * g + 4 * hi;
            *(LAS unsigned*)(kl + r32 * 64 + dv) = pk4_fp8(o[k][4 * g] * F8_ACT_SCALE, o[k][4 * g + 1] * F8_ACT_SCALE, o[k][4 * g + 2] * F8_ACT_SCALE, o[k][4 * g + 3] * F8_ACT_SCALE); }
    LDS_WAIT();
    { const int orow = lane >> 2, opc = lane & 3;
      const u32x4 w0 = *(const LAS u32x4*)(kl + orow * 64 + opc * 16), w1 = *(const LAS u32x4*)(kl + (16 + orow) * 64 + opc * 16);
      unsigned char* ob = (unsigned char*)(C.a->ws + WS_O) + (tokbase + q0 + orow) * DM + h * 64 + opc * 16;
      *(u32x4*)ob = w0; *(u32x4*)(ob + (size_t)16 * DM) = w1; }
    LDS_WAIT();
}


constexpr int PH_PER_LAYER = 8, N_PHASES = 1 + DEPTH * PH_PER_LAYER + 1;

__global__ void __launch_bounds__(512, 2) fwd(Args args) {
    extern __shared__ __attribute__((aligned(16))) unsigned char lds_raw[];
    Ctx C;
    C.lds = (LAS unsigned char*)lds_raw;
    C.tid = threadIdx.x; C.lane = C.tid & 63; C.wave = __builtin_amdgcn_readfirstlane(C.tid >> 6);
    C.G = gridDim.x; { const int bx = blockIdx.x; C.vcu = (C.G % 8 == 0) ? (bx % 8) * (C.G / 8) + bx / 8 : bx; }
    C.a = &args;
    LAS unsigned* lctl = (LAS unsigned*)(C.lds + LCTL_OFF);
    for (int u = C.tid; u < 1024; u += 512) lctl[u] = 0u;
    __syncthreads();
    const int lo = args.ph_lo, hi = args.ph_hi;
    XcdBarrier bar; bar.bar = ((unsigned*)(C.a->ws + WS_CTL)) + CW_BAR; bar.x = 0; bar.st = nullptr;
    if (hi - lo > 1) bar = xcd_barrier_post(((unsigned*)(C.a->ws + WS_CTL)) + CW_BAR, (volatile LAS unsigned*)lctl);
#ifndef PH_MASK
#define PH_MASK 0xffff
#endif
#define PHM(kind) ((PH_MASK >> (kind)) & 1)
#define IN(k) (lo <= (k) && (k) < hi)
#define INL(p) (PHM((p) + 1) && IN(pb + (p)))
#define SEAM(k) do { if (IN(k) && IN((k) + 1)) xcd_barrier(bar); } while (0)

    if (PHM(0) && IN(0)) { p0_prologue(C); __syncthreads(); SEAM(0); }

    for (int l = 0; l < DEPTH; ++l) {
        const int pb = 1 + PH_PER_LAYER * l;
        const bool odd = (l & 1) != 0;
        if (INL(0)) {
            const Ctx P = launder(C);
            if (l == 0) norm_phase<false, 1, false, true>(P, l, P.a->in[I_X], P.a->in[I_NMIX], 0, ((bf16*)(P.a->ws + WS_WBG)));
            else if (odd) norm_phase<true, 0, false, false>(P, l, nullptr, P.a->in[I_NMIX], 0, nullptr);
            else norm_phase<true, 1, false, false>(P, l, nullptr, P.a->in[I_NMIX], 0, ((bf16*)(P.a->ws + WS_WBG)) + (size_t)(l >> 1) * 16 * 1024);
            SEAM(pb + 0);
        }
        if (INL(1)) {
            const Ctx P = launder(C); const int bx = (P.vcu % (P.G / 8)) * 8 + P.vcu / (P.G / 8);
            pg8::Gemm g{((bf16*)(P.a->ws + WS_H)), ((bf16*)(P.a->ws + WS_WIN)) + (size_t)l * 3072 * 1024, 1024}; pg8::StaticOrder S; S.init(NTOK, QKVW, P.G, bx);
            pg8::EpiQKV E{((bf16*)(P.a->ws + WS_QKV)), QKVW, C2, odd ? 4 : 2, 0.125f, odd ? -1 : 6};
            pg8::gemm_phase<pg8::EpiQKV, pg8::StaticOrder, false, true>(P.lds, P.tid, g, S, E);
            SEAM(pb + 1);
        }
        if (INL(2) || INL(3)) {
            if (!odd) {
                LAS float* lamp = (LAS float*)(lctl + 64);
                LAS int* itemp = (LAS int*)(lctl + 65);
                if (C.wave == 0) { const float* lp = C.a->in[I_ELAM] + (size_t)(l >> 1) * 256; const float a = wave_sum(lp[C.lane] * lp[64 + C.lane]), bq = wave_sum(lp[128 + C.lane] * lp[192 + C.lane]);
                    if (C.lane == 0) *lamp = __expf(a) - __expf(bq); }
                const float lam_init = 0.8f - 0.6f * __expf(-0.3f * (float)l);
                const int myx = (int)(xb_xcc_id() & 7u);
#pragma unroll 1
                for (int pass_ = 0; pass_ < 2; ++pass_) {
                    if (!(pass_ == 0 ? INL(2) : INL(3))) continue;
                    const int nqb = pass_ == 0 ? 8 : 24, qb_hi = pass_ == 0 ? 31 : 23, nitem = 32 + 4 * nqb;
#pragma unroll 1
                    for (int kx = 0; kx < 8; ++kx) {
                        const int xq = (myx + kx) & 7;
                        unsigned* qctr = ((unsigned*)(C.a->ws + WS_CTL)) + CW_QUEUE + 1024 + (((l >> 1) * 2 + pass_) * 8 + xq) * 16;
                        for (;;) {
                            __syncthreads();
                            if (C.tid == 0) *itemp = (int)__hip_atomic_fetch_add(qctr, 1u, __ATOMIC_RELAXED, __HIP_MEMORY_SCOPE_AGENT);
                            __syncthreads();
                            const int item = __builtin_amdgcn_readfirstlane(*itemp);
                            const float lam = *lamp + lam_init;
                            if (item >= nitem) break;
                            const Ctx P = launder(C);
                            if (item < 32) { const int oct = 7 - (item >> 2), bh = 4 * xq + (item & 3);
                                if (pass_ == 0) gla_local_unit(P, l, bh >> 2, bh & 3, oct); else gla_scan_unit(P, l, bh >> 2, bh & 3, oct); }
                            else { const int k = item - 32, bh = 4 * xq + (k & 3), qb = qb_hi - (k >> 2); diffattn_unit(P, l, bh >> 2, bh & 3, qb, lam, lam_init); }
                        }
                    }
                    if (pass_ == 0) { SEAM(pb + 2); } else { SEAM(pb + 3); }
                }
            } else if (INL(3)) {
                const Ctx P = launder(C);
                const int gw = P.vcu * 8 + P.wave, NGW = P.G * 8;
                for (int u = gw; u < NBATCH * 16 * 128; u += NGW) { const int hs = u & 1, qt = (u >> 1) & 127, hp = (u >> 8) & 7, b = u >> 11;
                    const int u2 = u + NGW; const bool hn = u2 < NBATCH * 16 * 128;
                    stickbreak_wave_unit(P, b, 2 * hp + hs, qt, hn ? (u2 >> 11) : -1, 2 * ((u2 >> 8) & 7) + (u2 & 1), (u2 >> 1) & 127); }
                __syncthreads();
                SEAM(pb + 3);
            }
        }
        if (INL(4)) {
            const Ctx P = launder(C); const int bx = (P.vcu % (P.G / 8)) * 8 + P.vcu / (P.G / 8);
            pg8::Gemm g{(const bf16*)(P.a->ws + WS_O), (const bf16*)(P.a->ws + WS_WOUT + (size_t)l * 1024 * 1024), 512}; pg8::StaticOrder S; S.init(NTOK, DM, P.G, bx);
            const float* gate1 = ((float*)(P.a->ws + WS_MOD)) + (size_t)l * 8 * 6144 + 2 * 1024;
            if (l == 0) { pg8::EpiResid<true> E{P.a->in[I_X], (bf16*)(P.a->ws + WS_XB), gate1}; pg8::gemm_phase<pg8::EpiResid<true>, pg8::StaticOrder, false, true, true>(P.lds, P.tid, g, S, E); }
            else { pg8::EpiResid<false> E{nullptr, (bf16*)(P.a->ws + WS_XB), gate1}; pg8::gemm_phase<pg8::EpiResid<false>, pg8::StaticOrder, false, true, true>(P.lds, P.tid, g, S, E); }
            SEAM(pb + 4);
        }
        if (INL(5)) {
            const Ctx P = launder(C);
            norm_phase<false, 2, false, false>(P, l, nullptr, P.a->in[I_NFFN], 3, ((bf16*)(P.a->ws + WS_WR)) + (size_t)l * 36 * 1024);
            SEAM(pb + 5);
        }
        if (INL(6)) {
            const Ctx P = launder(C); const int bx = (P.vcu % (P.G / 8)) * 8 + P.vcu / (P.G / 8);
            LAS int* tb = (LAS int*)(P.lds + LCTL_OFF + 64); LAS int* cl = (LAS int*)(P.lds + LCTL_OFF + 512);
            const int* cnt = (const int*)(((unsigned*)(P.a->ws + WS_CTL)) + CW_CNT + 64 * l);
            __syncthreads();
            if (P.tid < 32) {
                const int cv = (int)__hip_atomic_load(cnt + P.tid, __ATOMIC_RELAXED, __HIP_MEMORY_SCOPE_AGENT); cl[P.tid] = cv; int t = (cv + 255) >> 8;
#pragma unroll
                for (int d = 1; d < 32; d <<= 1) { const int v = __shfl_up(t, d); if (P.tid >= d) t += v; }
                tb[P.tid + 1] = t; if (P.tid == 0) tb[0] = 0; }
            __syncthreads();
            const int T = __builtin_amdgcn_readfirstlane(tb[32]);
            pg8::GroupedOrder S{tb, T, P.G, bx, ((int*)(P.a->ws + WS_PLIST)), cl};
            pg8::Gemm g{(const bf16*)(P.a->ws + WS_H8), (const bf16*)(P.a->ws + WS_WGU + (size_t)l * 32 * 1024 * 1024), 512};
            pg8::EpiSwiGLU8 E{(unsigned char*)(P.a->ws + WS_O), ((float*)(P.a->ws + WS_WLIST))};
            pg8::gemm_phase<pg8::EpiSwiGLU8, pg8::GroupedOrder, true, true, true>(P.lds, P.tid, g, S, E);
            SEAM(pb + 6);
        }
        if (INL(7)) {
            const Ctx P = launder(C); const int bx = (P.vcu % (P.G / 8)) * 8 + P.vcu / (P.G / 8);
            LAS int* tb = (LAS int*)(P.lds + LCTL_OFF + 64); LAS int* cl = (LAS int*)(P.lds + LCTL_OFF + 512);
            if (!INL(6)) {
            const int* cnt = (const int*)(((unsigned*)(P.a->ws + WS_CTL)) + CW_CNT + 64 * l);
            __syncthreads();
            if (P.tid < 32) {
                const int cv = (int)__hip_atomic_load(cnt + P.tid, __ATOMIC_RELAXED, __HIP_MEMORY_SCOPE_AGENT); cl[P.tid] = cv; int t = (cv + 255) >> 8;
#pragma unroll
                for (int d = 1; d < 32; d <<= 1) { const int v = __shfl_up(t, d); if (P.tid >= d) t += v; }
                tb[P.tid + 1] = t; if (P.tid == 0) tb[0] = 0; }
            __syncthreads();
            }
            const int T = __builtin_amdgcn_readfirstlane(tb[32]);
            pg8::GroupedOrder S{tb, T, P.G, bx, ((int*)(P.a->ws + WS_PLIST)), cl};
            pg8::Gemm g{(const bf16*)(P.a->ws + WS_O), (const bf16*)(P.a->ws + WS_WD + (size_t)l * 32 * 1024 * 512), 256};
            pg8::EpiScatterY E{((bf16*)(P.a->ws + WS_QKV)), ((int*)(P.a->ws + WS_PLIST))};
            pg8::gemm_phase<pg8::EpiScatterY, pg8::GroupedOrder, false, true, true>(P.lds, P.tid, g, S, E);
            SEAM(pb + 7);
        }
    }
    if (PHM(9) && IN(N_PHASES - 1)) { const Ctx P = launder(C); norm_phase<true, 0, true, false>(P, DEPTH, nullptr, P.a->in[I_NFIN], 0, nullptr); }
#undef IN
#undef INL
#undef SEAM
}

extern "C" void kernel_launch(void* const* d_in, const int* in_sizes, int n_in, void* d_out, int out_size, void* d_ws, size_t ws_size, hipStream_t stream) {
    static int grid = 0;
    if (grid == 0) {
        if (n_in != 24 || in_sizes[0] != NTOK * DM || out_size != NTOK * DM || ws_size < WS_END) { fprintf(stderr, "kernel_launch: unexpected shapes (n_in %d, in0 %d, out %d, ws %zu)\n", n_in, n_in > 0 ? in_sizes[0] : -1, out_size, ws_size); grid = -1; return; }
        int dev = 0, cus = 0, per_cu = 0;
        if (hipGetDevice(&dev) != hipSuccess || hipDeviceGetAttribute(&cus, hipDeviceAttributeMultiprocessorCount, dev) != hipSuccess) { grid = -1; return; }
        if (hipFuncSetAttribute((const void*)fwd, hipFuncAttributeMaxDynamicSharedMemorySize, LDS_BYTES) != hipSuccess) { fprintf(stderr, "kernel_launch: hipFuncSetAttribute failed\n"); grid = -1; return; }
        if (hipOccupancyMaxActiveBlocksPerMultiprocessor(&per_cu, (const void*)fwd, 512, LDS_BYTES) != hipSuccess || per_cu < 1) fprintf(stderr, "kernel_launch: occupancy query reports %d\n", per_cu);
        (void)hipGetLastError();
        grid = cus;
        if (grid != 256) { fprintf(stderr, "kernel_launch: built for a 256-CU device (one workgroup per CU), found %d CUs\n", cus); grid = -1; return; }
    }
    if (grid < 0) return;
    if (hipMemsetAsync((char*)d_ws + WS_CTL, 0, CTL_ZERO_BYTES, stream) != hipSuccess) return;
    Args a{};
    for (int i = 0; i < 24; ++i) a.in[i] = (const float*)d_in[i];
    a.out = (float*)d_out; a.ws = (unsigned char*)d_ws;
    a.ph_lo = 0; a.ph_hi = N_PHASES;
    hipLaunchKernelGGL(fwd, dim3(grid), dim3(512), LDS_BYTES, stream, a);
}
```
